# Optimizing an MI355X kernel written in HIP

```python
import math
import jax, jax.numpy as jnp
from jax import lax
import numpy as np

D_MODEL = 1024
BATCH = 32
SEQ = 2048
DEPTH = 1

MEM_LEN = 256
EPS = 1e-6
MLA_HEADS = 8
MLA_NOPE = 64
MLA_ROPE = 32
MLA_V = 64
MLA_Q_RANK = 384
MLA_KV_RANK = 256
ROPE_THETA = 10000.0
Q_BLOCK = 128
ML_HEADS = 8
ML_DK = 64
ML_DV = 64
ML_CHUNK = 64
CONV_WIDTH = 5
MEM_HEADS = 4
MEM_HEAD_DIM = 128
MLA_WIDTH = MLA_HEADS * MLA_V
ML_WIDTH = ML_HEADS * ML_DV
MEM_WIDTH = MEM_HEADS * MEM_HEAD_DIM
N_BRANCH = 3
BRANCH_WIDTH = 512
N_ML_GATES = 4 * ML_HEADS
N_IN = N_BRANCH * D_MODEL + MLA_Q_RANK + MLA_KV_RANK + MLA_ROPE + 3 * ML_WIDTH + N_ML_GATES + MEM_WIDTH
D_FF = -(-8 * D_MODEL // (3 * 256)) * 256

kernel_name = "hybrid_mla_mlstm_memory_gated_block"


def rms_norm(x, g):
    xf = x.astype(jnp.float32)
    y = xf * lax.rsqrt(jnp.mean(xf * xf, axis=-1, keepdims=True) + EPS)
    return (y * g.astype(jnp.float32)).astype(x.dtype)


def rope_angles(positions):
    half = MLA_ROPE // 2
    inv = ROPE_THETA ** (-jnp.arange(half, dtype=jnp.float32) / half)
    ang = positions.astype(jnp.float32)[..., None] * inv
    return jnp.cos(ang), jnp.sin(ang)


def apply_rope(x, cos, sin):
    half = x.shape[-1] // 2
    x1, x2 = x[..., :half], x[..., half:]
    out = jnp.concatenate([x1 * cos - x2 * sin, x1 * sin + x2 * cos], axis=-1)
    return out.astype(x.dtype)


def split_columns(z):
    sizes = (N_BRANCH * D_MODEL, MLA_Q_RANK, MLA_KV_RANK, MLA_ROPE,
             ML_WIDTH, ML_WIDTH, ML_WIDTH, N_ML_GATES, MEM_WIDTH)
    idx = np.cumsum(sizes)[:-1].tolist()
    return jnp.split(z, idx, axis=-1)


def mla_attention(c_q, c_kv, k_rope_in, positions, g_q, g_kv, w_uq, w_uk, w_uv):
    B, S, _ = c_q.shape
    cq = rms_norm(c_q, g_q)
    ckv = rms_norm(c_kv, g_kv)
    q = jnp.einsum('bsr,rhd->bshd', cq, w_uq)
    q_nope, q_rope = q[..., :MLA_NOPE], q[..., MLA_NOPE:]
    cos, sin = rope_angles(positions)
    q_rope = apply_rope(q_rope, cos[:, :, None, :], sin[:, :, None, :])
    k_rope = apply_rope(k_rope_in, cos, sin)
    k_nope = jnp.einsum('bsr,rhd->bshd', ckv, w_uk)
    v = jnp.einsum('bsr,rhd->bshd', ckv, w_uv)
    scale = (MLA_NOPE + MLA_ROPE) ** -0.5
    nb = S // Q_BLOCK
    qn_b = q_nope.reshape(B, nb, Q_BLOCK, MLA_HEADS, MLA_NOPE).swapaxes(0, 1)
    qr_b = q_rope.reshape(B, nb, Q_BLOCK, MLA_HEADS, MLA_ROPE).swapaxes(0, 1)

    def block(args):
        qn, qr = args
        s = (jnp.einsum('bqhd,bkhd->bhqk', qn, k_nope)
             + jnp.einsum('bqhd,bkd->bhqk', qr, k_rope))
        p = jax.nn.softmax(s.astype(jnp.float32) * scale, axis=-1).astype(v.dtype)
        return jnp.einsum('bhqk,bkhd->bqhd', p, v)

    o = lax.map(block, (qn_b, qr_b))
    return o.swapaxes(0, 1).reshape(B, S, MLA_WIDTH)


def mlstm_chunkwise(q, k, v, i_pre, f_pre):
    B, H, S, dk = q.shape
    dv = v.shape[-1]
    L = ML_CHUNK
    nc = S // L
    to_chunks = lambda t: jnp.moveaxis(t.reshape(B, H, nc, L, *t.shape[3:]), 2, 0)
    qc, kc, vc = to_chunks(q), to_chunks(k), to_chunks(v)
    lf = to_chunks(jax.nn.log_sigmoid(f_pre))
    ic = to_chunks(i_pre)
    mask = jnp.tril(jnp.ones((L, L), dtype=bool))

    def step(carry, inp):
        C, n, m = carry
        qb, kb, vb, lfb, ib = inp
        b = jnp.cumsum(lfb, axis=-1)
        dmat = jnp.where(mask, b[..., :, None] - b[..., None, :] + ib[..., None, :], -jnp.inf)
        inter = b + m[..., None]
        m_t = jnp.maximum(inter, dmat.max(axis=-1))
        w_inter = jnp.exp(inter - m_t)
        s = jnp.einsum('bhtd,bhsd->bhts', qb, kb) * jnp.exp(dmat - m_t[..., None])
        num = (jnp.einsum('bhts,bhse->bhte', s, vb)
               + w_inter[..., None] * jnp.einsum('bhed,bhtd->bhte', C, qb))
        den = s.sum(axis=-1) + w_inter * jnp.einsum('bhd,bhtd->bht', n, qb)
        h = num / jnp.maximum(jnp.abs(den), jnp.exp(-m_t))[..., None]
        bL = b[..., -1]
        g = bL[..., None] - b + ib
        m_new = jnp.maximum(bL + m, g.max(axis=-1))
        decay = jnp.exp(bL + m - m_new)
        ws = jnp.exp(g - m_new[..., None])
        C_new = decay[..., None, None] * C + jnp.einsum('bhs,bhse,bhsd->bhed', ws, vb, kb)
        n_new = decay[..., None] * n + jnp.einsum('bhs,bhsd->bhd', ws, kb)
        return (C_new, n_new, m_new), h

    init = (jnp.zeros((B, H, dv, dk), jnp.float32),
            jnp.zeros((B, H, dk), jnp.float32),
            jnp.full((B, H), -jnp.inf, jnp.float32))
    _, hs = lax.scan(step, init, (qc, kc, vc, lf, ic))
    return jnp.moveaxis(hs, 0, 2).reshape(B, H, S, dv)


def mlstm_branch(u, v_in, o_pre, gate_pre, conv_w, w_q, w_k, gate_bias, g_head):
    B, S, _ = u.shape
    dtype = u.dtype
    c = lax.conv_general_dilated(u, conv_w[:, None, :], window_strides=(1,), padding='SAME',
                                 dimension_numbers=('NWC', 'WIO', 'NWC'),
                                 feature_group_count=ML_WIDTH)
    c = jax.nn.silu(c).reshape(B, S, ML_HEADS, ML_DK)
    q = jnp.einsum('bshc,hcd->bhsd', c, w_q).astype(jnp.float32)
    k = (jnp.einsum('bshc,hcd->bhsd', c, w_k) * (ML_DK ** -0.5)).astype(jnp.float32)
    v = v_in.reshape(B, S, ML_HEADS, ML_DV).transpose(0, 2, 1, 3).astype(jnp.float32)
    gates = (gate_pre.reshape(B, S, 4, ML_HEADS) + gate_bias).astype(jnp.float32)
    gates = gates.transpose(2, 0, 3, 1)
    flip = lambda t: jnp.flip(t, axis=2)
    q2 = jnp.concatenate([q, flip(q)], axis=1)
    k2 = jnp.concatenate([k, flip(k)], axis=1)
    v2 = jnp.concatenate([v, flip(v)], axis=1)
    i2 = jnp.concatenate([gates[0], flip(gates[2])], axis=1)
    f2 = jnp.concatenate([gates[1], flip(gates[3])], axis=1)
    h2 = mlstm_chunkwise(q2, k2, v2, i2, f2)
    h = h2[:, :ML_HEADS] + flip(h2[:, ML_HEADS:])
    h = h.transpose(0, 2, 1, 3)
    h = h * lax.rsqrt(jnp.mean(h * h, axis=-1, keepdims=True) + EPS)
    h = h.reshape(B, S, ML_WIDTH) * g_head.astype(jnp.float32)
    return (jax.nn.sigmoid(o_pre.astype(jnp.float32)) * h).astype(dtype)


def memory_attention(q_in, mem_n, w_kv):
    B, S, _ = q_in.shape
    M = mem_n.shape[1]
    q = q_in.reshape(B, S, MEM_HEADS, MEM_HEAD_DIM)
    kv = mem_n @ w_kv
    k = kv[..., :MEM_WIDTH].reshape(B, M, MEM_HEADS, MEM_HEAD_DIM)
    v = kv[..., MEM_WIDTH:].reshape(B, M, MEM_HEADS, MEM_HEAD_DIM)
    s = jnp.einsum('bshd,bmhd->bhsm', q, k).astype(jnp.float32) * (MEM_HEAD_DIM ** -0.5)
    p = jax.nn.softmax(s, axis=-1).astype(v.dtype)
    return jnp.einsum('bhsm,bmhd->bshd', p, v).reshape(B, S, MEM_WIDTH)


def hybrid_layer(x, mem, positions, g_mix, w_in, mla_g_q, mla_g_kv, mla_w_uq, mla_w_uk, mla_w_uv,
                 ml_conv_w, ml_w_q, ml_w_k, ml_gate_bias, ml_g_head, mem_g, mem_w_kv,
                 w_branch, w_out, g_ffn, w_ffn_gate, w_ffn_up, w_ffn_down):
    B, S, D = x.shape
    h = rms_norm(x, g_mix)
    z = h @ w_in
    (z_gate, z_cq, z_ckv, z_kr, z_mu, z_mv, z_mo, z_mg, z_memq) = split_columns(z)
    gates = jax.nn.sigmoid(z_gate.astype(jnp.float32)).reshape(B, S, N_BRANCH, D).astype(x.dtype)
    o_mla = mla_attention(z_cq, z_ckv, z_kr, positions, mla_g_q, mla_g_kv, mla_w_uq, mla_w_uk, mla_w_uv)
    o_ml = mlstm_branch(z_mu, z_mv, z_mo, z_mg, ml_conv_w, ml_w_q, ml_w_k, ml_gate_bias, ml_g_head)
    o_mem = memory_attention(z_memq, rms_norm(mem, mem_g), mem_w_kv)
    merged = (gates[:, :, 0] * (o_mla @ w_branch[0])
              + gates[:, :, 1] * (o_ml @ w_branch[1])
              + gates[:, :, 2] * (o_mem @ w_branch[2]))
    x = x + merged @ w_out
    h2 = rms_norm(x, g_ffn)
    ffn = (jax.nn.silu(h2 @ w_ffn_gate) * (h2 @ w_ffn_up)) @ w_ffn_down
    return x + ffn


def setup_inputs(seed: int = 0) -> dict:
    key = jax.random.key(seed)
    ks = jax.random.split(key, 32)
    f32 = jnp.float32
    nrm = lambda k, shape, fan_in: jax.random.normal(k, shape, f32) * (fan_in ** -0.5)
    gain = lambda k, shape: 1.0 + 0.02 * jax.random.normal(k, shape, f32)
    x = jax.random.normal(ks[0], (BATCH, SEQ, D_MODEL), f32)
    mem = jax.random.normal(ks[1], (BATCH, MEM_LEN, D_MODEL), f32)
    offsets = jax.random.randint(ks[2], (BATCH, 1), 0, 4096, dtype=jnp.int32)
    positions = offsets + jnp.arange(SEQ, dtype=jnp.int32)[None, :]
    f_base = jnp.linspace(3.0, 6.0, ML_HEADS, dtype=f32)
    i_base = jnp.zeros((ML_HEADS,), f32)
    gate_base = jnp.stack([i_base, f_base, i_base, f_base])
    ml_gate_bias = gate_base[None] + 0.01 * jax.random.normal(ks[3], (DEPTH, 4, ML_HEADS), f32)
    return {
        "x": x,
        "mem": mem,
        "positions": positions,
        "g_mix": gain(ks[4], (DEPTH, D_MODEL)),
        "w_in": nrm(ks[5], (DEPTH, D_MODEL, N_IN), D_MODEL),
        "mla_g_q": gain(ks[6], (DEPTH, MLA_Q_RANK)),
        "mla_g_kv": gain(ks[7], (DEPTH, MLA_KV_RANK)),
        "mla_w_uq": nrm(ks[8], (DEPTH, MLA_Q_RANK, MLA_HEADS, MLA_NOPE + MLA_ROPE), MLA_Q_RANK),
        "mla_w_uk": nrm(ks[9], (DEPTH, MLA_KV_RANK, MLA_HEADS, MLA_NOPE), MLA_KV_RANK),
        "mla_w_uv": nrm(ks[10], (DEPTH, MLA_KV_RANK, MLA_HEADS, MLA_V), MLA_KV_RANK),
        "ml_conv_w": nrm(ks[11], (DEPTH, CONV_WIDTH, ML_WIDTH), CONV_WIDTH),
        "ml_w_q": nrm(ks[12], (DEPTH, ML_HEADS, ML_DK, ML_DK), ML_DK),
        "ml_w_k": nrm(ks[13], (DEPTH, ML_HEADS, ML_DK, ML_DK), ML_DK),
        "ml_gate_bias": ml_gate_bias,
        "ml_g_head": gain(ks[14], (DEPTH, ML_WIDTH)),
        "mem_g": gain(ks[15], (DEPTH, D_MODEL)),
        "mem_w_kv": nrm(ks[16], (DEPTH, D_MODEL, 2 * MEM_WIDTH), D_MODEL),
        "w_branch": nrm(ks[17], (DEPTH, N_BRANCH, BRANCH_WIDTH, D_MODEL), BRANCH_WIDTH),
        "w_out": nrm(ks[18], (DEPTH, D_MODEL, D_MODEL), D_MODEL),
        "g_ffn": gain(ks[19], (DEPTH, D_MODEL)),
        "w_ffn_gate": nrm(ks[20], (DEPTH, D_MODEL, D_FF), D_MODEL),
        "w_ffn_up": nrm(ks[21], (DEPTH, D_MODEL, D_FF), D_MODEL),
        "w_ffn_down": nrm(ks[22], (DEPTH, D_FF, D_MODEL), D_FF),
        "g_final": gain(ks[23], (D_MODEL,)),
    }


def reference(x, mem, positions, g_mix, w_in, mla_g_q, mla_g_kv, mla_w_uq, mla_w_uk, mla_w_uv,
              ml_conv_w, ml_w_q, ml_w_k, ml_gate_bias, ml_g_head, mem_g, mem_w_kv,
              w_branch, w_out, g_ffn, w_ffn_gate, w_ffn_up, w_ffn_down, g_final):
    for l in range(DEPTH):
        x = hybrid_layer(x, mem, positions, g_mix[l], w_in[l], mla_g_q[l], mla_g_kv[l],
                         mla_w_uq[l], mla_w_uk[l], mla_w_uv[l], ml_conv_w[l], ml_w_q[l],
                         ml_w_k[l], ml_gate_bias[l], ml_g_head[l], mem_g[l], mem_w_kv[l],
                         w_branch[l], w_out[l], g_ffn[l], w_ffn_gate[l], w_ffn_up[l],
                         w_ffn_down[l])
    return rms_norm(x, g_final)
```

```cpp
#include <hip/hip_runtime.h>
#include <cstdio>
#include <cstdint>

constexpr int BATCH = 32, SEQ = 2048, DM = 1024, M = BATCH * SEQ;
constexpr int MEM_LEN = 256, MMEM = BATCH * MEM_LEN;
constexpr int NIN = 5824, NINP = 5888;
constexpr int DFF = 2816, NGU = 2 * DFF;
constexpr int QR = 384, KVR = 256, ROPE = 32, NOPE = 64, DQK = 96, MLAH = 8, QW = MLAH * DQK;
constexpr int MLW = 512, MLH = 8, MEMW = 512, MEMH = 4, MEMD = 128;
constexpr float EPS = 1e-6f;
constexpr int ZA_KR = 384, ZA_MG = 416;

constexpr size_t MiB = 1u << 20;
constexpr size_t WS_CTL = 0, CTL_ZERO_BYTES = 1 * MiB;
constexpr size_t WS_WIN = 1 * MiB;
constexpr size_t WS_WKVM = 13 * MiB;
constexpr size_t WS_WUQ = 15 * MiB;
constexpr size_t WS_WUKV = 16 * MiB;
constexpr size_t WS_WML = 17 * MiB;
constexpr size_t WS_WBR = 18 * MiB;
constexpr size_t WS_WOUT = 21 * MiB;
constexpr size_t WS_WGU = 23 * MiB;
constexpr size_t WS_WDN = 34 * MiB;
constexpr size_t WS_COS = 40 * MiB;
constexpr size_t WS_SIN = 44 * MiB;
constexpr size_t WS_RSTDX = 48 * MiB;
constexpr size_t WS_RSTDCQ = WS_RSTDX + 256 * 1024, WS_RSTDCKV = WS_RSTDCQ + 256 * 1024;
constexpr size_t WS_SSQ1 = 49 * MiB;
constexpr size_t WS_SSQ2 = 53 * MiB;
constexpr size_t WS_XB = 64 * MiB;
constexpr size_t WS_QKK = WS_XB, WS_OMLA = WS_XB + 64 * MiB, WS_X1B = WS_XB;
constexpr size_t WS_G = 192 * MiB;
constexpr size_t WS_ACT = WS_G;
constexpr size_t WS_ZA = 576 * MiB;
constexpr size_t WS_CKV = 640 * MiB;
constexpr size_t WS_MU = 672 * MiB;
constexpr size_t WS_QKQ = WS_MU;
constexpr size_t WS_MV = 736 * MiB;
constexpr size_t WS_MO = 800 * MiB;
constexpr size_t WS_MEMQ = 864 * MiB;
constexpr size_t WS_MEMKV = 928 * MiB;
constexpr size_t WS_MEMN = 944 * MiB;
constexpr size_t WS_CML = 960 * MiB;
constexpr size_t WS_OML = WS_CML;
constexpr size_t WS_MERGED = WS_ZA;
constexpr size_t WS_END = 1024 * MiB;
static_assert(WS_WIN + (size_t)NINP * DM * 2 <= WS_WKVM && WS_WGU + (size_t)NGU * DM * 2 <= WS_WDN && WS_WDN + (size_t)DM * DFF * 2 <= WS_COS, "weights map");
static_assert(WS_G + (size_t)M * 3072 * 2 == WS_ZA && WS_ACT + (size_t)M * DFF * 2 <= WS_ZA && WS_MERGED + (size_t)M * DM * 2 <= WS_MV && WS_CML + (size_t)M * 512 * 2 == WS_END, "activation map");
constexpr size_t DO_Q = 0, DO_K = 96 * MiB, DO_V = 192 * MiB;

enum { I_X = 0, I_MEM, I_POS, I_GMIX, I_WIN, I_GQ, I_GKV, I_WUQ, I_WUK, I_WUV, I_CONVW, I_WQ, I_WK, I_GBIAS, I_GHEAD, I_MEMG, I_MEMWKV, I_WBR, I_WOUT, I_GFFN, I_WFG, I_WFU, I_WFD, I_GFINAL, N_INPUTS };
struct Params { const float* in[N_INPUTS]; float* out; unsigned char* ws; };
#define GAS __attribute__((address_space(1)))
#define LAS __attribute__((address_space(3)))
typedef unsigned short bf16;
typedef unsigned v4u __attribute__((ext_vector_type(4)));
typedef float f32x4 __attribute__((ext_vector_type(4)));
typedef short bf16x8 __attribute__((ext_vector_type(8)));
typedef GAS unsigned gu32;
typedef GAS unsigned long long gu64;
#define RLX_AGENT __ATOMIC_RELAXED, __HIP_MEMORY_SCOPE_AGENT
#define LDS_WAIT() asm volatile("s_waitcnt lgkmcnt(0)" ::: "memory")
#define VM_WAIT() asm volatile("s_waitcnt vmcnt(0)" ::: "memory")
__device__ __forceinline__ unsigned long long rt() { return __builtin_amdgcn_s_memrealtime(); }
__device__ __forceinline__ unsigned f2bf(float f) { unsigned u = __builtin_bit_cast(unsigned, f); return (u + 0x7fffu + ((u >> 16) & 1u)) >> 16; }
__device__ __forceinline__ unsigned pk2(float lo, float hi) { return f2bf(lo) | (f2bf(hi) << 16); }
#define XB_TMO      128
#define XB_XCNT(j)  (256  + 64 * (j))
#define XB_XSUB(j)  (1280 + 64 * (j))
#define XB_XGEN(j)  (2304 + 64 * (j))
#define XB_TOP      3328
#define XB_TOPGEN   3392
#define XCD_BAR_WORDS 3456
#define XB_SPIN_CAP (1u << 18)

__device__ __forceinline__ unsigned xb_ld(unsigned* p)              { return __hip_atomic_load(p, __ATOMIC_RELAXED, __HIP_MEMORY_SCOPE_AGENT); }
__device__ __forceinline__ unsigned xb_add(unsigned* p, unsigned v) { return __hip_atomic_fetch_add(p, v, __ATOMIC_RELAXED, __HIP_MEMORY_SCOPE_AGENT); }
__device__ __forceinline__ unsigned xb_xcc_id() { return (unsigned)__builtin_amdgcn_s_getreg((3 << 11) | 20) & 0xFu; }
#define XB_SPIN(cond, bar) do { unsigned _sp = 0; while (cond) { __builtin_amdgcn_s_sleep(1); \
    if ((++_sp & 255u) == 0u) { if (xb_ld(&(bar)[XB_TMO])) break; if (_sp > XB_SPIN_CAP) { atomicAdd(&(bar)[XB_TMO], 1u); break; } } } } while (0)

struct XcdBarrier {
    unsigned* bar; unsigned x;
    volatile LAS unsigned* st;
};

__device__ __forceinline__ XcdBarrier xcd_barrier_post(unsigned* bar, volatile LAS unsigned* st) {
    XcdBarrier b; b.bar = bar; b.x = xb_xcc_id(); b.st = st;
    if (threadIdx.x == 0) (void)xb_add(&bar[XB_XCNT(b.x)], 1u);
    return b;
}
__device__ __forceinline__ void xcd_barrier_complete(unsigned* bar, unsigned x, unsigned& nloc, unsigned& nx) {
    const unsigned G = gridDim.x * gridDim.y * gridDim.z;
    unsigned sum, cnt, mine, sp = 0u;
    for (;;) {
        sum = 0u; cnt = 0u; mine = 0u;
#pragma unroll
        for (unsigned j = 0; j < 16; ++j) { const unsigned c = xb_ld(&bar[XB_XCNT(j)]); sum += c; cnt += (c > 0u) ? 1u : 0u; mine = (j == x) ? c : mine; }
        if (sum == G) break;
        __builtin_amdgcn_s_sleep(1);
        if ((++sp & 255u) == 0u) { if (xb_ld(&bar[XB_TMO])) break; if (sp > XB_SPIN_CAP) { atomicAdd(&bar[XB_TMO], 1u); break; } }
    }
    nloc = mine > 0u ? mine : 1u; nx = cnt > 0u ? cnt : 1u;
}

__device__ __forceinline__ void xcd_barrier(const XcdBarrier& b) {
    asm volatile("s_waitcnt vmcnt(0)" ::: "memory");
    __syncthreads();
    if (threadIdx.x == 0) {
        unsigned* bar = b.bar;
        __builtin_amdgcn_s_waitcnt(0);
        unsigned nloc = b.st[0], nx = b.st[1];
        if (nloc == 0u) { xcd_barrier_complete(bar, b.x, nloc, nx); b.st[0] = nloc; b.st[1] = nx; }
        const unsigned old = xb_add(&bar[XB_XSUB(b.x)], 1u);
        const unsigned gen = old / nloc;
        if (old + 1u == (gen + 1u) * nloc) {
            __builtin_amdgcn_fence(__ATOMIC_RELEASE, "agent");
            asm volatile("s_waitcnt vmcnt(0)" ::: "memory");
            const unsigned og = xb_add(&bar[XB_TOP], 1u);
            const unsigned tg = og / nx;
            if (og + 1u == (tg + 1u) * nx) xb_add(&bar[XB_TOPGEN], 1u);
            else XB_SPIN(xb_ld(&bar[XB_TOPGEN]) == tg, bar);
            __builtin_amdgcn_fence(__ATOMIC_ACQUIRE, "agent");
            xb_add(&bar[XB_XGEN(b.x)], 1u);
            asm volatile("s_waitcnt vmcnt(0)" ::: "memory");
        } else {
            XB_SPIN(xb_ld(&bar[XB_XGEN(b.x)]) == gen, bar);
            __builtin_amdgcn_fence(__ATOMIC_ACQUIRE, "agent");
            asm volatile("s_waitcnt vmcnt(0)" ::: "memory");
        }
    }
    __syncthreads();
}
namespace pg8 {
#define PG8_LAS __attribute__((address_space(3)))
typedef unsigned short bf16_t;
typedef short bf16x8 __attribute__((ext_vector_type(8)));
typedef float f32x4 __attribute__((ext_vector_type(4)));
typedef unsigned u32x4 __attribute__((ext_vector_type(4)));
constexpr int BM = 256, BK = 64, HALF = 128, HTB = HALF * BK * 2  , STAGE_BYTES = 8 * HTB, NXCD = 8, WGM = 8;

__host__ __device__ __forceinline__ int lds_byte(int r, int c) { const int st = (r >> 4) * 2 + (c >> 5), rr = r & 15, cc = c & 31, ob = rr * 64 + cc * 2; return st * 1024 + (ob ^ (((ob >> 9) & 1) << 5)); }
__host__ __device__ __forceinline__ void stage_rc(int b, int& R, int& C) { const int st = b / 1024, sb = b % 1024, swz = sb ^ (((sb >> 9) & 1) << 5); R = (st >> 1) * 16 + swz / 64; C = (st & 1) * 32 + (swz % 64) / 2; }
__host__ __device__ __forceinline__ int perm32(int rho) { const int n = rho >> 4, i = rho & 15; return 8 * (i >> 2) + 4 * n + (i & 3); }

struct Unit { int pm, pn; };
struct Gemm { const bf16_t* A; const bf16_t* Bt; int M, N, K, lda, ldb, pad; };

struct StaticOrder {
    int nM, nN, nwg, G, c;
    __host__ __device__ void init(int M, int N, int G_, int c_) { nM = M / BM; nN = N / BM; nwg = nM * nN; G = G_; c = c_; }
    __host__ __device__ bool next(int i, Unit& u) const {
        const long L = (long)i * G + c; if (L >= nwg) return false;
        int wgid = (int)L; { const int q = nwg / NXCD, r = nwg % NXCD, xcd = wgid % NXCD, off = wgid / NXCD; wgid = (xcd < r ? xcd * (q + 1) : r * (q + 1) + (xcd - r) * q) + off; }
        const int nig = WGM * nN, gid = wgid / nig, fm = gid * WGM, gsz = (nM - fm) < WGM ? (nM - fm) : WGM;
        u.pm = fm + ((wgid % nig) % gsz); u.pn = (wgid % nig) / gsz; return true;
    }
    __device__ __forceinline__ void a_ready(const Unit&) const {}
    __device__ __forceinline__ void done(const Unit&) const {}
};

__device__ __forceinline__ unsigned cvt_pk_bf16(float lo, float hi) { unsigned r; asm volatile("v_cvt_pk_bf16_f32 %0, %1, %2" : "=v"(r) : "v"(lo), "v"(hi)); return r; }
typedef float f32x2 __attribute__((ext_vector_type(2)));
template <class Epi, class Sched, bool ALIGN_EPI = false, bool SP2 = false>
__device__ __forceinline__ void gemm_phase(PG8_LAS unsigned char* lds, const Gemm g, const Sched& S, const Epi& E) {
    const int tid = threadIdx.x, wid = __builtin_amdgcn_readfirstlane(tid >> 6), lane = tid & 63, wr = wid >> 2, wc = wid & 3, fr = lane & 15, fq = lane >> 4;
    const int K = g.K, nt = K / BK;
    unsigned voffA[2], voffB[2];
#pragma unroll
    for (int i = 0; i < 2; ++i) { int R, C; stage_rc(tid * 16 + i * 8192, R, C); const int Rb = Epi::PERM ? ((R & ~31) + perm32(R & 31)) : R;
        voffA[i] = (unsigned)(R * g.lda + C) * 2u; voffB[i] = (unsigned)(Rb * g.ldb + C) * 2u; }
    const size_t kstep = (size_t)(BK * 2);
    const size_t hstepA = (size_t)HALF * g.lda * 2, hstepB = (size_t)HALF * g.ldb * 2;
    const size_t tstepA = 2 * hstepA, tstepB = 2 * hstepB;
    const unsigned ldsw = (unsigned)wid * 1024u;
    const int aoff = lds_byte(wr * 64 + fr, fq * 8), boff = lds_byte(wc * 32 + fr, fq * 8);
#define PG8_SA(b, h) (((b) * 2 + (h)) * HTB)
#define PG8_SB(b, h) ((4 + (b) * 2 + (h)) * HTB)
#define PG8_STAGE(bufoff, gbase, voff) do { _Pragma("unroll") for (int _i = 0; _i < 2; ++_i) \
        __builtin_amdgcn_global_load_lds((const unsigned*)((const char*)(gbase) + (voff)[_i]), (PG8_LAS unsigned*)(lds + (bufoff) + ldsw + _i * 8192), 16, 0, 0); } while (0)
#define PG8_LDA(dst, b, h) do { _Pragma("unroll") for (int m = 0; m < 4; ++m) _Pragma("unroll") for (int k = 0; k < 2; ++k) dst[m][k] = *(const PG8_LAS bf16x8*)(lds + PG8_SA(b, h) + aoff + m * 2048 + k * 1024); } while (0)
#define PG8_LDB(dst, b, h) do { _Pragma("unroll") for (int n = 0; n < 2; ++n) _Pragma("unroll") for (int k = 0; k < 2; ++k) dst[n][k] = *(const PG8_LAS bf16x8*)(lds + PG8_SB(b, h) + boff + n * 2048 + k * 1024); } while (0)
#define PG8_MMA(ai, bj, At, Bt) do { __builtin_amdgcn_s_setprio(1); _Pragma("unroll") for (int m = 0; m < 4; ++m) _Pragma("unroll") for (int n = 0; n < 2; ++n) _Pragma("unroll") for (int k = 0; k < 2; ++k) \
        acc[ai][bj][m][n] = __builtin_amdgcn_mfma_f32_16x16x32_bf16(Bt[n][k], At[m][k], acc[ai][bj][m][n], 0, 0, 0); __builtin_amdgcn_s_setprio(0); } while (0)
#define PG8_WAIT_V(n) asm volatile("s_waitcnt vmcnt(" #n ")" ::: "memory")
#define PG8_WAIT_L(n) asm volatile("s_waitcnt lgkmcnt(" #n ")" ::: "memory")
#define PG8_BAR __builtin_amdgcn_s_barrier()
#define PG8_SCHED __builtin_amdgcn_sched_barrier(0)
    Unit cur, nxt; int ui = 0;
    if (!S.next(0, cur)) return;
    f32x4 acc[2][2][4][2];
#pragma unroll
    for (int a = 0; a < 2; ++a)
#pragma unroll
        for (int b = 0; b < 2; ++b)
#pragma unroll
            for (int m = 0; m < 4; ++m)
#pragma unroll
                for (int n = 0; n < 2; ++n) acc[a][b][m][n] = (f32x4){0.f, 0.f, 0.f, 0.f};
    bf16x8 At[4][2], B0[2][2], B1[2][2];
    const char* cA = (const char*)g.A + (size_t)cur.pm * tstepA; const char* cB = (const char*)g.Bt + (size_t)cur.pn * tstepB;
    S.a_ready(cur);
    if constexpr (SP2) {
        PG8_STAGE(PG8_SB(0, 0), cB, voffB); PG8_STAGE(PG8_SB(0, 1), cB + hstepB, voffB); PG8_STAGE(PG8_SA(0, 0), cA, voffA); PG8_STAGE(PG8_SA(0, 1), cA + hstepA, voffA);
        if (wr == 1) PG8_BAR;
        PG8_WAIT_V(2); PG8_BAR;
        PG8_STAGE(PG8_SB(1, 0), cB + kstep, voffB); PG8_STAGE(PG8_SA(1, 0), cA + kstep, voffA); PG8_STAGE(PG8_SB(1, 1), cB + hstepB + kstep, voffB);
        PG8_WAIT_V(6); PG8_BAR;
    } else {
        PG8_STAGE(PG8_SB(0, 0), cB, voffB); PG8_STAGE(PG8_SA(0, 0), cA, voffA); PG8_STAGE(PG8_SB(0, 1), cB + hstepB, voffB); PG8_STAGE(PG8_SA(0, 1), cA + hstepA, voffA);
        if (wr == 1) PG8_BAR;
        PG8_WAIT_V(4); PG8_BAR;
        PG8_STAGE(PG8_SB(1, 0), cB + kstep, voffB); PG8_STAGE(PG8_SA(1, 0), cA + kstep, voffA); PG8_STAGE(PG8_SB(1, 1), cB + hstepB + kstep, voffB);
        PG8_WAIT_V(6); PG8_BAR;
    }
    for (;;) {
        const bool has_next = S.next(ui + 1, nxt);
        const char* nA = has_next ? (const char*)g.A + (size_t)nxt.pm * tstepA : cA; const char* nB = has_next ? (const char*)g.Bt + (size_t)nxt.pn * tstepB : cB;
        for (int t = 0; t < nt; t += 2) {
            const bool last = (t == nt - 2);
            const char* a1 = cA + (size_t)(t + 1) * kstep;
            const char* a2 = last ? nA : cA + (size_t)(t + 2) * kstep; const char* b2 = last ? nB : cB + (size_t)(t + 2) * kstep;
            const char* a3 = a2 + kstep; const char* b3 = b2 + kstep;
            if (last && has_next) S.a_ready(nxt);
            if constexpr (SP2) {
            PG8_LDB(B0, 0, 0); PG8_LDB(B1, 0, 1); PG8_SCHED; PG8_LDA(At, 0, 0); PG8_STAGE(PG8_SA(1, 1), a1 + hstepA, voffA);
            PG8_WAIT_V(8); PG8_WAIT_L(0); PG8_BAR; PG8_MMA(0, 0, At, B0); PG8_MMA(0, 1, At, B1); PG8_BAR; PG8_SCHED;
            PG8_LDA(At, 0, 1); PG8_STAGE(PG8_SB(0, 0), b2, voffB); PG8_STAGE(PG8_SB(0, 1), b2 + hstepB, voffB); PG8_STAGE(PG8_SA(0, 0), a2, voffA);
            PG8_WAIT_V(8); PG8_WAIT_L(0); PG8_BAR; PG8_MMA(1, 0, At, B0); PG8_MMA(1, 1, At, B1); PG8_BAR; PG8_SCHED;
            PG8_LDB(B0, 1, 0); PG8_LDB(B1, 1, 1); PG8_SCHED; PG8_LDA(At, 1, 0); PG8_STAGE(PG8_SA(0, 1), a2 + hstepA, voffA);
            PG8_WAIT_V(8); PG8_WAIT_L(0); PG8_BAR; PG8_MMA(0, 0, At, B0); PG8_MMA(0, 1, At, B1); PG8_BAR; PG8_SCHED;
            PG8_LDA(At, 1, 1); PG8_STAGE(PG8_SB(1, 0), b3, voffB); PG8_STAGE(PG8_SB(1, 1), b3 + hstepB, voffB); PG8_STAGE(PG8_SA(1, 0), a3, voffA);
            PG8_WAIT_V(8); PG8_WAIT_L(0); PG8_BAR; PG8_MMA(1, 0, At, B0); PG8_MMA(1, 1, At, B1); PG8_BAR; PG8_SCHED;
            } else {
            PG8_LDB(B0, 0, 0); PG8_SCHED; PG8_LDA(At, 0, 0); PG8_STAGE(PG8_SA(1, 1), a1 + hstepA, voffA);
            PG8_WAIT_L(8); PG8_BAR; PG8_WAIT_L(0); PG8_MMA(0, 0, At, B0); PG8_BAR; PG8_SCHED;
            PG8_LDB(B1, 0, 1); PG8_STAGE(PG8_SB(0, 0), b2, voffB);
            PG8_BAR; PG8_WAIT_L(0); PG8_MMA(0, 1, At, B1); PG8_BAR;
            PG8_LDA(At, 0, 1); PG8_STAGE(PG8_SA(0, 0), a2, voffA);
            PG8_BAR; PG8_WAIT_L(0); PG8_MMA(1, 0, At, B0); PG8_BAR; PG8_SCHED;
            PG8_STAGE(PG8_SB(0, 1), b2 + hstepB, voffB);
            PG8_WAIT_V(6); PG8_BAR; PG8_MMA(1, 1, At, B1); PG8_BAR;
            PG8_LDB(B0, 1, 0); PG8_SCHED; PG8_LDA(At, 1, 0); PG8_STAGE(PG8_SA(0, 1), a2 + hstepA, voffA);
            PG8_WAIT_L(8); PG8_BAR; PG8_WAIT_L(0); PG8_MMA(0, 0, At, B0); PG8_BAR; PG8_SCHED;
            PG8_LDB(B1, 1, 1); PG8_STAGE(PG8_SB(1, 0), b3, voffB);
            PG8_BAR; PG8_WAIT_L(0); PG8_MMA(0, 1, At, B1); PG8_BAR;
            PG8_LDA(At, 1, 1); PG8_STAGE(PG8_SA(1, 0), a3, voffA);
            PG8_BAR; PG8_WAIT_L(0); PG8_MMA(1, 0, At, B0); PG8_BAR; PG8_SCHED;
            PG8_STAGE(PG8_SB(1, 1), b3 + hstepB, voffB);
            PG8_WAIT_V(6); PG8_BAR; PG8_MMA(1, 1, At, B1); PG8_BAR;
            }
        }
        if constexpr (ALIGN_EPI) { if (wr == 0) PG8_BAR; }
        if constexpr (!Epi::AFTER_DRAIN) { E(acc, cur, wr, wc, fr, fq); S.done(cur); }
        if (!has_next) break;
#pragma unroll
        for (int a = 0; a < 2; ++a)
#pragma unroll
            for (int b = 0; b < 2; ++b)
#pragma unroll
                for (int m = 0; m < 4; ++m)
#pragma unroll
                    for (int n = 0; n < 2; ++n) acc[a][b][m][n] = (f32x4){0.f, 0.f, 0.f, 0.f};
        cur = nxt; cA = nA; cB = nB; ++ui;
        if constexpr (ALIGN_EPI) { if (wr == 1) PG8_BAR; }
    }
    PG8_WAIT_V(0);
    if constexpr (!ALIGN_EPI) { if (wr == 0) PG8_BAR; }
    PG8_BAR;
    if constexpr (Epi::AFTER_DRAIN) { E.fused(acc, cur, wr, wc, fr, fq, lds, wid, lane); S.done(cur); }
#undef PG8_SA
#undef PG8_SB
#undef PG8_STAGE
#undef PG8_LDA
#undef PG8_LDB
#undef PG8_MMA
#undef PG8_WAIT_V
#undef PG8_WAIT_L
#undef PG8_BAR
#undef PG8_SCHED
}
}
typedef unsigned u32x4_t __attribute__((ext_vector_type(4)));
__device__ __forceinline__ float bf2f(unsigned short b) { return __uint_as_float((unsigned)b << 16); }
__device__ __forceinline__ float bflo(unsigned w) { return __uint_as_float(w << 16); }
__device__ __forceinline__ float bfhi(unsigned w) { return __uint_as_float(w & 0xffff0000u); }
__device__ __forceinline__ float sigmoid_f(float x) { return __builtin_amdgcn_rcpf(1.f + __builtin_amdgcn_exp2f(-1.4426950408889634f * x)); }
__device__ __forceinline__ float silu_f(float x) { return x * sigmoid_f(x); }
__device__ __forceinline__ u32x4_t pack8(const pg8::f32x4& a, const pg8::f32x4& b) {
    u32x4_t w; w.x = pg8::cvt_pk_bf16(a[0], a[1]); w.y = pg8::cvt_pk_bf16(a[2], a[3]); w.z = pg8::cvt_pk_bf16(b[0], b[1]); w.w = pg8::cvt_pk_bf16(b[2], b[3]); return w; }
__device__ __forceinline__ void unpack8(const u32x4_t w, pg8::f32x4& a, pg8::f32x4& b) {
    a = (pg8::f32x4){bflo(w.x), bfhi(w.x), bflo(w.y), bfhi(w.y)}; b = (pg8::f32x4){bflo(w.z), bfhi(w.z), bflo(w.w), bfhi(w.w)}; }

#define EPI_ARGS const pg8::f32x4 (&acc)[2][2][4][2], const pg8::Unit& u, int wr, int wc, int fr, int fq
#define EPI_ROWS_BEGIN  _Pragma("unroll") for (int ai = 0; ai < 2; ++ai) _Pragma("unroll") for (int m = 0; m < 4; ++m) { const int row = u.pm * 256 + ai * 128 + wr * 64 + m * 16 + fr;
#define EPI_ROWS_END }

struct EpiWin {
    static constexpr bool PERM = true, AFTER_DRAIN = false;
    unsigned char* ws;
    __device__ __forceinline__ void operator()(EPI_ARGS) const {
        const int pn = u.pn; size_t off; int ldc, cb; bool act = false;
        if (pn < 12) { off = WS_G; ldc = 3072; cb = pn * 256; act = true; }
        else if (pn < 14) { off = WS_ZA; ldc = 512; cb = (pn - 12) * 256; }
        else if (pn < 15) { off = WS_CKV; ldc = 256; cb = 0; }
        else if (pn < 17) { off = WS_MU; ldc = 512; cb = (pn - 15) * 256; }
        else if (pn < 19) { off = WS_MV; ldc = 512; cb = (pn - 17) * 256; }
        else if (pn < 21) { off = WS_MO; ldc = 512; cb = (pn - 19) * 256; act = true; }
        else { off = WS_MEMQ; ldc = 512; cb = (pn - 21) * 256; }
        bf16* base = (bf16*)(ws + off); const float* rstd = (const float*)(ws + WS_RSTDX);
        const int col0 = cb + wc * 32 + 8 * fq;
        EPI_ROWS_BEGIN
            const float rs = rstd[row]; bf16* rowp = base + (size_t)row * ldc + col0;
#pragma unroll
            for (int bj = 0; bj < 2; ++bj) { pg8::f32x4 v0 = acc[ai][bj][m][0] * rs, v1 = acc[ai][bj][m][1] * rs;
                if (act) {
#pragma unroll
                    for (int e = 0; e < 4; ++e) { v0[e] = sigmoid_f(v0[e]); v1[e] = sigmoid_f(v1[e]); } }
                *(u32x4_t*)(rowp + bj * 128) = pack8(v0, v1); }
        EPI_ROWS_END
    }
};
struct EpiPlain {
    static constexpr bool PERM = true, AFTER_DRAIN = false;
    bf16* O0; bf16* O1; int split, ldc;
    __device__ __forceinline__ void operator()(EPI_ARGS) const {
        int c8 = u.pn * 256 + wc * 32 + 8 * fq; bf16* base = O0;
        if (split && c8 >= split) { base = O1; c8 -= split; }
        EPI_ROWS_BEGIN
            bf16* rowp = base + (size_t)row * ldc + c8;
#pragma unroll
            for (int bj = 0; bj < 2; ++bj) *(u32x4_t*)(rowp + bj * 128) = pack8(acc[ai][bj][m][0], acc[ai][bj][m][1]);
        EPI_ROWS_END
    }
};
struct EpiQup {
    static constexpr bool PERM = true, AFTER_DRAIN = false;
    bf16* Q; const float* rstd; const float* cs; const float* sn;
    __device__ __forceinline__ void operator()(EPI_ARGS) const {
        EPI_ROWS_BEGIN
            const float rs = rstd[row];
#pragma unroll
            for (int bj = 0; bj < 2; ++bj) { const int c8 = u.pn * 256 + bj * 128 + wc * 32 + 8 * fq; const int h = c8 / 96, w = c8 - 96 * h;
                pg8::f32x4 v0 = acc[ai][bj][m][0] * rs, v1 = acc[ai][bj][m][1] * rs;
                if (w >= 64) { const int i0 = (w - 64) >> 1; const pg8::f32x4 c = *(const pg8::f32x4*)(cs + (size_t)row * 16 + i0), s = *(const pg8::f32x4*)(sn + (size_t)row * 16 + i0);
                    pg8::f32x4 r0, r1;
                    r0[0] = v0[0] * c[0] - v0[1] * s[0]; r0[1] = v0[0] * s[0] + v0[1] * c[0]; r0[2] = v0[2] * c[1] - v0[3] * s[1]; r0[3] = v0[2] * s[1] + v0[3] * c[1];
                    r1[0] = v1[0] * c[2] - v1[1] * s[2]; r1[1] = v1[0] * s[2] + v1[1] * c[2]; r1[2] = v1[2] * c[3] - v1[3] * s[3]; r1[3] = v1[2] * s[3] + v1[3] * c[3];
                    v0 = r0; v1 = r1; }
                *(u32x4_t*)(Q + (size_t)row * QW + c8) = pack8(v0, v1); }
        EPI_ROWS_END
    }
};
struct EpiKVup {
    static constexpr bool PERM = true, AFTER_DRAIN = false;
    bf16* Kd; bf16* Vd; const float* rstd;
    __device__ __forceinline__ void operator()(EPI_ARGS) const {
        EPI_ROWS_BEGIN
            const float rs = rstd[row];
#pragma unroll
            for (int bj = 0; bj < 2; ++bj) { const int c8 = u.pn * 256 + bj * 128 + wc * 32 + 8 * fq;
                bf16* dst = (c8 < 512) ? Kd + (size_t)row * QW + (c8 >> 6) * 96 + (c8 & 63) : Vd + (size_t)row * 512 + (c8 - 512);
                *(u32x4_t*)dst = pack8(acc[ai][bj][m][0] * rs, acc[ai][bj][m][1] * rs); }
        EPI_ROWS_END
    }
};
struct EpiBranch {
    static constexpr bool PERM = true, AFTER_DRAIN = false;
    const bf16* G; bf16* Mg; int b, pad;
    __device__ __forceinline__ void operator()(EPI_ARGS) const {
        EPI_ROWS_BEGIN
#pragma unroll
            for (int bj = 0; bj < 2; ++bj) { const int c8 = u.pn * 256 + bj * 128 + wc * 32 + 8 * fq;
                pg8::f32x4 g0, g1; unpack8(*(const u32x4_t*)(G + (size_t)row * 3072 + b * 1024 + c8), g0, g1);
                pg8::f32x4 v0 = acc[ai][bj][m][0] * g0, v1 = acc[ai][bj][m][1] * g1; bf16* dst = Mg + (size_t)row * DM + c8;
                if (b > 0) { pg8::f32x4 p0, p1; unpack8(*(const u32x4_t*)dst, p0, p1); v0 += p0; v1 += p1; }
                *(u32x4_t*)dst = pack8(v0, v1); }
        EPI_ROWS_END
    }
};
template <bool WB> struct EpiResid {
    static constexpr bool PERM = true, AFTER_DRAIN = false;
    const float* res; float* xo; bf16* xb; float* ssq;
    __device__ __forceinline__ void operator()(EPI_ARGS) const {
        EPI_ROWS_BEGIN
            float s = 0.f;
#pragma unroll
            for (int bj = 0; bj < 2; ++bj) { const int c8 = u.pn * 256 + bj * 128 + wc * 32 + 8 * fq; const size_t o = (size_t)row * DM + c8;
                const pg8::f32x4 v0 = *(const pg8::f32x4*)(res + o) + acc[ai][bj][m][0], v1 = *(const pg8::f32x4*)(res + o + 4) + acc[ai][bj][m][1];
                *(pg8::f32x4*)(xo + o) = v0; *(pg8::f32x4*)(xo + o + 4) = v1;
                if (WB) *(u32x4_t*)(xb + o) = pack8(v0, v1);
                s += (v0[0] * v0[0] + v0[1] * v0[1]) + (v0[2] * v0[2] + v0[3] * v0[3]) + (v1[0] * v1[0] + v1[1] * v1[1]) + (v1[2] * v1[2] + v1[3] * v1[3]); }
            s += __shfl_xor(s, 16); s += __shfl_xor(s, 32);
            if (fq == 0) ssq[(size_t)row * 16 + u.pn * 4 + wc] = s;
        EPI_ROWS_END
    }
};
__device__ __forceinline__ float rstd_from_ssq(const float* ssq, int row) {
    const pg8::f32x4* p = (const pg8::f32x4*)(ssq + (size_t)row * 16); const pg8::f32x4 a = p[0], b = p[1], c = p[2], d = p[3];
    const float t = ((a[0] + a[1]) + (a[2] + a[3])) + ((b[0] + b[1]) + (b[2] + b[3])) + ((c[0] + c[1]) + (c[2] + c[3])) + ((d[0] + d[1]) + (d[2] + d[3]));
    return 1.0f / sqrtf(t * (1.0f / DM) + EPS);
}
struct EpiFfnUp {
    static constexpr bool PERM = true, AFTER_DRAIN = false;
    bf16* act; const float* ssq;
    __device__ __forceinline__ void operator()(EPI_ARGS) const {
        const int c8 = u.pn * 128 + wc * 32 + 8 * fq;
        EPI_ROWS_BEGIN
            const float rs = rstd_from_ssq(ssq, row);
            pg8::f32x4 g0 = acc[ai][0][m][0] * rs, g1 = acc[ai][0][m][1] * rs; const pg8::f32x4 u0 = acc[ai][1][m][0] * rs, u1 = acc[ai][1][m][1] * rs;
#pragma unroll
            for (int e = 0; e < 4; ++e) { g0[e] = silu_f(g0[e]) * u0[e]; g1[e] = silu_f(g1[e]) * u1[e]; }
            *(u32x4_t*)(act + (size_t)row * DFF + c8) = pack8(g0, g1);
        EPI_ROWS_END
    }
};
typedef float f32x4g __attribute__((ext_vector_type(4)));
__device__ __forceinline__ float wave_sum(float v) {
#pragma unroll
    for (int o = 1; o < 64; o <<= 1) v += __shfl_xor(v, o);
    return v;
}
struct MapWin { __device__ __forceinline__ int operator()(int n) const {
    if (n < 3072) return n;
    if (n < 3584) { const int j = n - 3072; if (j < 384) return 3072 + j; if (j < 416) { const int i = (j - 384) >> 1, pp = (j - 384) & 1; return 3712 + i + 16 * pp; } if (j < 448) return 5280 + (j - 416); return -1; }
    if (n < 3840) return 3456 + (n - 3584);
    if (n < 4352) return 3744 + (n - 3840);
    if (n < 4864) return 4256 + (n - 4352);
    if (n < 5376) return 4768 + (n - 4864);
    return 5312 + (n - 5376); } };
struct MapUq { __device__ __forceinline__ int operator()(int n) const { const int h = n / 96, j = n - 96 * h; if (j < 64) return n; const int i = (j - 64) >> 1, pp = (j - 64) & 1; return h * 96 + 64 + i + 16 * pp; } };
struct MapId { __device__ __forceinline__ int operator()(int n) const { return n; } };
struct RowId { __device__ __forceinline__ int operator()(int n) const { return n; } };
struct RowGU { int up; __device__ __forceinline__ int operator()(int j) const { return (j >> 7) * 256 + (j & 127) + up * 128; } };

template <class SCol, class DRow>
__device__ __forceinline__ void tr_job(const float* src, int ld_src, int K, int NL, bf16* dst, int ldd, const float* rs, const SCol& scol, const DRow& drow, LAS float* scr, int gw, int ngw, int lane) {
    const int nblk = NL / 32, nitems = (K / 64) * nblk;
    for (int it = gw; it < nitems; it += ngw) {
        const int kb = it / nblk, nb = it - kb * nblk, k0 = 64 * kb, n0 = 32 * nb;
        const int sc = scol(n0 + (lane & 31));
#pragma unroll 8
        for (int i = 0; i < 32; ++i) { const int kk = 2 * i + (lane >> 5); float v = 0.f;
            if (sc >= 0) { v = src[(size_t)(k0 + kk) * ld_src + sc]; if (rs) v *= rs[k0 + kk]; }
            scr[kk * 33 + (lane & 31)] = v; }
        LDS_WAIT(); asm volatile("" ::: "memory");
        const int c = lane & 7;
#pragma unroll
        for (int j = 0; j < 4; ++j) { const int n = (lane >> 3) + 8 * j; const LAS float* s = scr + (8 * c) * 33 + n;
            v4u o; o.x = pk2(s[0 * 33], s[1 * 33]); o.y = pk2(s[2 * 33], s[3 * 33]); o.z = pk2(s[4 * 33], s[5 * 33]); o.w = pk2(s[6 * 33], s[7 * 33]);
            *(GAS v4u*)(dst + (size_t)drow(n0 + n) * ldd + k0 + 8 * c) = o; }
        LDS_WAIT(); asm volatile("" ::: "memory");
    }
}
__device__ __forceinline__ double rope_inv(int i) {
    switch (i) {
        case 0: return 1.0; case 1: return 0.5623413251903491; case 2: return 0.31622776601683794; case 3: return 0.17782794100389228;
        case 4: return 0.1; case 5: return 0.05623413251903491; case 6: return 0.03162277660168379; case 7: return 0.01778279410038923;
        case 8: return 0.01; case 9: return 0.005623413251903491; case 10: return 0.0031622776601683794; case 11: return 0.0017782794100389228;
        case 12: return 0.001; case 13: return 0.0005623413251903491; case 14: return 0.00031622776601683794; default: return 0.00017782794100389227; }
}
__device__ __forceinline__ void row_to_bf16(const float* xrow, bf16* orow, float* rstd_out, const float* gain, int lane) {
    const GAS f32x4g* xr = (const GAS f32x4g*)xrow + lane;
    f32x4g v[4]; float s = 0.f;
#pragma unroll
    for (int j = 0; j < 4; ++j) { v[j] = xr[64 * j]; s += (v[j].x * v[j].x + v[j].y * v[j].y) + (v[j].z * v[j].z + v[j].w * v[j].w); }
    const float rstd = 1.f / sqrtf(wave_sum(s) * (1.f / DM) + EPS);
    if (rstd_out && lane == 0) *rstd_out = rstd;
    GAS unsigned long long* o8 = (GAS unsigned long long*)orow + lane;
#pragma unroll
    for (int j = 0; j < 4; ++j) { f32x4g w = v[j];
        if (gain) { const f32x4g g = ((const GAS f32x4g*)gain)[lane + 64 * j]; w = w * rstd * g; }
        o8[64 * j] = (unsigned long long)pk2(w.x, w.y) | ((unsigned long long)pk2(w.z, w.w) << 32); }
}

__device__ __forceinline__ void phase_prologue(const Params& p, LAS unsigned char* lds, int gw, int ngw, int wave, int lane) {
    LAS float* scr = (LAS float*)(lds + wave * 16384);
    unsigned char* ws = p.ws;
    tr_job(p.in[I_WIN], NIN, DM, NINP, (bf16*)(ws + WS_WIN), DM, p.in[I_GMIX], MapWin{}, RowId{}, scr, gw, ngw, lane);
    tr_job(p.in[I_MEMWKV], 1024, DM, 1024, (bf16*)(ws + WS_WKVM), DM, nullptr, MapId{}, RowId{}, scr, gw, ngw, lane);
    tr_job(p.in[I_WUQ], QW, QR, QW, (bf16*)(ws + WS_WUQ), QR, p.in[I_GQ], MapUq{}, RowId{}, scr, gw, ngw, lane);
    tr_job(p.in[I_WUK], 512, KVR, 512, (bf16*)(ws + WS_WUKV), KVR, p.in[I_GKV], MapId{}, RowId{}, scr, gw, ngw, lane);
    tr_job(p.in[I_WUV], 512, KVR, 512, (bf16*)(ws + WS_WUKV) + (size_t)512 * KVR, KVR, p.in[I_GKV], MapId{}, RowId{}, scr, gw, ngw, lane);
    for (int b = 0; b < 3; ++b) tr_job(p.in[I_WBR] + (size_t)b * 512 * DM, DM, 512, DM, (bf16*)(ws + WS_WBR) + (size_t)b * DM * 512, 512, nullptr, MapId{}, RowId{}, scr, gw, ngw, lane);
    tr_job(p.in[I_WOUT], DM, DM, DM, (bf16*)(ws + WS_WOUT), DM, nullptr, MapId{}, RowId{}, scr, gw, ngw, lane);
    tr_job(p.in[I_WFG], DFF, DM, DFF, (bf16*)(ws + WS_WGU), DM, p.in[I_GFFN], MapId{}, RowGU{0}, scr, gw, ngw, lane);
    tr_job(p.in[I_WFU], DFF, DM, DFF, (bf16*)(ws + WS_WGU), DM, p.in[I_GFFN], MapId{}, RowGU{1}, scr, gw, ngw, lane);
    tr_job(p.in[I_WFD], DM, DFF, DM, (bf16*)(ws + WS_WDN), DFF, nullptr, MapId{}, RowId{}, scr, gw, ngw, lane);
    { bf16* W = (bf16*)(ws + WS_WML);
      for (int e = gw * 64 + lane; e < 1024 * 512; e += ngw * 64) { const int n = e >> 9, k = e & 511, part = n >> 9, h = (n >> 6) & 7, d = n & 63; float v = 0.f;
          if ((k >> 6) == h) { const float* w = part ? p.in[I_WK] : p.in[I_WQ]; v = w[(size_t)h * 4096 + (k & 63) * 64 + d]; if (part) v *= 0.125f; }
          W[e] = (bf16)f2bf(v); } }
    for (int m = gw; m < M; m += ngw) row_to_bf16(p.in[I_X] + (size_t)m * DM, (bf16*)(ws + WS_XB) + (size_t)m * DM, (float*)(ws + WS_RSTDX) + m, nullptr, lane);
    for (int m = gw; m < MMEM; m += ngw) row_to_bf16(p.in[I_MEM] + (size_t)m * DM, (bf16*)(ws + WS_MEMN) + (size_t)m * DM, nullptr, p.in[I_MEMG], lane);
    { const int* pos = (const int*)p.in[I_POS]; float* cs = (float*)(ws + WS_COS); float* sn = (float*)(ws + WS_SIN);
      for (int e = gw * 64 + lane; e < M * 16; e += ngw * 64) { const int m = e >> 4, i = e & 15;
          const double rev = (double)pos[m] * rope_inv(i) * 0.15915494309189535; const float fr = (float)(rev - __builtin_rint(rev));
          cs[e] = __builtin_amdgcn_cosf(fr); sn[e] = __builtin_amdgcn_sinf(fr); } }
}

__device__ __forceinline__ void phase_tokprep(const Params& p, int gw, int ngw, int lane) {
    unsigned char* ws = p.ws;
    const bf16* ZA = (const bf16*)(ws + WS_ZA); const bf16* CKV = (const bf16*)(ws + WS_CKV); const bf16* MU = (const bf16*)(ws + WS_MU);
    bf16* Kd = (bf16*)((unsigned char*)p.out + DO_K); bf16* Cml = (bf16*)(ws + WS_CML);
    const float* cs = (const float*)(ws + WS_COS); const float* sn = (const float*)(ws + WS_SIN); const float* cw = p.in[I_CONVW];
    float wv[5][8];
#pragma unroll
    for (int j = 0; j < 5; ++j)
#pragma unroll
        for (int e = 0; e < 8; ++e) wv[j][e] = cw[j * 512 + lane * 8 + e];
    for (int m = gw; m < M; m += ngw) {
        float s1 = 0.f, s2 = 0.f;
        if (lane < 48) { const u32x4_t w = *(const u32x4_t*)(ZA + (size_t)m * 512 + lane * 8);
            const float a0 = bflo(w.x), a1 = bfhi(w.x), a2 = bflo(w.y), a3 = bfhi(w.y), a4 = bflo(w.z), a5 = bfhi(w.z), a6 = bflo(w.w), a7 = bfhi(w.w);
            s1 = (a0 * a0 + a1 * a1) + (a2 * a2 + a3 * a3) + (a4 * a4 + a5 * a5) + (a6 * a6 + a7 * a7); }
        if (lane < 32) { const u32x4_t w = *(const u32x4_t*)(CKV + (size_t)m * 256 + lane * 8);
            const float a0 = bflo(w.x), a1 = bfhi(w.x), a2 = bflo(w.y), a3 = bfhi(w.y), a4 = bflo(w.z), a5 = bfhi(w.z), a6 = bflo(w.w), a7 = bfhi(w.w);
            s2 = (a0 * a0 + a1 * a1) + (a2 * a2 + a3 * a3) + (a4 * a4 + a5 * a5) + (a6 * a6 + a7 * a7); }
        s1 = wave_sum(s1); s2 = wave_sum(s2);
        if (lane == 0) { ((float*)(ws + WS_RSTDCQ))[m] = 1.f / sqrtf(s1 * (1.f / QR) + EPS); ((float*)(ws + WS_RSTDCKV))[m] = 1.f / sqrtf(s2 * (1.f / KVR) + EPS); }
        if (lane < 16) { const unsigned w = *(const unsigned*)(ZA + (size_t)m * 512 + ZA_KR + 2 * lane); const float x1 = bflo(w), x2 = bfhi(w), c = cs[(size_t)m * 16 + lane], s = sn[(size_t)m * 16 + lane];
            const unsigned o = pk2(x1 * c - x2 * s, x1 * s + x2 * c);
#pragma unroll
            for (int h = 0; h < 8; ++h) *(unsigned*)(Kd + (size_t)m * QW + h * 96 + 64 + 2 * lane) = o; }
        const int t = m & (SEQ - 1); float a[8];
#pragma unroll
        for (int e = 0; e < 8; ++e) a[e] = 0.f;
#pragma unroll
        for (int j = 0; j < 5; ++j) { const int tt = t + j - 2;
            if (tt >= 0 && tt < SEQ) { const u32x4_t w = *(const u32x4_t*)(MU + (size_t)(m + j - 2) * 512 + lane * 8);
                a[0] += wv[j][0] * bflo(w.x); a[1] += wv[j][1] * bfhi(w.x); a[2] += wv[j][2] * bflo(w.y); a[3] += wv[j][3] * bfhi(w.y);
                a[4] += wv[j][4] * bflo(w.z); a[5] += wv[j][5] * bfhi(w.z); a[6] += wv[j][6] * bflo(w.w); a[7] += wv[j][7] * bfhi(w.w); } }
        u32x4_t o; o.x = pk2(silu_f(a[0]), silu_f(a[1])); o.y = pk2(silu_f(a[2]), silu_f(a[3])); o.z = pk2(silu_f(a[4]), silu_f(a[5])); o.w = pk2(silu_f(a[6]), silu_f(a[7]));
        *(u32x4_t*)(Cml + (size_t)m * 512 + lane * 8) = o;
    }
}
__device__ __forceinline__ void phase_final(const Params& p, int gw, int ngw, int lane) {
    const float* ssq = (const float*)(p.ws + WS_SSQ2); const float* g = p.in[I_GFINAL];
    f32x4g gv[4];
#pragma unroll
    for (int j = 0; j < 4; ++j) gv[j] = ((const f32x4g*)g)[lane + 64 * j];
    for (int m = gw; m < M; m += ngw) { const float rs = rstd_from_ssq(ssq, m); f32x4g* xr = (f32x4g*)(p.out + (size_t)m * DM) + lane;
#pragma unroll
        for (int j = 0; j < 4; ++j) xr[64 * j] = xr[64 * j] * rs * gv[j]; }
}
template <int TDQK, int TDV>
__global__ __launch_bounds__(256) void naive_attn(const bf16* Q, int ldq, const bf16* K, int ldk, const bf16* V, int ldv, bf16* O, int ldo, int H, int Sq, int Skv, float scale) {
    constexpr int NCH = TDV / 64, ROWS = 256 / NCH;
    __shared__ float Ks[32][TDQK]; __shared__ float Vs[32][TDV];
    const int nqb = Sq / ROWS; int bid = blockIdx.x; const int qb = bid % nqb; bid /= nqb; const int h = bid % H, b = bid / H;
    const int tid = threadIdx.x, r = tid % ROWS, ch = tid / ROWS;
    const size_t qrow = (size_t)b * Sq + (size_t)qb * ROWS + r;
    float q[TDQK];
#pragma unroll
    for (int d = 0; d < TDQK; ++d) q[d] = bf2f(Q[qrow * ldq + h * TDQK + d]) * scale;
    float o[64];
#pragma unroll
    for (int e = 0; e < 64; ++e) o[e] = 0.f;
    float mx = -1e30f, l = 0.f;
    for (int k0 = 0; k0 < Skv; k0 += 32) {
        __syncthreads();
        for (int e = tid; e < 32 * TDQK; e += 256) { const int kk = e / TDQK, d = e % TDQK; Ks[kk][d] = bf2f(K[((size_t)b * Skv + k0 + kk) * ldk + h * TDQK + d]); }
        for (int e = tid; e < 32 * TDV; e += 256) { const int kk = e / TDV, d = e % TDV; Vs[kk][d] = bf2f(V[((size_t)b * Skv + k0 + kk) * ldv + h * TDV + d]); }
        __syncthreads();
        for (int kk = 0; kk < 32; ++kk) {
            float s = 0.f;
#pragma unroll
            for (int d = 0; d < TDQK; ++d) s += q[d] * Ks[kk][d];
            if (s > mx) { const float a = __expf(mx - s); l *= a;
#pragma unroll
                for (int e = 0; e < 64; ++e) o[e] *= a;
                mx = s; }
            const float pr = __expf(s - mx); l += pr;
#pragma unroll
            for (int e = 0; e < 64; ++e) o[e] += pr * Vs[kk][ch * 64 + e];
        }
    }
    const float il = 1.f / l;
#pragma unroll
    for (int e = 0; e < 64; ++e) O[qrow * ldo + h * TDV + ch * 64 + e] = (bf16)f2bf(o[e] * il);
}

constexpr int NML_LDS = (6 * 64 * 65 + 16 * 64) * 4;
__global__ __launch_bounds__(256) void naive_mlstm(const bf16* Qm, const bf16* Km, const bf16* Vm, const bf16* ZA, const float* gate_bias, const bf16* MO, const float* g_head, bf16* Oml) {
    extern __shared__ __attribute__((aligned(16))) float sm[];
    float (*Cs)[65] = (float (*)[65])sm; float (*qs)[65] = (float (*)[65])(sm + 64 * 65); float (*ks)[65] = (float (*)[65])(sm + 2 * 64 * 65);
    float (*vs)[65] = (float (*)[65])(sm + 3 * 64 * 65); float (*Ss)[65] = (float (*)[65])(sm + 4 * 64 * 65); float (*Hs)[65] = (float (*)[65])(sm + 5 * 64 * 65);
    float* vec = sm + 6 * 64 * 65; float *ns = vec, *bs = vec + 64, *is_ = vec + 128, *lfs = vec + 192, *mts = vec + 256, *wis = vec + 320, *wss = vec + 384, *dens = vec + 448, *rn = vec + 512, *scal = vec + 576;
    const int b = blockIdx.x >> 3, h = blockIdx.x & 7, tid = threadIdx.x;
    for (int dir = 0; dir < 2; ++dir) {
        for (int e = tid; e < 4096; e += 256) Cs[e >> 6][e & 63] = 0.f;
        if (tid < 64) ns[tid] = 0.f;
        float mst = -1e30f;
        __syncthreads();
        for (int cc = 0; cc < 32; ++cc) {
            const int c = dir ? 31 - cc : cc;
            for (int e = tid; e < 4096; e += 256) { const int j = e >> 6, d = e & 63; const int t = dir ? c * 64 + 63 - j : c * 64 + j; const size_t o = ((size_t)b * SEQ + t) * 512 + h * 64 + d;
                qs[j][d] = bf2f(Qm[o]); ks[j][d] = bf2f(Km[o]); vs[j][d] = bf2f(Vm[o]); }
            if (tid < 64) { const int j = tid; const int t = dir ? c * 64 + 63 - j : c * 64 + j; const size_t row = (size_t)b * SEQ + t;
                const float ip = bf2f(ZA[row * 512 + ZA_MG + (dir * 2 + 0) * 8 + h]) + gate_bias[(dir * 2 + 0) * 8 + h];
                const float fp = bf2f(ZA[row * 512 + ZA_MG + (dir * 2 + 1) * 8 + h]) + gate_bias[(dir * 2 + 1) * 8 + h];
                is_[j] = ip; lfs[j] = fminf(fp, 0.f) - log1pf(__expf(-fabsf(fp))); }
            __syncthreads();
            if (tid == 0) { float a = 0.f, pm = -1e30f;
                for (int j = 0; j < 64; ++j) { a += lfs[j]; bs[j] = a; pm = fmaxf(pm, is_[j] - a); const float mt = fmaxf(a + mst, a + pm); mts[j] = mt; wis[j] = __expf(a + mst - mt); }
                const float bL = a; float gm = -1e30f;
                for (int s = 0; s < 64; ++s) gm = fmaxf(gm, bL - bs[s] + is_[s]);
                const float mnew = fmaxf(bL + mst, gm); scal[0] = mnew; scal[1] = __expf(bL + mst - mnew);
                for (int s = 0; s < 64; ++s) wss[s] = __expf(bL - bs[s] + is_[s] - mnew); }
            __syncthreads();
            for (int e = tid; e < 4096; e += 256) { const int j = e >> 6, s = e & 63; float v = 0.f;
                if (s <= j) { float dot = 0.f; for (int d = 0; d < 64; ++d) dot += qs[j][d] * ks[s][d]; v = dot * __expf(bs[j] - bs[s] + is_[s] - mts[j]); }
                Ss[j][s] = v; }
            __syncthreads();
            if (tid < 64) { const int j = tid; float sum = 0.f, qn = 0.f; for (int s = 0; s < 64; ++s) sum += Ss[j][s]; for (int d = 0; d < 64; ++d) qn += ns[d] * qs[j][d];
                const float den = sum + wis[j] * qn; dens[j] = fmaxf(fabsf(den), __expf(-mts[j])); }
            __syncthreads();
            for (int e = tid; e < 4096; e += 256) { const int j = e >> 6, ee = e & 63; float a = 0.f, cq = 0.f;
                for (int s = 0; s < 64; ++s) a += Ss[j][s] * vs[s][ee];
                for (int d = 0; d < 64; ++d) cq += Cs[ee][d] * qs[j][d];
                Hs[j][ee] = (a + wis[j] * cq) / dens[j]; }
            __syncthreads();
            if (dir == 0) {
                for (int e = tid; e < 4096; e += 256) { const int j = e >> 6, ee = e & 63; const int t = c * 64 + j; Oml[((size_t)b * SEQ + t) * 512 + h * 64 + ee] = (bf16)f2bf(Hs[j][ee]); }
            } else {
                for (int e = tid; e < 4096; e += 256) { const int j = e >> 6, ee = e & 63; const int t = c * 64 + 63 - j; Hs[j][ee] += bf2f(Oml[((size_t)b * SEQ + t) * 512 + h * 64 + ee]); }
                __syncthreads();
                if (tid < 64) { float ss = 0.f; for (int ee = 0; ee < 64; ++ee) ss += Hs[tid][ee] * Hs[tid][ee]; rn[tid] = 1.f / sqrtf(ss * (1.f / 64.f) + EPS); }
                __syncthreads();
                for (int e = tid; e < 4096; e += 256) { const int j = e >> 6, ee = e & 63; const int t = c * 64 + 63 - j; const size_t o = ((size_t)b * SEQ + t) * 512 + h * 64 + ee;
                    Oml[o] = (bf16)f2bf(Hs[j][ee] * rn[j] * g_head[h * 64 + ee] * bf2f(MO[o])); }
            }
            const float decay = scal[1];
            for (int e = tid; e < 4096; e += 256) { const int ee = e >> 6, d = e & 63; float a = 0.f; for (int s = 0; s < 64; ++s) a += wss[s] * vs[s][ee] * ks[s][d]; Cs[ee][d] = decay * Cs[ee][d] + a; }
            if (tid < 64) { const int d = tid; float a = 0.f; for (int s = 0; s < 64; ++s) a += wss[s] * ks[s][d]; ns[d] = decay * ns[d] + a; }
            mst = scal[0];
            __syncthreads();
        }
    }
}
constexpr int NTHR = 512, GEMM_LDS = pg8::STAGE_BYTES;
template <class Epi> __global__ __launch_bounds__(NTHR, 2) void k_gemm(pg8::Gemm g, Epi E) {
    extern __shared__ __attribute__((aligned(16))) unsigned char lds[];
    pg8::StaticOrder S; S.init(g.M, g.N, (int)gridDim.x, (int)blockIdx.x);
    pg8::gemm_phase<Epi, pg8::StaticOrder, true, true>((LAS unsigned char*)lds, g, S, E);
}
__global__ __launch_bounds__(NTHR, 2) void k_prologue(Params p) {
    extern __shared__ __attribute__((aligned(16))) unsigned char lds[];
    const int wave = __builtin_amdgcn_readfirstlane(threadIdx.x >> 6), lane = threadIdx.x & 63;
    phase_prologue(p, (LAS unsigned char*)lds, blockIdx.x * 8 + wave, gridDim.x * 8, wave, lane);
}
__global__ __launch_bounds__(NTHR, 2) void k_tokprep(Params p) {
    const int wave = __builtin_amdgcn_readfirstlane(threadIdx.x >> 6), lane = threadIdx.x & 63;
    phase_tokprep(p, blockIdx.x * 8 + wave, gridDim.x * 8, lane);
}
__global__ __launch_bounds__(NTHR, 2) void k_final(Params p) {
    const int wave = __builtin_amdgcn_readfirstlane(threadIdx.x >> 6), lane = threadIdx.x & 63;
    phase_final(p, blockIdx.x * 8 + wave, gridDim.x * 8, lane);
}
static pg8::Gemm mk_gemm(const void* A, const void* Bt, int M_, int N_, int K_, int lda, int ldb) { pg8::Gemm g{}; g.A = (const pg8::bf16_t*)A; g.Bt = (const pg8::bf16_t*)Bt; g.M = M_; g.N = N_; g.K = K_; g.lda = lda; g.ldb = ldb; g.pad = 0; return g; }
template <class Epi> static void launch_gemm(const pg8::Gemm& g, const Epi& E, hipStream_t stream) {
    static bool once = false;
    if (!once) { (void)hipFuncSetAttribute((const void*)k_gemm<Epi>, hipFuncAttributeMaxDynamicSharedMemorySize, GEMM_LDS); once = true; }
    hipLaunchKernelGGL(k_gemm<Epi>, dim3(256), dim3(NTHR), GEMM_LDS, stream, g, E);
}
extern "C" void kernel_launch(void* const* d_in, const int* in_sizes, int n_in, void* d_out, int out_size, void* d_ws, size_t ws_size, hipStream_t stream) {
    static int ok = 0;
    if (ok == 0) {
        if (n_in != N_INPUTS || in_sizes[0] != M * DM || out_size != M * DM || ws_size < WS_END) { fprintf(stderr, "kernel_launch: shape/workspace mismatch (n_in %d, ws %zu)\n", n_in, ws_size); ok = -1; return; }
        (void)hipFuncSetAttribute((const void*)k_prologue, hipFuncAttributeMaxDynamicSharedMemorySize, GEMM_LDS);
        (void)hipFuncSetAttribute((const void*)naive_mlstm, hipFuncAttributeMaxDynamicSharedMemorySize, NML_LDS);
        ok = 1;
    }
    if (ok < 0) return;
    unsigned char* ws = (unsigned char*)d_ws; unsigned char* ob = (unsigned char*)d_out;
    Params p{}; for (int i = 0; i < N_INPUTS; ++i) p.in[i] = (const float*)d_in[i]; p.out = (float*)d_out; p.ws = ws;
    (void)hipMemsetAsync(ws + WS_CTL, 0, CTL_ZERO_BYTES, stream);
    hipLaunchKernelGGL(k_prologue, dim3(256), dim3(NTHR), GEMM_LDS, stream, p);
    { EpiWin E{}; E.ws = ws; launch_gemm(mk_gemm(ws + WS_XB, ws + WS_WIN, M, NINP, DM, DM, DM), E, stream); }
    { EpiPlain E{}; E.O0 = (bf16*)(ws + WS_MEMKV); E.O1 = nullptr; E.split = 0; E.ldc = 1024; launch_gemm(mk_gemm(ws + WS_MEMN, ws + WS_WKVM, MMEM, 1024, DM, DM, DM), E, stream); }
    hipLaunchKernelGGL(k_tokprep, dim3(256), dim3(NTHR), 0, stream, p);
    { EpiQup E{}; E.Q = (bf16*)(ob + DO_Q); E.rstd = (const float*)(ws + WS_RSTDCQ); E.cs = (const float*)(ws + WS_COS); E.sn = (const float*)(ws + WS_SIN);
      launch_gemm(mk_gemm(ws + WS_ZA, ws + WS_WUQ, M, QW, QR, 512, QR), E, stream); }
    { EpiKVup E{}; E.Kd = (bf16*)(ob + DO_K); E.Vd = (bf16*)(ob + DO_V); E.rstd = (const float*)(ws + WS_RSTDCKV); launch_gemm(mk_gemm(ws + WS_CKV, ws + WS_WUKV, M, 1024, KVR, KVR, KVR), E, stream); }
    { EpiPlain E{}; E.O0 = (bf16*)(ws + WS_QKQ); E.O1 = (bf16*)(ws + WS_QKK); E.split = 512; E.ldc = 512; launch_gemm(mk_gemm(ws + WS_CML, ws + WS_WML, M, 1024, 512, 512, 512), E, stream); }
    hipLaunchKernelGGL(naive_mlstm, dim3(BATCH * MLH), dim3(256), NML_LDS, stream, (const bf16*)(ws + WS_QKQ), (const bf16*)(ws + WS_QKK), (const bf16*)(ws + WS_MV), (const bf16*)(ws + WS_ZA),
                       p.in[I_GBIAS], (const bf16*)(ws + WS_MO), p.in[I_GHEAD], (bf16*)(ws + WS_OML));
    hipLaunchKernelGGL((naive_attn<96, 64>), dim3(BATCH * MLAH * (SEQ / 256)), dim3(256), 0, stream, (const bf16*)(ob + DO_Q), QW, (const bf16*)(ob + DO_K), QW, (const bf16*)(ob + DO_V), 512,
                       (bf16*)(ws + WS_OMLA), 512, MLAH, SEQ, SEQ, 0.10206207261596575f);
    hipLaunchKernelGGL((naive_attn<128, 128>), dim3(BATCH * MEMH * (SEQ / 128)), dim3(256), 0, stream, (const bf16*)(ws + WS_MEMQ), 512, (const bf16*)(ws + WS_MEMKV), 1024, (const bf16*)(ws + WS_MEMKV) + 512, 1024,
                       (bf16*)(ws + WS_MEMQ), 512, MEMH, SEQ, MEM_LEN, 0.08838834764831845f);
    for (int b = 0; b < 3; ++b) { EpiBranch E{}; E.G = (const bf16*)(ws + WS_G); E.Mg = (bf16*)(ws + WS_MERGED); E.b = b; E.pad = 0;
        const size_t ao = b == 0 ? WS_OMLA : (b == 1 ? WS_OML : WS_MEMQ);
        launch_gemm(mk_gemm(ws + ao, ws + WS_WBR + (size_t)b * DM * 512 * 2, M, DM, 512, 512, 512), E, stream); }
    { EpiResid<true> E{}; E.res = p.in[I_X]; E.xo = (float*)d_out; E.xb = (bf16*)(ws + WS_X1B); E.ssq = (float*)(ws + WS_SSQ1); launch_gemm(mk_gemm(ws + WS_MERGED, ws + WS_WOUT, M, DM, DM, DM, DM), E, stream); }
    { EpiFfnUp E{}; E.act = (bf16*)(ws + WS_ACT); E.ssq = (const float*)(ws + WS_SSQ1); launch_gemm(mk_gemm(ws + WS_X1B, ws + WS_WGU, M, NGU, DM, DM, DM), E, stream); }
    { EpiResid<false> E{}; E.res = (const float*)d_out; E.xo = (float*)d_out; E.xb = nullptr; E.ssq = (float*)(ws + WS_SSQ2); launch_gemm(mk_gemm(ws + WS_ACT, ws + WS_WDN, M, DM, DFF, DFF, DFF), E, stream); }
    hipLaunchKernelGGL(k_final, dim3(256), dim3(NTHR), 0, stream, p);
}
```

```cpp
#include <hip/hip_runtime.h>
#include <cstdio>
#include <cstdint>

constexpr int BATCH = 32, SEQ = 2048, DM = 1024, M = BATCH * SEQ;
constexpr int MEM_LEN = 256, MMEM = BATCH * MEM_LEN;
constexpr int NIN = 5824, NINP = 5888;
constexpr int DFF = 2816, NGU = 2 * DFF;
constexpr int QR = 384, KVR = 256, ROPE = 32, NOPE = 64, DQK = 96, MLAH = 8, QW = MLAH * DQK;
constexpr int MLW = 512, MLH = 8, MEMW = 512, MEMH = 4, MEMD = 128;
constexpr float EPS = 1e-6f;
constexpr int ZA_KR = 384, ZA_MG = 416;

constexpr size_t MiB = 1u << 20;
constexpr size_t WS_CTL = 0, CTL_ZERO_BYTES = 1 * MiB;
constexpr size_t WS_WIN = 1 * MiB;
constexpr size_t WS_WKVM = 13 * MiB;
constexpr size_t WS_WUQ = 15 * MiB;
constexpr size_t WS_WUKV = 16 * MiB;
constexpr size_t WS_WML = 17 * MiB;
constexpr size_t WS_WBR = 18 * MiB;
constexpr size_t WS_WOUT = 21 * MiB;
constexpr size_t WS_WGU = 23 * MiB;
constexpr size_t WS_WDN = 34 * MiB;
constexpr size_t WS_COS = 40 * MiB;
constexpr size_t WS_SIN = 44 * MiB;
constexpr size_t WS_RSTDX = 48 * MiB;
constexpr size_t WS_RSTDCQ = WS_RSTDX + 256 * 1024, WS_RSTDCKV = WS_RSTDCQ + 256 * 1024;
constexpr size_t WS_SSQ1 = 49 * MiB;
constexpr size_t WS_SSQ2 = 53 * MiB;
constexpr size_t WS_XB = 64 * MiB;
constexpr size_t WS_QKK = WS_XB, WS_OMLA = WS_XB + 64 * MiB, WS_X1B = WS_XB;
constexpr size_t WS_G = 192 * MiB;
constexpr size_t WS_ACT = WS_G;
constexpr size_t WS_ZA = 576 * MiB;
constexpr size_t WS_CKV = 640 * MiB;
constexpr size_t WS_MU = 672 * MiB;
constexpr size_t WS_QKQ = WS_MU;
constexpr size_t WS_MV = 736 * MiB;
constexpr size_t WS_MO = 800 * MiB;
constexpr size_t WS_MEMQ = 864 * MiB;
constexpr size_t WS_MEMKV = 928 * MiB;
constexpr size_t WS_MEMN = 944 * MiB;
constexpr size_t WS_CML = 960 * MiB;
constexpr size_t WS_OML = WS_CML;
constexpr size_t WS_MERGED = WS_ZA;
constexpr size_t WS_END = 1024 * MiB;
static_assert(WS_WIN + (size_t)NINP * DM * 2 <= WS_WKVM && WS_WGU + (size_t)NGU * DM * 2 <= WS_WDN && WS_WDN + (size_t)DM * DFF * 2 <= WS_COS, "weights map");
static_assert(WS_G + (size_t)M * 3072 * 2 == WS_ZA && WS_ACT + (size_t)M * DFF * 2 <= WS_ZA && WS_MERGED + (size_t)M * DM * 2 <= WS_MV && WS_CML + (size_t)M * 512 * 2 == WS_END, "activation map");
constexpr size_t DO_Q = 0, DO_K = 96 * MiB, DO_V = 192 * MiB;

enum { I_X = 0, I_MEM, I_POS, I_GMIX, I_WIN, I_GQ, I_GKV, I_WUQ, I_WUK, I_WUV, I_CONVW, I_WQ, I_WK, I_GBIAS, I_GHEAD, I_MEMG, I_MEMWKV, I_WBR, I_WOUT, I_GFFN, I_WFG, I_WFU, I_WFD, I_GFINAL, N_INPUTS };
struct Params { const float* in[N_INPUTS]; float* out; unsigned char* ws; };
#define GAS __attribute__((address_space(1)))
#define LAS __attribute__((address_space(3)))
typedef unsigned short bf16;
typedef unsigned v4u __attribute__((ext_vector_type(4)));
typedef float f32x4 __attribute__((ext_vector_type(4)));
typedef short bf16x8 __attribute__((ext_vector_type(8)));
typedef GAS unsigned gu32;
typedef GAS unsigned long long gu64;
#define RLX_AGENT __ATOMIC_RELAXED, __HIP_MEMORY_SCOPE_AGENT
#define LDS_WAIT() asm volatile("s_waitcnt lgkmcnt(0)" ::: "memory")
#define VM_WAIT() asm volatile("s_waitcnt vmcnt(0)" ::: "memory")
__device__ __forceinline__ unsigned long long rt() { return __builtin_amdgcn_s_memrealtime(); }
__device__ __forceinline__ unsigned f2bf(float f) { unsigned u = __builtin_bit_cast(unsigned, f); return (u + 0x7fffu + ((u >> 16) & 1u)) >> 16; }
__device__ __forceinline__ unsigned pk2(float lo, float hi) { return f2bf(lo) | (f2bf(hi) << 16); }
#define XB_TMO      128
#define XB_XCNT(j)  (256  + 64 * (j))
#define XB_XSUB(j)  (1280 + 64 * (j))
#define XB_XGEN(j)  (2304 + 64 * (j))
#define XB_TOP      3328
#define XB_TOPGEN   3392
#define XCD_BAR_WORDS 3456
#define XB_SPIN_CAP (1u << 18)

__device__ __forceinline__ unsigned xb_ld(unsigned* p)              { return __hip_atomic_load(p, __ATOMIC_RELAXED, __HIP_MEMORY_SCOPE_AGENT); }
__device__ __forceinline__ unsigned xb_add(unsigned* p, unsigned v) { return __hip_atomic_fetch_add(p, v, __ATOMIC_RELAXED, __HIP_MEMORY_SCOPE_AGENT); }
__device__ __forceinline__ unsigned xb_xcc_id() { return (unsigned)__builtin_amdgcn_s_getreg((3 << 11) | 20) & 0xFu; }
#define XB_SPIN(cond, bar) do { unsigned _sp = 0; while (cond) { __builtin_amdgcn_s_sleep(1); \
    if ((++_sp & 255u) == 0u) { if (xb_ld(&(bar)[XB_TMO])) break; if (_sp > XB_SPIN_CAP) { atomicAdd(&(bar)[XB_TMO], 1u); break; } } } } while (0)

struct XcdBarrier {
    unsigned* bar; unsigned x;
    volatile LAS unsigned* st;
};

__device__ __forceinline__ XcdBarrier xcd_barrier_post(unsigned* bar, volatile LAS unsigned* st) {
    XcdBarrier b; b.bar = bar; b.x = xb_xcc_id(); b.st = st;
    if (threadIdx.x == 0) (void)xb_add(&bar[XB_XCNT(b.x)], 1u);
    return b;
}
__device__ __forceinline__ void xcd_barrier_complete(unsigned* bar, unsigned x, unsigned& nloc, unsigned& nx) {
    const unsigned G = gridDim.x * gridDim.y * gridDim.z;
    unsigned sum, cnt, mine, sp = 0u;
    for (;;) {
        sum = 0u; cnt = 0u; mine = 0u;
#pragma unroll
        for (unsigned j = 0; j < 16; ++j) { const unsigned c = xb_ld(&bar[XB_XCNT(j)]); sum += c; cnt += (c > 0u) ? 1u : 0u; mine = (j == x) ? c : mine; }
        if (sum == G) break;
        __builtin_amdgcn_s_sleep(1);
        if ((++sp & 255u) == 0u) { if (xb_ld(&bar[XB_TMO])) break; if (sp > XB_SPIN_CAP) { atomicAdd(&bar[XB_TMO], 1u); break; } }
    }
    nloc = mine > 0u ? mine : 1u; nx = cnt > 0u ? cnt : 1u;
}

__device__ __forceinline__ void xcd_barrier(const XcdBarrier& b) {
    asm volatile("s_waitcnt vmcnt(0)" ::: "memory");
    __syncthreads();
    if (threadIdx.x == 0) {
        unsigned* bar = b.bar;
        __builtin_amdgcn_s_waitcnt(0);
        unsigned nloc = b.st[0], nx = b.st[1];
        if (nloc == 0u) { xcd_barrier_complete(bar, b.x, nloc, nx); b.st[0] = nloc; b.st[1] = nx; }
        const unsigned old = xb_add(&bar[XB_XSUB(b.x)], 1u);
        const unsigned gen = old / nloc;
        if (old + 1u == (gen + 1u) * nloc) {
            __builtin_amdgcn_fence(__ATOMIC_RELEASE, "agent");
            asm volatile("s_waitcnt vmcnt(0)" ::: "memory");
            const unsigned og = xb_add(&bar[XB_TOP], 1u);
            const unsigned tg = og / nx;
            if (og + 1u == (tg + 1u) * nx) xb_add(&bar[XB_TOPGEN], 1u);
            else XB_SPIN(xb_ld(&bar[XB_TOPGEN]) == tg, bar);
            __builtin_amdgcn_fence(__ATOMIC_ACQUIRE, "agent");
            xb_add(&bar[XB_XGEN(b.x)], 1u);
            asm volatile("s_waitcnt vmcnt(0)" ::: "memory");
        } else {
            XB_SPIN(xb_ld(&bar[XB_XGEN(b.x)]) == gen, bar);
            __builtin_amdgcn_fence(__ATOMIC_ACQUIRE, "agent");
            asm volatile("s_waitcnt vmcnt(0)" ::: "memory");
        }
    }
    __syncthreads();
}
namespace pg8 {
#define PG8_LAS __attribute__((address_space(3)))
typedef unsigned short bf16_t;
typedef short bf16x8 __attribute__((ext_vector_type(8)));
typedef float f32x4 __attribute__((ext_vector_type(4)));
typedef unsigned u32x4 __attribute__((ext_vector_type(4)));
constexpr int BM = 256, BK = 64, HALF = 128, HTB = HALF * BK * 2  , STAGE_BYTES = 8 * HTB, NXCD = 8, WGM = 8;

__host__ __device__ __forceinline__ int lds_byte(int r, int c) { const int st = (r >> 4) * 2 + (c >> 5), rr = r & 15, cc = c & 31, ob = rr * 64 + cc * 2; return st * 1024 + (ob ^ (((ob >> 9) & 1) << 5)); }
__host__ __device__ __forceinline__ void stage_rc(int b, int& R, int& C) { const int st = b / 1024, sb = b % 1024, swz = sb ^ (((sb >> 9) & 1) << 5); R = (st >> 1) * 16 + swz / 64; C = (st & 1) * 32 + (swz % 64) / 2; }
__host__ __device__ __forceinline__ int perm32(int rho) { const int n = rho >> 4, i = rho & 15; return 8 * (i >> 2) + 4 * n + (i & 3); }

struct Unit { int pm, pn; };
struct Gemm { const bf16_t* A; const bf16_t* Bt; int M, N, K, lda, ldb, pad; };

struct StaticOrder {
    int nM, nN, nwg, G, c;
    __host__ __device__ void init(int M, int N, int G_, int c_) { nM = M / BM; nN = N / BM; nwg = nM * nN; G = G_; c = c_; }
    __host__ __device__ bool next(int i, Unit& u) const {
        const long L = (long)i * G + c; if (L >= nwg) return false;
        int wgid = (int)L; { const int q = nwg / NXCD, r = nwg % NXCD, xcd = wgid % NXCD, off = wgid / NXCD; wgid = (xcd < r ? xcd * (q + 1) : r * (q + 1) + (xcd - r) * q) + off; }
        const int nig = WGM * nN, gid = wgid / nig, fm = gid * WGM, gsz = (nM - fm) < WGM ? (nM - fm) : WGM;
        u.pm = fm + ((wgid % nig) % gsz); u.pn = (wgid % nig) / gsz; return true;
    }
    __device__ __forceinline__ void a_ready(const Unit&) const {}
    __device__ __forceinline__ void done(const Unit&) const {}
};

__device__ __forceinline__ unsigned cvt_pk_bf16(float lo, float hi) { unsigned r; asm volatile("v_cvt_pk_bf16_f32 %0, %1, %2" : "=v"(r) : "v"(lo), "v"(hi)); return r; }
typedef float f32x2 __attribute__((ext_vector_type(2)));
template <class Epi, class Sched, bool ALIGN_EPI = false, bool SP2 = false>
__device__ __forceinline__ void gemm_phase(PG8_LAS unsigned char* lds, const Gemm g, const Sched& S, const Epi& E) {
    const int tid = threadIdx.x, wid = __builtin_amdgcn_readfirstlane(tid >> 6), lane = tid & 63, wr = wid >> 2, wc = wid & 3, fr = lane & 15, fq = lane >> 4;
    const int K = g.K, nt = K / BK;
    unsigned voffA[2], voffB[2];
#pragma unroll
    for (int i = 0; i < 2; ++i) { int R, C; stage_rc(tid * 16 + i * 8192, R, C); const int Rb = Epi::PERM ? ((R & ~31) + perm32(R & 31)) : R;
        voffA[i] = (unsigned)(R * g.lda + C) * 2u; voffB[i] = (unsigned)(Rb * g.ldb + C) * 2u; }
    const size_t kstep = (size_t)(BK * 2);
    const size_t hstepA = (size_t)HALF * g.lda * 2, hstepB = (size_t)HALF * g.ldb * 2;
    const size_t tstepA = 2 * hstepA, tstepB = 2 * hstepB;
    const unsigned ldsw = (unsigned)wid * 1024u;
    const int aoff = lds_byte(wr * 64 + fr, fq * 8), boff = lds_byte(wc * 32 + fr, fq * 8);
#define PG8_SA(b, h) (((b) * 2 + (h)) * HTB)
#define PG8_SB(b, h) ((4 + (b) * 2 + (h)) * HTB)
#define PG8_STAGE(bufoff, gbase, voff) do { _Pragma("unroll") for (int _i = 0; _i < 2; ++_i) \
        __builtin_amdgcn_global_load_lds((const unsigned*)((const char*)(gbase) + (voff)[_i]), (PG8_LAS unsigned*)(lds + (bufoff) + ldsw + _i * 8192), 16, 0, 0); } while (0)
#define PG8_LDA(dst, b, h) do { _Pragma("unroll") for (int m = 0; m < 4; ++m) _Pragma("unroll") for (int k = 0; k < 2; ++k) dst[m][k] = *(const PG8_LAS bf16x8*)(lds + PG8_SA(b, h) + aoff + m * 2048 + k * 1024); } while (0)
#define PG8_LDB(dst, b, h) do { _Pragma("unroll") for (int n = 0; n < 2; ++n) _Pragma("unroll") for (int k = 0; k < 2; ++k) dst[n][k] = *(const PG8_LAS bf16x8*)(lds + PG8_SB(b, h) + boff + n * 2048 + k * 1024); } while (0)
#define PG8_MMA(ai, bj, At, Bt) do { __builtin_amdgcn_s_setprio(1); _Pragma("unroll") for (int m = 0; m < 4; ++m) _Pragma("unroll") for (int n = 0; n < 2; ++n) _Pragma("unroll") for (int k = 0; k < 2; ++k) \
        acc[ai][bj][m][n] = __builtin_amdgcn_mfma_f32_16x16x32_bf16(Bt[n][k], At[m][k], acc[ai][bj][m][n], 0, 0, 0); __builtin_amdgcn_s_setprio(0); } while (0)
#define PG8_WAIT_V(n) asm volatile("s_waitcnt vmcnt(" #n ")" ::: "memory")
#define PG8_WAIT_L(n) asm volatile("s_waitcnt lgkmcnt(" #n ")" ::: "memory")
#define PG8_BAR __builtin_amdgcn_s_barrier()
#define PG8_SCHED __builtin_amdgcn_sched_barrier(0)
    Unit cur, nxt; int ui = 0;
    if (!S.next(0, cur)) return;
    f32x4 acc[2][2][4][2];
#pragma unroll
    for (int a = 0; a < 2; ++a)
#pragma unroll
        for (int b = 0; b < 2; ++b)
#pragma unroll
            for (int m = 0; m < 4; ++m)
#pragma unroll
                for (int n = 0; n < 2; ++n) acc[a][b][m][n] = (f32x4){0.f, 0.f, 0.f, 0.f};
    bf16x8 At[4][2], B0[2][2], B1[2][2];
    const char* cA = (const char*)g.A + (size_t)cur.pm * tstepA; const char* cB = (const char*)g.Bt + (size_t)cur.pn * tstepB;
    S.a_ready(cur);
    if constexpr (SP2) {
        PG8_STAGE(PG8_SB(0, 0), cB, voffB); PG8_STAGE(PG8_SB(0, 1), cB + hstepB, voffB); PG8_STAGE(PG8_SA(0, 0), cA, voffA); PG8_STAGE(PG8_SA(0, 1), cA + hstepA, voffA);
        if (wr == 1) PG8_BAR;
        PG8_WAIT_V(2); PG8_BAR;
        PG8_STAGE(PG8_SB(1, 0), cB + kstep, voffB); PG8_STAGE(PG8_SA(1, 0), cA + kstep, voffA); PG8_STAGE(PG8_SB(1, 1), cB + hstepB + kstep, voffB);
        PG8_WAIT_V(6); PG8_BAR;
    } else {
        PG8_STAGE(PG8_SB(0, 0), cB, voffB); PG8_STAGE(PG8_SA(0, 0), cA, voffA); PG8_STAGE(PG8_SB(0, 1), cB + hstepB, voffB); PG8_STAGE(PG8_SA(0, 1), cA + hstepA, voffA);
        if (wr == 1) PG8_BAR;
        PG8_WAIT_V(4); PG8_BAR;
        PG8_STAGE(PG8_SB(1, 0), cB + kstep, voffB); PG8_STAGE(PG8_SA(1, 0), cA + kstep, voffA); PG8_STAGE(PG8_SB(1, 1), cB + hstepB + kstep, voffB);
        PG8_WAIT_V(6); PG8_BAR;
    }
    for (;;) {
        const bool has_next = S.next(ui + 1, nxt);
        const char* nA = has_next ? (const char*)g.A + (size_t)nxt.pm * tstepA : cA; const char* nB = has_next ? (const char*)g.Bt + (size_t)nxt.pn * tstepB : cB;
        for (int t = 0; t < nt; t += 2) {
            const bool last = (t == nt - 2);
            const char* a1 = cA + (size_t)(t + 1) * kstep;
            const char* a2 = last ? nA : cA + (size_t)(t + 2) * kstep; const char* b2 = last ? nB : cB + (size_t)(t + 2) * kstep;
            const char* a3 = a2 + kstep; const char* b3 = b2 + kstep;
            if (last && has_next) S.a_ready(nxt);
            if constexpr (SP2) {
            PG8_LDB(B0, 0, 0); PG8_LDB(B1, 0, 1); PG8_SCHED; PG8_LDA(At, 0, 0); PG8_STAGE(PG8_SA(1, 1), a1 + hstepA, voffA);
            PG8_WAIT_V(8); PG8_WAIT_L(0); PG8_BAR; PG8_MMA(0, 0, At, B0); PG8_MMA(0, 1, At, B1); PG8_BAR; PG8_SCHED;
            PG8_LDA(At, 0, 1); PG8_STAGE(PG8_SB(0, 0), b2, voffB); PG8_STAGE(PG8_SB(0, 1), b2 + hstepB, voffB); PG8_STAGE(PG8_SA(0, 0), a2, voffA);
            PG8_WAIT_V(8); PG8_WAIT_L(0); PG8_BAR; PG8_MMA(1, 0, At, B0); PG8_MMA(1, 1, At, B1); PG8_BAR; PG8_SCHED;
            PG8_LDB(B0, 1, 0); PG8_LDB(B1, 1, 1); PG8_SCHED; PG8_LDA(At, 1, 0); PG8_STAGE(PG8_SA(0, 1), a2 + hstepA, voffA);
            PG8_WAIT_V(8); PG8_WAIT_L(0); PG8_BAR; PG8_MMA(0, 0, At, B0); PG8_MMA(0, 1, At, B1); PG8_BAR; PG8_SCHED;
            PG8_LDA(At, 1, 1); PG8_STAGE(PG8_SB(1, 0), b3, voffB); PG8_STAGE(PG8_SB(1, 1), b3 + hstepB, voffB); PG8_STAGE(PG8_SA(1, 0), a3, voffA);
            PG8_WAIT_V(8); PG8_WAIT_L(0); PG8_BAR; PG8_MMA(1, 0, At, B0); PG8_MMA(1, 1, At, B1); PG8_BAR; PG8_SCHED;
            } else {
            PG8_LDB(B0, 0, 0); PG8_SCHED; PG8_LDA(At, 0, 0); PG8_STAGE(PG8_SA(1, 1), a1 + hstepA, voffA);
            PG8_WAIT_L(8); PG8_BAR; PG8_WAIT_L(0); PG8_MMA(0, 0, At, B0); PG8_BAR; PG8_SCHED;
            PG8_LDB(B1, 0, 1); PG8_STAGE(PG8_SB(0, 0), b2, voffB);
            PG8_BAR; PG8_WAIT_L(0); PG8_MMA(0, 1, At, B1); PG8_BAR;
            PG8_LDA(At, 0, 1); PG8_STAGE(PG8_SA(0, 0), a2, voffA);
            PG8_BAR; PG8_WAIT_L(0); PG8_MMA(1, 0, At, B0); PG8_BAR; PG8_SCHED;
            PG8_STAGE(PG8_SB(0, 1), b2 + hstepB, voffB);
            PG8_WAIT_V(6); PG8_BAR; PG8_MMA(1, 1, At, B1); PG8_BAR;
            PG8_LDB(B0, 1, 0); PG8_SCHED; PG8_LDA(At, 1, 0); PG8_STAGE(PG8_SA(0, 1), a2 + hstepA, voffA);
            PG8_WAIT_L(8); PG8_BAR; PG8_WAIT_L(0); PG8_MMA(0, 0, At, B0); PG8_BAR; PG8_SCHED;
            PG8_LDB(B1, 1, 1); PG8_STAGE(PG8_SB(1, 0), b3, voffB);
            PG8_BAR; PG8_WAIT_L(0); PG8_MMA(0, 1, At, B1); PG8_BAR;
            PG8_LDA(At, 1, 1); PG8_STAGE(PG8_SA(1, 0), a3, voffA);
            PG8_BAR; PG8_WAIT_L(0); PG8_MMA(1, 0, At, B0); PG8_BAR; PG8_SCHED;
            PG8_STAGE(PG8_SB(1, 1), b3 + hstepB, voffB);
            PG8_WAIT_V(6); PG8_BAR; PG8_MMA(1, 1, At, B1); PG8_BAR;
            }
        }
        if constexpr (ALIGN_EPI) { if (wr == 0) PG8_BAR; }
        if constexpr (!Epi::AFTER_DRAIN) { E(acc, cur, wr, wc, fr, fq); S.done(cur); }
        if (!has_next) break;
#pragma unroll
        for (int a = 0; a < 2; ++a)
#pragma unroll
            for (int b = 0; b < 2; ++b)
#pragma unroll
                for (int m = 0; m < 4; ++m)
#pragma unroll
                    for (int n = 0; n < 2; ++n) acc[a][b][m][n] = (f32x4){0.f, 0.f, 0.f, 0.f};
        cur = nxt; cA = nA; cB = nB; ++ui;
        if constexpr (ALIGN_EPI) { if (wr == 1) PG8_BAR; }
    }
    PG8_WAIT_V(0);
    if constexpr (!ALIGN_EPI) { if (wr == 0) PG8_BAR; }
    PG8_BAR;
    if constexpr (Epi::AFTER_DRAIN) { E.fused(acc, cur, wr, wc, fr, fq, lds, wid, lane); S.done(cur); }
#undef PG8_SA
#undef PG8_SB
#undef PG8_STAGE
#undef PG8_LDA
#undef PG8_LDB
#undef PG8_MMA
#undef PG8_WAIT_V
#undef PG8_WAIT_L
#undef PG8_BAR
#undef PG8_SCHED
}
}
typedef unsigned u32x4_t __attribute__((ext_vector_type(4)));
__device__ __forceinline__ float bf2f(unsigned short b) { return __uint_as_float((unsigned)b << 16); }
__device__ __forceinline__ float bflo(unsigned w) { return __uint_as_float(w << 16); }
__device__ __forceinline__ float bfhi(unsigned w) { return __uint_as_float(w & 0xffff0000u); }
__device__ __forceinline__ float sigmoid_f(float x) { return __builtin_amdgcn_rcpf(1.f + __builtin_amdgcn_exp2f(-1.4426950408889634f * x)); }
__device__ __forceinline__ float silu_f(float x) { return x * sigmoid_f(x); }
__device__ __forceinline__ u32x4_t pack8(const pg8::f32x4& a, const pg8::f32x4& b) {
    u32x4_t w; w.x = pg8::cvt_pk_bf16(a[0], a[1]); w.y = pg8::cvt_pk_bf16(a[2], a[3]); w.z = pg8::cvt_pk_bf16(b[0], b[1]); w.w = pg8::cvt_pk_bf16(b[2], b[3]); return w; }
__device__ __forceinline__ void unpack8(const u32x4_t w, pg8::f32x4& a, pg8::f32x4& b) {
    a = (pg8::f32x4){bflo(w.x), bfhi(w.x), bflo(w.y), bfhi(w.y)}; b = (pg8::f32x4){bflo(w.z), bfhi(w.z), bflo(w.w), bfhi(w.w)}; }

#define EPI_ARGS const pg8::f32x4 (&acc)[2][2][4][2], const pg8::Unit& u, int wr, int wc, int fr, int fq
#define EPI_ROWS_BEGIN  _Pragma("unroll") for (int ai = 0; ai < 2; ++ai) _Pragma("unroll") for (int m = 0; m < 4; ++m) { const int row = u.pm * 256 + ai * 128 + wr * 64 + m * 16 + fr;
#define EPI_ROWS_END }

struct EpiWin {
    static constexpr bool PERM = true, AFTER_DRAIN = false;
    unsigned char* ws;
    __device__ __forceinline__ void operator()(EPI_ARGS) const {
        const int pn = u.pn; size_t off; int ldc, cb; bool act = false;
        if (pn < 12) { off = WS_G; ldc = 3072; cb = pn * 256; act = true; }
        else if (pn < 14) { off = WS_ZA; ldc = 512; cb = (pn - 12) * 256; }
        else if (pn < 15) { off = WS_CKV; ldc = 256; cb = 0; }
        else if (pn < 17) { off = WS_MU; ldc = 512; cb = (pn - 15) * 256; }
        else if (pn < 19) { off = WS_MV; ldc = 512; cb = (pn - 17) * 256; }
        else if (pn < 21) { off = WS_MO; ldc = 512; cb = (pn - 19) * 256; act = true; }
        else { off = WS_MEMQ; ldc = 512; cb = (pn - 21) * 256; }
        bf16* base = (bf16*)(ws + off); const float* rstd = (const float*)(ws + WS_RSTDX);
        const int col0 = cb + wc * 32 + 8 * fq;
        EPI_ROWS_BEGIN
            const float rs = rstd[row]; bf16* rowp = base + (size_t)row * ldc + col0;
#pragma unroll
            for (int bj = 0; bj < 2; ++bj) { pg8::f32x4 v0 = acc[ai][bj][m][0] * rs, v1 = acc[ai][bj][m][1] * rs;
                if (act) {
#pragma unroll
                    for (int e = 0; e < 4; ++e) { v0[e] = sigmoid_f(v0[e]); v1[e] = sigmoid_f(v1[e]); } }
                *(u32x4_t*)(rowp + bj * 128) = pack8(v0, v1); }
        EPI_ROWS_END
    }
};
struct EpiPlain {
    static constexpr bool PERM = true, AFTER_DRAIN = false;
    bf16* O0; bf16* O1; int split, ldc;
    __device__ __forceinline__ void operator()(EPI_ARGS) const {
        int c8 = u.pn * 256 + wc * 32 + 8 * fq; bf16* base = O0;
        if (split && c8 >= split) { base = O1; c8 -= split; }
        EPI_ROWS_BEGIN
            bf16* rowp = base + (size_t)row * ldc + c8;
#pragma unroll
            for (int bj = 0; bj < 2; ++bj) *(u32x4_t*)(rowp + bj * 128) = pack8(acc[ai][bj][m][0], acc[ai][bj][m][1]);
        EPI_ROWS_END
    }
};
struct EpiQup {
    static constexpr bool PERM = true, AFTER_DRAIN = false;
    bf16* Q; const float* rstd; const float* cs; const float* sn;
    __device__ __forceinline__ void operator()(EPI_ARGS) const {
        EPI_ROWS_BEGIN
            const float rs = rstd[row];
#pragma unroll
            for (int bj = 0; bj < 2; ++bj) { const int c8 = u.pn * 256 + bj * 128 + wc * 32 + 8 * fq; const int h = c8 / 96, w = c8 - 96 * h;
                pg8::f32x4 v0 = acc[ai][bj][m][0] * rs, v1 = acc[ai][bj][m][1] * rs;
                if (w >= 64) { const int i0 = (w - 64) >> 1; const pg8::f32x4 c = *(const pg8::f32x4*)(cs + (size_t)row * 16 + i0), s = *(const pg8::f32x4*)(sn + (size_t)row * 16 + i0);
                    pg8::f32x4 r0, r1;
                    r0[0] = v0[0] * c[0] - v0[1] * s[0]; r0[1] = v0[0] * s[0] + v0[1] * c[0]; r0[2] = v0[2] * c[1] - v0[3] * s[1]; r0[3] = v0[2] * s[1] + v0[3] * c[1];
                    r1[0] = v1[0] * c[2] - v1[1] * s[2]; r1[1] = v1[0] * s[2] + v1[1] * c[2]; r1[2] = v1[2] * c[3] - v1[3] * s[3]; r1[3] = v1[2] * s[3] + v1[3] * c[3];
                    v0 = r0; v1 = r1; }
                *(u32x4_t*)(Q + (size_t)row * QW + c8) = pack8(v0, v1); }
        EPI_ROWS_END
    }
};
struct EpiKVup {
    static constexpr bool PERM = true, AFTER_DRAIN = false;
    bf16* Kd; bf16* Vd; const float* rstd;
    __device__ __forceinline__ void operator()(EPI_ARGS) const {
        EPI_ROWS_BEGIN
            const float rs = rstd[row];
#pragma unroll
            for (int bj = 0; bj < 2; ++bj) { const int c8 = u.pn * 256 + bj * 128 + wc * 32 + 8 * fq;
                bf16* dst = (c8 < 512) ? Kd + (size_t)row * QW + (c8 >> 6) * 96 + (c8 & 63) : Vd + (size_t)row * 512 + (c8 - 512);
                *(u32x4_t*)dst = pack8(acc[ai][bj][m][0] * rs, acc[ai][bj][m][1] * rs); }
        EPI_ROWS_END
    }
};
struct EpiBranch {
    static constexpr bool PERM = true, AFTER_DRAIN = false;
    const bf16* G; bf16* Mg; int b, pad;
    __device__ __forceinline__ void operator()(EPI_ARGS) const {
        EPI_ROWS_BEGIN
#pragma unroll
            for (int bj = 0; bj < 2; ++bj) { const int c8 = u.pn * 256 + bj * 128 + wc * 32 + 8 * fq;
                pg8::f32x4 g0, g1; unpack8(*(const u32x4_t*)(G + (size_t)row * 3072 + b * 1024 + c8), g0, g1);
                pg8::f32x4 v0 = acc[ai][bj][m][0] * g0, v1 = acc[ai][bj][m][1] * g1; bf16* dst = Mg + (size_t)row * DM + c8;
                if (b > 0) { pg8::f32x4 p0, p1; unpack8(*(const u32x4_t*)dst, p0, p1); v0 += p0; v1 += p1; }
                *(u32x4_t*)dst = pack8(v0, v1); }
        EPI_ROWS_END
    }
};
template <bool WB> struct EpiResid {
    static constexpr bool PERM = true, AFTER_DRAIN = false;
    const float* res; float* xo; bf16* xb; float* ssq;
    __device__ __forceinline__ void operator()(EPI_ARGS) const {
        EPI_ROWS_BEGIN
            float s = 0.f;
#pragma unroll
            for (int bj = 0; bj < 2; ++bj) { const int c8 = u.pn * 256 + bj * 128 + wc * 32 + 8 * fq; const size_t o = (size_t)row * DM + c8;
                const pg8::f32x4 v0 = *(const pg8::f32x4*)(res + o) + acc[ai][bj][m][0], v1 = *(const pg8::f32x4*)(res + o + 4) + acc[ai][bj][m][1];
                *(pg8::f32x4*)(xo + o) = v0; *(pg8::f32x4*)(xo + o + 4) = v1;
                if (WB) *(u32x4_t*)(xb + o) = pack8(v0, v1);
                s += (v0[0] * v0[0] + v0[1] * v0[1]) + (v0[2] * v0[2] + v0[3] * v0[3]) + (v1[0] * v1[0] + v1[1] * v1[1]) + (v1[2] * v1[2] + v1[3] * v1[3]); }
            s += __shfl_xor(s, 16); s += __shfl_xor(s, 32);
            if (fq == 0) ssq[(size_t)row * 16 + u.pn * 4 + wc] = s;
        EPI_ROWS_END
    }
};
__device__ __forceinline__ float rstd_from_ssq(const float* ssq, int row) {
    const pg8::f32x4* p = (const pg8::f32x4*)(ssq + (size_t)row * 16); const pg8::f32x4 a = p[0], b = p[1], c = p[2], d = p[3];
    const float t = ((a[0] + a[1]) + (a[2] + a[3])) + ((b[0] + b[1]) + (b[2] + b[3])) + ((c[0] + c[1]) + (c[2] + c[3])) + ((d[0] + d[1]) + (d[2] + d[3]));
    return 1.0f / sqrtf(t * (1.0f / DM) + EPS);
}
struct EpiFfnUp {
    static constexpr bool PERM = true, AFTER_DRAIN = false;
    bf16* act; const float* ssq;
    __device__ __forceinline__ void operator()(EPI_ARGS) const {
        const int c8 = u.pn * 128 + wc * 32 + 8 * fq;
        EPI_ROWS_BEGIN
            const float rs = rstd_from_ssq(ssq, row);
            pg8::f32x4 g0 = acc[ai][0][m][0] * rs, g1 = acc[ai][0][m][1] * rs; const pg8::f32x4 u0 = acc[ai][1][m][0] * rs, u1 = acc[ai][1][m][1] * rs;
#pragma unroll
            for (int e = 0; e < 4; ++e) { g0[e] = silu_f(g0[e]) * u0[e]; g1[e] = silu_f(g1[e]) * u1[e]; }
            *(u32x4_t*)(act + (size_t)row * DFF + c8) = pack8(g0, g1);
        EPI_ROWS_END
    }
};
typedef float f32x4g __attribute__((ext_vector_type(4)));
__device__ __forceinline__ float wave_sum(float v) {
#pragma unroll
    for (int o = 1; o < 64; o <<= 1) v += __shfl_xor(v, o);
    return v;
}
struct MapWin { __device__ __forceinline__ int operator()(int n) const {
    if (n < 3072) return n;
    if (n < 3584) { const int j = n - 3072; if (j < 384) return 3072 + j; if (j < 416) { const int i = (j - 384) >> 1, pp = (j - 384) & 1; return 3712 + i + 16 * pp; } if (j < 448) return 5280 + (j - 416); return -1; }
    if (n < 3840) return 3456 + (n - 3584);
    if (n < 4352) return 3744 + (n - 3840);
    if (n < 4864) return 4256 + (n - 4352);
    if (n < 5376) return 4768 + (n - 4864);
    return 5312 + (n - 5376); } };
struct MapUq { __device__ __forceinline__ int operator()(int n) const { const int h = n / 96, j = n - 96 * h; if (j < 64) return n; const int i = (j - 64) >> 1, pp = (j - 64) & 1; return h * 96 + 64 + i + 16 * pp; } };
struct MapId { __device__ __forceinline__ int operator()(int n) const { return n; } };
struct RowId { __device__ __forceinline__ int operator()(int n) const { return n; } };
struct RowGU { int up; __device__ __forceinline__ int operator()(int j) const { return (j >> 7) * 256 + (j & 127) + up * 128; } };

template <class SCol, class DRow>
__device__ __forceinline__ void tr_job(const float* src, int ld_src, int K, int NL, bf16* dst, int ldd, const float* rs, const SCol& scol, const DRow& drow, LAS float* scr, int gw, int ngw, int lane) {
    const int nblk = NL / 32, nitems = (K / 64) * nblk;
    for (int it = gw; it < nitems; it += ngw) {
        const int kb = it / nblk, nb = it - kb * nblk, k0 = 64 * kb, n0 = 32 * nb;
        const int sc = scol(n0 + (lane & 31));
#pragma unroll 8
        for (int i = 0; i < 32; ++i) { const int kk = 2 * i + (lane >> 5); float v = 0.f;
            if (sc >= 0) { v = src[(size_t)(k0 + kk) * ld_src + sc]; if (rs) v *= rs[k0 + kk]; }
            scr[kk * 33 + (lane & 31)] = v; }
        LDS_WAIT(); asm volatile("" ::: "memory");
        const int c = lane & 7;
#pragma unroll
        for (int j = 0; j < 4; ++j) { const int n = (lane >> 3) + 8 * j; const LAS float* s = scr + (8 * c) * 33 + n;
            v4u o; o.x = pk2(s[0 * 33], s[1 * 33]); o.y = pk2(s[2 * 33], s[3 * 33]); o.z = pk2(s[4 * 33], s[5 * 33]); o.w = pk2(s[6 * 33], s[7 * 33]);
            *(GAS v4u*)(dst + (size_t)drow(n0 + n) * ldd + k0 + 8 * c) = o; }
        LDS_WAIT(); asm volatile("" ::: "memory");
    }
}
__device__ __forceinline__ double rope_inv(int i) {
    switch (i) {
        case 0: return 1.0; case 1: return 0.5623413251903491; case 2: return 0.31622776601683794; case 3: return 0.17782794100389228;
        case 4: return 0.1; case 5: return 0.05623413251903491; case 6: return 0.03162277660168379; case 7: return 0.01778279410038923;
        case 8: return 0.01; case 9: return 0.005623413251903491; case 10: return 0.0031622776601683794; case 11: return 0.0017782794100389228;
        case 12: return 0.001; case 13: return 0.0005623413251903491; case 14: return 0.00031622776601683794; default: return 0.00017782794100389227; }
}
__device__ __forceinline__ void row_to_bf16(const float* xrow, bf16* orow, float* rstd_out, const float* gain, int lane) {
    const GAS f32x4g* xr = (const GAS f32x4g*)xrow + lane;
    f32x4g v[4]; float s = 0.f;
#pragma unroll
    for (int j = 0; j < 4; ++j) { v[j] = xr[64 * j]; s += (v[j].x * v[j].x + v[j].y * v[j].y) + (v[j].z * v[j].z + v[j].w * v[j].w); }
    const float rstd = 1.f / sqrtf(wave_sum(s) * (1.f / DM) + EPS);
    if (rstd_out && lane == 0) *rstd_out = rstd;
    GAS unsigned long long* o8 = (GAS unsigned long long*)orow + lane;
#pragma unroll
    for (int j = 0; j < 4; ++j) { f32x4g w = v[j];
        if (gain) { const f32x4g g = ((const GAS f32x4g*)gain)[lane + 64 * j]; w = w * rstd * g; }
        o8[64 * j] = (unsigned long long)pk2(w.x, w.y) | ((unsigned long long)pk2(w.z, w.w) << 32); }
}

__device__ __forceinline__ void phase_prologue(const Params& p, LAS unsigned char* lds, int gw, int ngw, int wave, int lane) {
    LAS float* scr = (LAS float*)(lds + wave * 16384);
    unsigned char* ws = p.ws;
    tr_job(p.in[I_WIN], NIN, DM, NINP, (bf16*)(ws + WS_WIN), DM, p.in[I_GMIX], MapWin{}, RowId{}, scr, gw, ngw, lane);
    tr_job(p.in[I_MEMWKV], 1024, DM, 1024, (bf16*)(ws + WS_WKVM), DM, nullptr, MapId{}, RowId{}, scr, gw, ngw, lane);
    tr_job(p.in[I_WUQ], QW, QR, QW, (bf16*)(ws + WS_WUQ), QR, p.in[I_GQ], MapUq{}, RowId{}, scr, gw, ngw, lane);
    tr_job(p.in[I_WUK], 512, KVR, 512, (bf16*)(ws + WS_WUKV), KVR, p.in[I_GKV], MapId{}, RowId{}, scr, gw, ngw, lane);
    tr_job(p.in[I_WUV], 512, KVR, 512, (bf16*)(ws + WS_WUKV) + (size_t)512 * KVR, KVR, p.in[I_GKV], MapId{}, RowId{}, scr, gw, ngw, lane);
    for (int b = 0; b < 3; ++b) tr_job(p.in[I_WBR] + (size_t)b * 512 * DM, DM, 512, DM, (bf16*)(ws + WS_WBR) + (size_t)b * DM * 512, 512, nullptr, MapId{}, RowId{}, scr, gw, ngw, lane);
    tr_job(p.in[I_WOUT], DM, DM, DM, (bf16*)(ws + WS_WOUT), DM, nullptr, MapId{}, RowId{}, scr, gw, ngw, lane);
    tr_job(p.in[I_WFG], DFF, DM, DFF, (bf16*)(ws + WS_WGU), DM, p.in[I_GFFN], MapId{}, RowGU{0}, scr, gw, ngw, lane);
    tr_job(p.in[I_WFU], DFF, DM, DFF, (bf16*)(ws + WS_WGU), DM, p.in[I_GFFN], MapId{}, RowGU{1}, scr, gw, ngw, lane);
    tr_job(p.in[I_WFD], DM, DFF, DM, (bf16*)(ws + WS_WDN), DFF, nullptr, MapId{}, RowId{}, scr, gw, ngw, lane);
    { bf16* W = (bf16*)(ws + WS_WML);
      for (int e = gw * 64 + lane; e < 1024 * 512; e += ngw * 64) { const int n = e >> 9, k = e & 511, part = n >> 9, h = (n >> 6) & 7, d = n & 63; float v = 0.f;
          if ((k >> 6) == h) { const float* w = part ? p.in[I_WK] : p.in[I_WQ]; v = w[(size_t)h * 4096 + (k & 63) * 64 + d]; if (part) v *= 0.125f; }
          W[e] = (bf16)f2bf(v); } }
    for (int m = gw; m < M; m += ngw) row_to_bf16(p.in[I_X] + (size_t)m * DM, (bf16*)(ws + WS_XB) + (size_t)m * DM, (float*)(ws + WS_RSTDX) + m, nullptr, lane);
    for (int m = gw; m < MMEM; m += ngw) row_to_bf16(p.in[I_MEM] + (size_t)m * DM, (bf16*)(ws + WS_MEMN) + (size_t)m * DM, nullptr, p.in[I_MEMG], lane);
    { const int* pos = (const int*)p.in[I_POS]; float* cs = (float*)(ws + WS_COS); float* sn = (float*)(ws + WS_SIN);
      for (int e = gw * 64 + lane; e < M * 16; e += ngw * 64) { const int m = e >> 4, i = e & 15;
          const double rev = (double)pos[m] * rope_inv(i) * 0.15915494309189535; const float fr = (float)(rev - __builtin_rint(rev));
          cs[e] = __builtin_amdgcn_cosf(fr); sn[e] = __builtin_amdgcn_sinf(fr); } }
}

__device__ __forceinline__ void phase_tokprep(const Params& p, int gw, int ngw, int lane) {
    unsigned char* ws = p.ws;
    const bf16* ZA = (const bf16*)(ws + WS_ZA); const bf16* CKV = (const bf16*)(ws + WS_CKV); const bf16* MU = (const bf16*)(ws + WS_MU);
    bf16* Kd = (bf16*)((unsigned char*)p.out + DO_K); bf16* Cml = (bf16*)(ws + WS_CML);
    const float* cs = (const float*)(ws + WS_COS); const float* sn = (const float*)(ws + WS_SIN); const float* cw = p.in[I_CONVW];
    float wv[5][8];
#pragma unroll
    for (int j = 0; j < 5; ++j)
#pragma unroll
        for (int e = 0; e < 8; ++e) wv[j][e] = cw[j * 512 + lane * 8 + e];
    for (int m = gw; m < M; m += ngw) {
        float s1 = 0.f, s2 = 0.f;
        if (lane < 48) { const u32x4_t w = *(const u32x4_t*)(ZA + (size_t)m * 512 + lane * 8);
            const float a0 = bflo(w.x), a1 = bfhi(w.x), a2 = bflo(w.y), a3 = bfhi(w.y), a4 = bflo(w.z), a5 = bfhi(w.z), a6 = bflo(w.w), a7 = bfhi(w.w);
            s1 = (a0 * a0 + a1 * a1) + (a2 * a2 + a3 * a3) + (a4 * a4 + a5 * a5) + (a6 * a6 + a7 * a7); }
        if (lane < 32) { const u32x4_t w = *(const u32x4_t*)(CKV + (size_t)m * 256 + lane * 8);
            const float a0 = bflo(w.x), a1 = bfhi(w.x), a2 = bflo(w.y), a3 = bfhi(w.y), a4 = bflo(w.z), a5 = bfhi(w.z), a6 = bflo(w.w), a7 = bfhi(w.w);
            s2 = (a0 * a0 + a1 * a1) + (a2 * a2 + a3 * a3) + (a4 * a4 + a5 * a5) + (a6 * a6 + a7 * a7); }
        s1 = wave_sum(s1); s2 = wave_sum(s2);
        if (lane == 0) { ((float*)(ws + WS_RSTDCQ))[m] = 1.f / sqrtf(s1 * (1.f / QR) + EPS); ((float*)(ws + WS_RSTDCKV))[m] = 1.f / sqrtf(s2 * (1.f / KVR) + EPS); }
        if (lane < 16) { const unsigned w = *(const unsigned*)(ZA + (size_t)m * 512 + ZA_KR + 2 * lane); const float x1 = bflo(w), x2 = bfhi(w), c = cs[(size_t)m * 16 + lane], s = sn[(size_t)m * 16 + lane];
            const unsigned o = pk2(x1 * c - x2 * s, x1 * s + x2 * c);
#pragma unroll
            for (int h = 0; h < 8; ++h) *(unsigned*)(Kd + (size_t)m * QW + h * 96 + 64 + 2 * lane) = o; }
        const int t = m & (SEQ - 1); float a[8];
#pragma unroll
        for (int e = 0; e < 8; ++e) a[e] = 0.f;
#pragma unroll
        for (int j = 0; j < 5; ++j) { const int tt = t + j - 2;
            if (tt >= 0 && tt < SEQ) { const u32x4_t w = *(const u32x4_t*)(MU + (size_t)(m + j - 2) * 512 + lane * 8);
                a[0] += wv[j][0] * bflo(w.x); a[1] += wv[j][1] * bfhi(w.x); a[2] += wv[j][2] * bflo(w.y); a[3] += wv[j][3] * bfhi(w.y);
                a[4] += wv[j][4] * bflo(w.z); a[5] += wv[j][5] * bfhi(w.z); a[6] += wv[j][6] * bflo(w.w); a[7] += wv[j][7] * bfhi(w.w); } }
        u32x4_t o; o.x = pk2(silu_f(a[0]), silu_f(a[1])); o.y = pk2(silu_f(a[2]), silu_f(a[3])); o.z = pk2(silu_f(a[4]), silu_f(a[5])); o.w = pk2(silu_f(a[6]), silu_f(a[7]));
        *(u32x4_t*)(Cml + (size_t)m * 512 + lane * 8) = o;
    }
}
__device__ __forceinline__ void phase_final(const Params& p, int gw, int ngw, int lane) {
    const float* ssq = (const float*)(p.ws + WS_SSQ2); const float* g = p.in[I_GFINAL];
    f32x4g gv[4];
#pragma unroll
    for (int j = 0; j < 4; ++j) gv[j] = ((const f32x4g*)g)[lane + 64 * j];
    for (int m = gw; m < M; m += ngw) { const float rs = rstd_from_ssq(ssq, m); f32x4g* xr = (f32x4g*)(p.out + (size_t)m * DM) + lane;
#pragma unroll
        for (int j = 0; j < 4; ++j) xr[64 * j] = xr[64 * j] * rs * gv[j]; }
}
template <int TDQK, int TDV>
__global__ __launch_bounds__(256) void naive_attn(const bf16* Q, int ldq, const bf16* K, int ldk, const bf16* V, int ldv, bf16* O, int ldo, int H, int Sq, int Skv, float scale) {
    constexpr int NCH = TDV / 64, ROWS = 256 / NCH;
    __shared__ float Ks[32][TDQK]; __shared__ float Vs[32][TDV];
    const int nqb = Sq / ROWS; int bid = blockIdx.x; const int qb = bid % nqb; bid /= nqb; const int h = bid % H, b = bid / H;
    const int tid = threadIdx.x, r = tid % ROWS, ch = tid / ROWS;
    const size_t qrow = (size_t)b * Sq + (size_t)qb * ROWS + r;
    float q[TDQK];
#pragma unroll
    for (int d = 0; d < TDQK; ++d) q[d] = bf2f(Q[qrow * ldq + h * TDQK + d]) * scale;
    float o[64];
#pragma unroll
    for (int e = 0; e < 64; ++e) o[e] = 0.f;
    float mx = -1e30f, l = 0.f;
    for (int k0 = 0; k0 < Skv; k0 += 32) {
        __syncthreads();
        for (int e = tid; e < 32 * TDQK; e += 256) { const int kk = e / TDQK, d = e % TDQK; Ks[kk][d] = bf2f(K[((size_t)b * Skv + k0 + kk) * ldk + h * TDQK + d]); }
        for (int e = tid; e < 32 * TDV; e += 256) { const int kk = e / TDV, d = e % TDV; Vs[kk][d] = bf2f(V[((size_t)b * Skv + k0 + kk) * ldv + h * TDV + d]); }
        __syncthreads();
        for (int kk = 0; kk < 32; ++kk) {
            float s = 0.f;
#pragma unroll
            for (int d = 0; d < TDQK; ++d) s += q[d] * Ks[kk][d];
            if (s > mx) { const float a = __expf(mx - s); l *= a;
#pragma unroll
                for (int e = 0; e < 64; ++e) o[e] *= a;
                mx = s; }
            const float pr = __expf(s - mx); l += pr;
#pragma unroll
            for (int e = 0; e < 64; ++e) o[e] += pr * Vs[kk][ch * 64 + e];
        }
    }
    const float il = 1.f / l;
#pragma unroll
    for (int e = 0; e < 64; ++e) O[qrow * ldo + h * TDV + ch * 64 + e] = (bf16)f2bf(o[e] * il);
}

constexpr int NML_LDS = (6 * 64 * 65 + 16 * 64) * 4;
__global__ __launch_bounds__(256) void naive_mlstm(const bf16* Qm, const bf16* Km, const bf16* Vm, const bf16* ZA, const float* gate_bias, const bf16* MO, const float* g_head, bf16* Oml) {
    extern __shared__ __attribute__((aligned(16))) float sm[];
    float (*Cs)[65] = (float (*)[65])sm; float (*qs)[65] = (float (*)[65])(sm + 64 * 65); float (*ks)[65] = (float (*)[65])(sm + 2 * 64 * 65);
    float (*vs)[65] = (float (*)[65])(sm + 3 * 64 * 65); float (*Ss)[65] = (float (*)[65])(sm + 4 * 64 * 65); float (*Hs)[65] = (float (*)[65])(sm + 5 * 64 * 65);
    float* vec = sm + 6 * 64 * 65; float *ns = vec, *bs = vec + 64, *is_ = vec + 128, *lfs = vec + 192, *mts = vec + 256, *wis = vec + 320, *wss = vec + 384, *dens = vec + 448, *rn = vec + 512, *scal = vec + 576;
    const int b = blockIdx.x >> 3, h = blockIdx.x & 7, tid = threadIdx.x;
    for (int dir = 0; dir < 2; ++dir) {
        for (int e = tid; e < 4096; e += 256) Cs[e >> 6][e & 63] = 0.f;
        if (tid < 64) ns[tid] = 0.f;
        float mst = -1e30f;
        __syncthreads();
        for (int cc = 0; cc < 32; ++cc) {
            const int c = dir ? 31 - cc : cc;
            for (int e = tid; e < 4096; e += 256) { const int j = e >> 6, d = e & 63; const int t = dir ? c * 64 + 63 - j : c * 64 + j; const size_t o = ((size_t)b * SEQ + t) * 512 + h * 64 + d;
                qs[j][d] = bf2f(Qm[o]); ks[j][d] = bf2f(Km[o]); vs[j][d] = bf2f(Vm[o]); }
            if (tid < 64) { const int j = tid; const int t = dir ? c * 64 + 63 - j : c * 64 + j; const size_t row = (size_t)b * SEQ + t;
                const float ip = bf2f(ZA[row * 512 + ZA_MG + (dir * 2 + 0) * 8 + h]) + gate_bias[(dir * 2 + 0) * 8 + h];
                const float fp = bf2f(ZA[row * 512 + ZA_MG + (dir * 2 + 1) * 8 + h]) + gate_bias[(dir * 2 + 1) * 8 + h];
                is_[j] = ip; lfs[j] = fminf(fp, 0.f) - log1pf(__expf(-fabsf(fp))); }
            __syncthreads();
            if (tid == 0) { float a = 0.f, pm = -1e30f;
                for (int j = 0; j < 64; ++j) { a += lfs[j]; bs[j] = a; pm = fmaxf(pm, is_[j] - a); const float mt = fmaxf(a + mst, a + pm); mts[j] = mt; wis[j] = __expf(a + mst - mt); }
                const float bL = a; float gm = -1e30f;
                for (int s = 0; s < 64; ++s) gm = fmaxf(gm, bL - bs[s] + is_[s]);
                const float mnew = fmaxf(bL + mst, gm); scal[0] = mnew; scal[1] = __expf(bL + mst - mnew);
                for (int s = 0; s < 64; ++s) wss[s] = __expf(bL - bs[s] + is_[s] - mnew); }
            __syncthreads();
            for (int e = tid; e < 4096; e += 256) { const int j = e >> 6, s = e & 63; float v = 0.f;
                if (s <= j) { float dot = 0.f; for (int d = 0; d < 64; ++d) dot += qs[j][d] * ks[s][d]; v = dot * __expf(bs[j] - bs[s] + is_[s] - mts[j]); }
                Ss[j][s] = v; }
            __syncthreads();
            if (tid < 64) { const int j = tid; float sum = 0.f, qn = 0.f; for (int s = 0; s < 64; ++s) sum += Ss[j][s]; for (int d = 0; d < 64; ++d) qn += ns[d] * qs[j][d];
                const float den = sum + wis[j] * qn; dens[j] = fmaxf(fabsf(den), __expf(-mts[j])); }
            __syncthreads();
            for (int e = tid; e < 4096; e += 256) { const int j = e >> 6, ee = e & 63; float a = 0.f, cq = 0.f;
                for (int s = 0; s < 64; ++s) a += Ss[j][s] * vs[s][ee];
                for (int d = 0; d < 64; ++d) cq += Cs[ee][d] * qs[j][d];
                Hs[j][ee] = (a + wis[j] * cq) / dens[j]; }
            __syncthreads();
            if (dir == 0) {
                for (int e = tid; e < 4096; e += 256) { const int j = e >> 6, ee = e & 63; const int t = c * 64 + j; Oml[((size_t)b * SEQ + t) * 512 + h * 64 + ee] = (bf16)f2bf(Hs[j][ee]); }
            } else {
                for (int e = tid; e < 4096; e += 256) { const int j = e >> 6, ee = e & 63; const int t = c * 64 + 63 - j; Hs[j][ee] += bf2f(Oml[((size_t)b * SEQ + t) * 512 + h * 64 + ee]); }
                __syncthreads();
                if (tid < 64) { float ss = 0.f; for (int ee = 0; ee < 64; ++ee) ss += Hs[tid][ee] * Hs[tid][ee]; rn[tid] = 1.f / sqrtf(ss * (1.f / 64.f) + EPS); }
                __syncthreads();
                for (int e = tid; e < 4096; e += 256) { const int j = e >> 6, ee = e & 63; const int t = c * 64 + 63 - j; const size_t o = ((size_t)b * SEQ + t) * 512 + h * 64 + ee;
                    Oml[o] = (bf16)f2bf(Hs[j][ee] * rn[j] * g_head[h * 64 + ee] * bf2f(MO[o])); }
            }
            const float decay = scal[1];
            for (int e = tid; e < 4096; e += 256) { const int ee = e >> 6, d = e & 63; float a = 0.f; for (int s = 0; s < 64; ++s) a += wss[s] * vs[s][ee] * ks[s][d]; Cs[ee][d] = decay * Cs[ee][d] + a; }
            if (tid < 64) { const int d = tid; float a = 0.f; for (int s = 0; s < 64; ++s) a += wss[s] * ks[s][d]; ns[d] = decay * ns[d] + a; }
            mst = scal[0];
            __syncthreads();
        }
    }
}
namespace att {
using bf16x8 = __attribute__((ext_vector_type(8))) short;
using s16x4 = __attribute__((ext_vector_type(4))) short;
using f32x16 = __attribute__((ext_vector_type(16))) float;
using u32x4 = __attribute__((ext_vector_type(4))) unsigned;
constexpr int NW = 8, QBLK = 32, KVBLK = 64;
constexpr size_t SHM_V = KVBLK * 128 * 2, SHM_K = KVBLK * 128 * 2, SHM_ATTN = 2 * SHM_V + 2 * SHM_K + NW * 64 * 4;
constexpr float THR = 8.f;
#define KSWZ(row, colB) ((row) * 256 + ((colB) ^ (((row) & 7) << 4)))
#define SBAR() __builtin_amdgcn_sched_barrier(0)
__device__ __forceinline__ int crow(int r, int hi) { return (r & 3) + 8 * (r >> 2) + 4 * hi; }
__device__ __forceinline__ unsigned cvtpk(float lo, float hi) { unsigned r; asm volatile("v_cvt_pk_bf16_f32 %0, %1, %2" : "=v"(r) : "v"(lo), "v"(hi)); return r; }

template <int MODE> struct Cfg;
template <> struct Cfg<0> { static constexpr float SCALE = 0.10206207261596575f; };
template <> struct Cfg<1> { static constexpr float SCALE = 0.08838834764831845f; };

template <int MODE> __device__ __forceinline__ void partialSM(f32x16& p0, f32x16& p1, float& m_reg, float& mn, float& alpha) {
  constexpr float SCALE = Cfg<MODE>::SCALE, C = SCALE * 1.4426950408889634f;
  float pmax = p0[0];
#pragma unroll
  for (int r = 1; r < 16; ++r) pmax = fmaxf(pmax, p0[r]);
#pragma unroll
  for (int r = 0; r < 16; ++r) pmax = fmaxf(pmax, p1[r]);
  { auto rr = __builtin_amdgcn_permlane32_swap(__float_as_uint(pmax), __float_as_uint(pmax), false, false);
    pmax = fmaxf(__uint_as_float(rr[0]), __uint_as_float(rr[1])); }
  if (__builtin_expect(__all(pmax - m_reg <= THR / SCALE), 1)) { mn = m_reg; alpha = 1.f; }
  else { mn = fmaxf(m_reg, pmax); alpha = __builtin_amdgcn_exp2f((m_reg - mn) * C); m_reg = mn; }
  const float mnC = -mn * C;
#pragma unroll
  for (int r = 0; r < 16; ++r) p0[r] = fmaf(p0[r], C, mnC);
#pragma unroll
  for (int r = 0; r < 16; ++r) p1[r] = fmaf(p1[r], C, mnC);
#pragma unroll
  for (int r = 0; r < 16; ++r) p0[r] = __builtin_amdgcn_exp2f(p0[r]);
}
__device__ __forceinline__ void finishSM(f32x16& p0, f32x16& p1, float alpha, float& l_reg, bf16x8& pa0, bf16x8& pa1, bf16x8& pa2, bf16x8& pa3) {
#pragma unroll
  for (int r = 0; r < 16; ++r) p1[r] = __builtin_amdgcn_exp2f(p1[r]);
  float ps = 0;
#pragma unroll
  for (int r = 0; r < 16; ++r) ps += p0[r];
#pragma unroll
  for (int r = 0; r < 16; ++r) ps += p1[r];
  { auto rr = __builtin_amdgcn_permlane32_swap(__float_as_uint(ps), __float_as_uint(ps), false, false);
    ps = __uint_as_float(rr[0]) + __uint_as_float(rr[1]); }
  l_reg = l_reg * alpha + ps;
#define PK4(P, BASE, OUT) do { unsigned a0 = cvtpk(P[BASE + 0], P[BASE + 1]), a1 = cvtpk(P[BASE + 2], P[BASE + 3]);   \
    unsigned b0 = cvtpk(P[BASE + 4], P[BASE + 5]), b1 = cvtpk(P[BASE + 6], P[BASE + 7]);                              \
    auto r0 = __builtin_amdgcn_permlane32_swap(a0, b0, false, false); auto r1 = __builtin_amdgcn_permlane32_swap(a1, b1, false, false); \
    u32x4 w = {r0[0], r1[0], r0[1], r1[1]}; OUT = *reinterpret_cast<bf16x8*>(&w); } while (0)
  PK4(p0, 0, pa0); PK4(p0, 8, pa1); PK4(p1, 0, pa2); PK4(p1, 8, pa3);
#undef PK4
}
template <int ND0> __device__ __forceinline__ void qkt(f32x16& p0, f32x16& p1, const char* Ks, const bf16x8* qr, int r32, int hi) {
  p0 = f32x16{}; p1 = f32x16{};
#pragma unroll
  for (int d0 = 0; d0 < ND0; ++d0) { const int cb = (d0 * 16 + hi * 8) * 2;
    const bf16x8 b0 = *reinterpret_cast<const bf16x8*>(Ks + KSWZ(r32, cb));
    const bf16x8 b1 = *reinterpret_cast<const bf16x8*>(Ks + KSWZ(32 + r32, cb));
    p0 = __builtin_amdgcn_mfma_f32_32x32x16_bf16(b0, qr[d0], p0, 0, 0, 0);
    p1 = __builtin_amdgcn_mfma_f32_32x32x16_bf16(b1, qr[d0], p1, 0, 0, 0); }
}
__device__ __forceinline__ int v_st(int k, int c) { const int kk = (k & ~0xC) | ((k & 4) << 1) | ((k & 8) >> 1); return ((kk >> 3) * 4 + (c >> 5)) * 512 + ((kk & 7) * 32 + (c & 31)) * 2; }
__device__ __forceinline__ int v_rd_base(int lane) { return ((lane & 3) << 3) | (((lane >> 2) & 3) << 6) | (((lane >> 4) & 1) << 5) | (((lane >> 5) & 1) << 8); }
constexpr int v_rd_off(int d0, int ks, int half) { return d0 * 512 + ks * 4096 + half * 2048; }
template <int OFF> __device__ __forceinline__ s16x4 tr_read(int vb) { s16x4 r; asm volatile("ds_read_b64_tr_b16 %0, %1 offset:%2" : "=&v"(r) : "v"(vb), "i"(OFF) : "memory"); return r; }
template <int D0> __device__ __forceinline__ void pv_one(f32x16& od, int vb, bf16x8 pa0, bf16x8 pa1, bf16x8 pa2, bf16x8 pa3) {
  const s16x4 l0 = tr_read<v_rd_off(D0, 0, 0)>(vb), h0 = tr_read<v_rd_off(D0, 0, 1)>(vb), l1 = tr_read<v_rd_off(D0, 1, 0)>(vb), h1 = tr_read<v_rd_off(D0, 1, 1)>(vb);
  const s16x4 l2 = tr_read<v_rd_off(D0, 2, 0)>(vb), h2 = tr_read<v_rd_off(D0, 2, 1)>(vb), l3 = tr_read<v_rd_off(D0, 3, 0)>(vb), h3 = tr_read<v_rd_off(D0, 3, 1)>(vb);
  asm volatile("s_waitcnt lgkmcnt(0)" ::: "memory"); SBAR();
#define PK(L, H) (bf16x8){L[0], L[1], L[2], L[3], H[0], H[1], H[2], H[3]}
  od = __builtin_amdgcn_mfma_f32_32x32x16_bf16(pa0, PK(l0, h0), od, 0, 0, 0);
  od = __builtin_amdgcn_mfma_f32_32x32x16_bf16(pa1, PK(l1, h1), od, 0, 0, 0);
  od = __builtin_amdgcn_mfma_f32_32x32x16_bf16(pa2, PK(l2, h2), od, 0, 0, 0);
  od = __builtin_amdgcn_mfma_f32_32x32x16_bf16(pa3, PK(l3, h3), od, 0, 0, 0);
#undef PK
}
template <int NDV> __device__ __forceinline__ void pv_all(f32x16* o, int vb, bf16x8 pa0, bf16x8 pa1, bf16x8 pa2, bf16x8 pa3) {
  pv_one<0>(o[0], vb, pa0, pa1, pa2, pa3); pv_one<1>(o[1], vb, pa0, pa1, pa2, pa3);
  if constexpr (NDV == 4) { pv_one<2>(o[2], vb, pa0, pa1, pa2, pa3); pv_one<3>(o[3], vb, pa0, pa1, pa2, pa3); }
}

template <int MODE, int ND0, int NDV>
__device__ __forceinline__ void attn_unit(const bf16* Qb, int ldq, const bf16* __restrict__ Kh, int ldk, const bf16* __restrict__ Vh, int ldv, bf16* Ob, int ldo, int seq, char* lds) {
  constexpr float SCALE = Cfg<MODE>::SCALE;
  const int tid = threadIdx.x, wid = tid >> 6, lane = tid & 63, r32 = lane & 31, hi = lane >> 5;
  char* V_lds = lds; char* K_lds = lds + 2 * SHM_V;
  float* wsf = (float*)(lds + 2 * SHM_V + 2 * SHM_K) + wid * 64; float* li_l = wsf; float* al_l = wsf + 32;
  float m_reg = -1e30f, l_reg = 0; f32x16 o[NDV]; bf16x8 qr[ND0];
#pragma unroll
  for (int d = 0; d < NDV; ++d) o[d] = f32x16{};
  const bf16* Qw = Qb + (long)(wid * QBLK + r32) * ldq + hi * 8;
#pragma unroll
  for (int d0 = 0; d0 < ND0; ++d0) qr[d0] = *reinterpret_cast<const bf16x8*>(Qw + d0 * 16);
  const int sr = tid >> 4, sc = (tid & 15) * 8, vst0 = v_st(sr, sc), vst1 = v_st(32 + sr, sc);
  const bool kact = sc < ND0 * 16, vact = sc < NDV * 32;
  const int vb0 = (int)(uintptr_t)V_lds + v_rd_base(lane);
  struct { bf16x8 vs0, vs1, ks0, ks1; } sr_[2];
#define SLOAD(i, k0) do { if (vact) { sr_[i].vs0 = *reinterpret_cast<const bf16x8*>(&Vh[(long)((k0) + sr) * ldv + sc]); sr_[i].vs1 = *reinterpret_cast<const bf16x8*>(&Vh[(long)((k0) + 32 + sr) * ldv + sc]); } \
    if (kact) { sr_[i].ks0 = *reinterpret_cast<const bf16x8*>(&Kh[(long)((k0) + sr) * ldk + sc]); sr_[i].ks1 = *reinterpret_cast<const bf16x8*>(&Kh[(long)((k0) + 32 + sr) * ldk + sc]); } } while (0)
#define SWRITE(b, i) do { if (vact) { *(bf16x8*)(V_lds + (b) * SHM_V + vst0) = sr_[i].vs0; *(bf16x8*)(V_lds + (b) * SHM_V + vst1) = sr_[i].vs1; } \
    if (kact) { const int kc = sc * 2; *(bf16x8*)(K_lds + (b) * SHM_K + KSWZ(sr, kc)) = sr_[i].ks0; *(bf16x8*)(K_lds + (b) * SHM_K + KSWZ(32 + sr, kc)) = sr_[i].ks1; } } while (0)
#define RESC(a) do { if (__any((a) < 1.f)) { if (hi == 0) al_l[r32] = (a); asm volatile("s_waitcnt lgkmcnt(0)" ::: "memory"); \
    _Pragma("unroll") for (int d = 0; d < NDV; ++d) _Pragma("unroll") for (int r = 0; r < 16; ++r) o[d][r] *= al_l[crow(r, hi)]; } } while (0)
  f32x16 pA0, pA1, pB0, pB1; float mnA, mnB, alA, alB; bf16x8 pa0, pa1, pa2, pa3; const int NT = seq / KVBLK;
  SLOAD(0, 0); asm volatile("s_waitcnt vmcnt(0)" ::: "memory"); SWRITE(0, 0); __syncthreads();
  qkt<ND0>(pA0, pA1, K_lds, qr, r32, hi); partialSM<MODE>(pA0, pA1, m_reg, mnA, alA);
  SLOAD(1, KVBLK); if (2 < NT) SLOAD(0, 2 * KVBLK);
  SWRITE(1, 1); __syncthreads();
  for (int j = 1; j + 1 < NT; j += 2) {
    SBAR(); qkt<ND0>(pB0, pB1, K_lds + SHM_K, qr, r32, hi);
    finishSM(pA0, pA1, alA, l_reg, pa0, pa1, pa2, pa3); SBAR();
    SLOAD(1, (j + 2) * KVBLK); SBAR();
    pv_all<NDV>(o, vb0, pa0, pa1, pa2, pa3); partialSM<MODE>(pB0, pB1, m_reg, mnB, alB);
    __syncthreads(); SWRITE(0, 0);
    RESC(alB); __syncthreads();
    SBAR(); qkt<ND0>(pA0, pA1, K_lds, qr, r32, hi);
    finishSM(pB0, pB1, alB, l_reg, pa0, pa1, pa2, pa3); SBAR();
    if (j + 3 < NT) SLOAD(0, (j + 3) * KVBLK); SBAR();
    pv_all<NDV>(o, vb0 + (int)SHM_V, pa0, pa1, pa2, pa3); partialSM<MODE>(pA0, pA1, m_reg, mnA, alA);
    __syncthreads(); SWRITE(1, 1);
    RESC(alA); __syncthreads();
  }
  SBAR(); qkt<ND0>(pB0, pB1, K_lds + SHM_K, qr, r32, hi);
  finishSM(pA0, pA1, alA, l_reg, pa0, pa1, pa2, pa3); SBAR();
  pv_all<NDV>(o, vb0, pa0, pa1, pa2, pa3); partialSM<MODE>(pB0, pB1, m_reg, mnB, alB);
  __syncthreads(); RESC(alB);
  finishSM(pB0, pB1, alB, l_reg, pa0, pa1, pa2, pa3); SBAR();
  pv_all<NDV>(o, vb0 + (int)SHM_V, pa0, pa1, pa2, pa3);
  if (hi == 0) li_l[r32] = l_reg; asm volatile("s_waitcnt lgkmcnt(0)" ::: "memory");
  float rli[16];
#pragma unroll
  for (int r = 0; r < 16; ++r) rli[r] = __builtin_amdgcn_rcpf(li_l[crow(r, hi)]);
  bf16* Ow = Ob + (long)(wid * QBLK) * ldo;
#pragma unroll
  for (int r = 0; r < 16; ++r) { const int orow = crow(r, hi);
#pragma unroll
    for (int d0 = 0; d0 < NDV; ++d0) Ow[(long)orow * ldo + d0 * 32 + r32] = (bf16)f2bf(o[d0][r] * rli[r]); }
  __syncthreads();
#undef SLOAD
#undef SWRITE
#undef RESC
}
#undef KSWZ
#undef SBAR
}

__device__ __forceinline__ void phase_attn_mla(const Params& p, char* lds, int vcu, int G) {
    const bf16* Q = (const bf16*)((const unsigned char*)p.out + DO_Q); const bf16* K = (const bf16*)((const unsigned char*)p.out + DO_K); const bf16* V = (const bf16*)((const unsigned char*)p.out + DO_V);
    bf16* O = (bf16*)(p.ws + WS_OMLA);
    for (int u = vcu; u < BATCH * MLAH * (SEQ / 256); u += G) { const int qb = u & 7, h = (u >> 3) & 7, b = u >> 6; const size_t r0 = (size_t)b * SEQ;
        att::attn_unit<0, 6, 2>(Q + (r0 + qb * 256) * QW + h * 96, QW, K + r0 * QW + h * 96, QW, V + r0 * 512 + h * 64, 512, O + (r0 + qb * 256) * 512 + h * 64, 512, SEQ, lds); }
}
__device__ __forceinline__ void phase_attn_mem(const Params& p, char* lds, int vcu, int G) {
    bf16* Q = (bf16*)(p.ws + WS_MEMQ); const bf16* KV = (const bf16*)(p.ws + WS_MEMKV);
    for (int u = vcu; u < BATCH * MEMH * (SEQ / 256); u += G) { const int qb = u & 7, h = (u >> 3) & 3, b = u >> 5;
        bf16* q = Q + ((size_t)b * SEQ + qb * 256) * 512 + h * 128;
        att::attn_unit<1, 8, 4>(q, 512, KV + (size_t)b * MEM_LEN * 1024 + h * 128, 1024, KV + (size_t)b * MEM_LEN * 1024 + 512 + h * 128, 1024, q, 512, MEM_LEN, lds); }
}
constexpr int NTHR = 512, GEMM_LDS = pg8::STAGE_BYTES;
template <class Epi> __global__ __launch_bounds__(NTHR, 2) void k_gemm(pg8::Gemm g, Epi E) {
    extern __shared__ __attribute__((aligned(16))) unsigned char lds[];
    pg8::StaticOrder S; S.init(g.M, g.N, (int)gridDim.x, (int)blockIdx.x);
    pg8::gemm_phase<Epi, pg8::StaticOrder, true, true>((LAS unsigned char*)lds, g, S, E);
}
__global__ __launch_bounds__(NTHR, 2) void k_prologue(Params p) {
    extern __shared__ __attribute__((aligned(16))) unsigned char lds[];
    const int wave = __builtin_amdgcn_readfirstlane(threadIdx.x >> 6), lane = threadIdx.x & 63;
    phase_prologue(p, (LAS unsigned char*)lds, blockIdx.x * 8 + wave, gridDim.x * 8, wave, lane);
}
__global__ __launch_bounds__(NTHR, 2) void k_tokprep(Params p) {
    const int wave = __builtin_amdgcn_readfirstlane(threadIdx.x >> 6), lane = threadIdx.x & 63;
    phase_tokprep(p, blockIdx.x * 8 + wave, gridDim.x * 8, lane);
}
__global__ __launch_bounds__(NTHR, 2) void k_final(Params p) {
    const int wave = __builtin_amdgcn_readfirstlane(threadIdx.x >> 6), lane = threadIdx.x & 63;
    phase_final(p, blockIdx.x * 8 + wave, gridDim.x * 8, lane);
}
__global__ __launch_bounds__(NTHR, 2) void k_attn_mla(Params p) {
    extern __shared__ __attribute__((aligned(16))) unsigned char lds[];
    const int G = gridDim.x, bx = blockIdx.x, vcu = (G % 8 == 0) ? (bx % 8) * (G / 8) + bx / 8 : bx;
    phase_attn_mla(p, (char*)lds, vcu, G);
}
__global__ __launch_bounds__(NTHR, 2) void k_attn_mem(Params p) {
    extern __shared__ __attribute__((aligned(16))) unsigned char lds[];
    const int G = gridDim.x, bx = blockIdx.x, vcu = (G % 8 == 0) ? (bx % 8) * (G / 8) + bx / 8 : bx;
    phase_attn_mem(p, (char*)lds, vcu, G);
}
static pg8::Gemm mk_gemm(const void* A, const void* Bt, int M_, int N_, int K_, int lda, int ldb) { pg8::Gemm g{}; g.A = (const pg8::bf16_t*)A; g.Bt = (const pg8::bf16_t*)Bt; g.M = M_; g.N = N_; g.K = K_; g.lda = lda; g.ldb = ldb; g.pad = 0; return g; }
template <class Epi> static void launch_gemm(const pg8::Gemm& g, const Epi& E, hipStream_t stream) {
    static bool once = false;
    if (!once) { (void)hipFuncSetAttribute((const void*)k_gemm<Epi>, hipFuncAttributeMaxDynamicSharedMemorySize, GEMM_LDS); once = true; }
    hipLaunchKernelGGL(k_gemm<Epi>, dim3(256), dim3(NTHR), GEMM_LDS, stream, g, E);
}
extern "C" void kernel_launch(void* const* d_in, const int* in_sizes, int n_in, void* d_out, int out_size, void* d_ws, size_t ws_size, hipStream_t stream) {
    static int ok = 0;
    if (ok == 0) {
        if (n_in != N_INPUTS || in_sizes[0] != M * DM || out_size != M * DM || ws_size < WS_END) { fprintf(stderr, "kernel_launch: shape/workspace mismatch (n_in %d, ws %zu)\n", n_in, ws_size); ok = -1; return; }
        (void)hipFuncSetAttribute((const void*)k_prologue, hipFuncAttributeMaxDynamicSharedMemorySize, GEMM_LDS);
        (void)hipFuncSetAttribute((const void*)k_attn_mla, hipFuncAttributeMaxDynamicSharedMemorySize, (int)att::SHM_ATTN);
        (void)hipFuncSetAttribute((const void*)k_attn_mem, hipFuncAttributeMaxDynamicSharedMemorySize, (int)att::SHM_ATTN);
        (void)hipFuncSetAttribute((const void*)naive_mlstm, hipFuncAttributeMaxDynamicSharedMemorySize, NML_LDS);
        ok = 1;
    }
    if (ok < 0) return;
    unsigned char* ws = (unsigned char*)d_ws; unsigned char* ob = (unsigned char*)d_out;
    Params p{}; for (int i = 0; i < N_INPUTS; ++i) p.in[i] = (const float*)d_in[i]; p.out = (float*)d_out; p.ws = ws;
    (void)hipMemsetAsync(ws + WS_CTL, 0, CTL_ZERO_BYTES, stream);
    hipLaunchKernelGGL(k_prologue, dim3(256), dim3(NTHR), GEMM_LDS, stream, p);
    { EpiWin E{}; E.ws = ws; launch_gemm(mk_gemm(ws + WS_XB, ws + WS_WIN, M, NINP, DM, DM, DM), E, stream); }
    { EpiPlain E{}; E.O0 = (bf16*)(ws + WS_MEMKV); E.O1 = nullptr; E.split = 0; E.ldc = 1024; launch_gemm(mk_gemm(ws + WS_MEMN, ws + WS_WKVM, MMEM, 1024, DM, DM, DM), E, stream); }
    hipLaunchKernelGGL(k_tokprep, dim3(256), dim3(NTHR), 0, stream, p);
    { EpiQup E{}; E.Q = (bf16*)(ob + DO_Q); E.rstd = (const float*)(ws + WS_RSTDCQ); E.cs = (const float*)(ws + WS_COS); E.sn = (const float*)(ws + WS_SIN);
      launch_gemm(mk_gemm(ws + WS_ZA, ws + WS_WUQ, M, QW, QR, 512, QR), E, stream); }
    { EpiKVup E{}; E.Kd = (bf16*)(ob + DO_K); E.Vd = (bf16*)(ob + DO_V); E.rstd = (const float*)(ws + WS_RSTDCKV); launch_gemm(mk_gemm(ws + WS_CKV, ws + WS_WUKV, M, 1024, KVR, KVR, KVR), E, stream); }
    { EpiPlain E{}; E.O0 = (bf16*)(ws + WS_QKQ); E.O1 = (bf16*)(ws + WS_QKK); E.split = 512; E.ldc = 512; launch_gemm(mk_gemm(ws + WS_CML, ws + WS_WML, M, 1024, 512, 512, 512), E, stream); }
    hipLaunchKernelGGL(naive_mlstm, dim3(BATCH * MLH), dim3(256), NML_LDS, stream, (const bf16*)(ws + WS_QKQ), (const bf16*)(ws + WS_QKK), (const bf16*)(ws + WS_MV), (const bf16*)(ws + WS_ZA),
                       p.in[I_GBIAS], (const bf16*)(ws + WS_MO), p.in[I_GHEAD], (bf16*)(ws + WS_OML));
    hipLaunchKernelGGL(k_attn_mla, dim3(256), dim3(NTHR), (int)att::SHM_ATTN, stream, p);
    hipLaunchKernelGGL(k_attn_mem, dim3(256), dim3(NTHR), (int)att::SHM_ATTN, stream, p);
    for (int b = 0; b < 3; ++b) { EpiBranch E{}; E.G = (const bf16*)(ws + WS_G); E.Mg = (bf16*)(ws + WS_MERGED); E.b = b; E.pad = 0;
        const size_t ao = b == 0 ? WS_OMLA : (b == 1 ? WS_OML : WS_MEMQ);
        launch_gemm(mk_gemm(ws + ao, ws + WS_WBR + (size_t)b * DM * 512 * 2, M, DM, 512, 512, 512), E, stream); }
    { EpiResid<true> E{}; E.res = p.in[I_X]; E.xo = (float*)d_out; E.xb = (bf16*)(ws + WS_X1B); E.ssq = (float*)(ws + WS_SSQ1); launch_gemm(mk_gemm(ws + WS_MERGED, ws + WS_WOUT, M, DM, DM, DM, DM), E, stream); }
    { EpiFfnUp E{}; E.act = (bf16*)(ws + WS_ACT); E.ssq = (const float*)(ws + WS_SSQ1); launch_gemm(mk_gemm(ws + WS_X1B, ws + WS_WGU, M, NGU, DM, DM, DM), E, stream); }
    { EpiResid<false> E{}; E.res = (const float*)d_out; E.xo = (float*)d_out; E.xb = nullptr; E.ssq = (float*)(ws + WS_SSQ2); launch_gemm(mk_gemm(ws + WS_ACT, ws + WS_WDN, M, DM, DFF, DFF, DFF), E, stream); }
    hipLaunchKernelGGL(k_final, dim3(256), dim3(NTHR), 0, stream, p);
}
```

```cpp
#include <hip/hip_runtime.h>
#include <cstdio>
#include <cstdint>

constexpr int BATCH = 32, SEQ = 2048, DM = 1024, M = BATCH * SEQ;
constexpr int MEM_LEN = 256, MMEM = BATCH * MEM_LEN;
constexpr int NIN = 5824, NINP = 5888;
constexpr int DFF = 2816, NGU = 2 * DFF;
constexpr int QR = 384, KVR = 256, ROPE = 32, NOPE = 64, DQK = 96, MLAH = 8, QW = MLAH * DQK;
constexpr int MLW = 512, MLH = 8, MEMW = 512, MEMH = 4, MEMD = 128;
constexpr float EPS = 1e-6f;
constexpr int ZA_KR = 384, ZA_MG = 416;

constexpr size_t MiB = 1u << 20;
constexpr size_t WS_CTL = 0, CTL_ZERO_BYTES = 1 * MiB;
constexpr size_t WS_WIN = 1 * MiB;
constexpr size_t WS_WKVM = 13 * MiB;
constexpr size_t WS_WUQ = 15 * MiB;
constexpr size_t WS_WUKV = 16 * MiB;
constexpr size_t WS_WML = 17 * MiB;
constexpr size_t WS_WBR = 18 * MiB;
constexpr size_t WS_WOUT = 21 * MiB;
constexpr size_t WS_WGU = 23 * MiB;
constexpr size_t WS_WDN = 34 * MiB;
constexpr size_t WS_COS = 40 * MiB;
constexpr size_t WS_SIN = 44 * MiB;
constexpr size_t WS_RSTDX = 48 * MiB;
constexpr size_t WS_RSTDCQ = WS_RSTDX + 256 * 1024, WS_RSTDCKV = WS_RSTDCQ + 256 * 1024;
constexpr size_t WS_SSQ1 = 49 * MiB;
constexpr size_t WS_SSQ2 = 53 * MiB;
constexpr size_t WS_XB = 64 * MiB;
constexpr size_t WS_QKK = WS_XB, WS_OMLA = WS_XB + 64 * MiB, WS_X1B = WS_XB;
constexpr size_t WS_G = 192 * MiB;
constexpr size_t WS_ACT = WS_G;
constexpr size_t WS_ZA = 576 * MiB;
constexpr size_t WS_CKV = 640 * MiB;
constexpr size_t WS_MU = 672 * MiB;
constexpr size_t WS_QKQ = WS_MU;
constexpr size_t WS_MV = 736 * MiB;
constexpr size_t WS_MO = 800 * MiB;
constexpr size_t WS_MEMQ = 864 * MiB;
constexpr size_t WS_MEMKV = 928 * MiB;
constexpr size_t WS_MEMN = 944 * MiB;
constexpr size_t WS_CML = 960 * MiB;
constexpr size_t WS_OML = WS_CML;
constexpr size_t WS_MERGED = WS_ZA;
constexpr size_t WS_END = 1024 * MiB;
static_assert(WS_WIN + (size_t)NINP * DM * 2 <= WS_WKVM && WS_WGU + (size_t)NGU * DM * 2 <= WS_WDN && WS_WDN + (size_t)DM * DFF * 2 <= WS_COS, "weights map");
static_assert(WS_G + (size_t)M * 3072 * 2 == WS_ZA && WS_ACT + (size_t)M * DFF * 2 <= WS_ZA && WS_MERGED + (size_t)M * DM * 2 <= WS_MV && WS_CML + (size_t)M * 512 * 2 == WS_END, "activation map");
constexpr size_t DO_Q = 0, DO_K = 96 * MiB, DO_V = 192 * MiB;

enum { I_X = 0, I_MEM, I_POS, I_GMIX, I_WIN, I_GQ, I_GKV, I_WUQ, I_WUK, I_WUV, I_CONVW, I_WQ, I_WK, I_GBIAS, I_GHEAD, I_MEMG, I_MEMWKV, I_WBR, I_WOUT, I_GFFN, I_WFG, I_WFU, I_WFD, I_GFINAL, N_INPUTS };
struct Params { const float* in[N_INPUTS]; float* out; unsigned char* ws; };
#define GAS __attribute__((address_space(1)))
#define LAS __attribute__((address_space(3)))
typedef unsigned short bf16;
typedef unsigned v4u __attribute__((ext_vector_type(4)));
typedef float f32x4 __attribute__((ext_vector_type(4)));
typedef short bf16x8 __attribute__((ext_vector_type(8)));
typedef GAS unsigned gu32;
typedef GAS unsigned long long gu64;
#define RLX_AGENT __ATOMIC_RELAXED, __HIP_MEMORY_SCOPE_AGENT
#define LDS_WAIT() asm volatile("s_waitcnt lgkmcnt(0)" ::: "memory")
#define VM_WAIT() asm volatile("s_waitcnt vmcnt(0)" ::: "memory")
__device__ __forceinline__ unsigned long long rt() { return __builtin_amdgcn_s_memrealtime(); }
__device__ __forceinline__ unsigned f2bf(float f) { unsigned u = __builtin_bit_cast(unsigned, f); return (u + 0x7fffu + ((u >> 16) & 1u)) >> 16; }
__device__ __forceinline__ unsigned pk2(float lo, float hi) { return f2bf(lo) | (f2bf(hi) << 16); }
#define XB_TMO      128
#define XB_XCNT(j)  (256  + 64 * (j))
#define XB_XSUB(j)  (1280 + 64 * (j))
#define XB_XGEN(j)  (2304 + 64 * (j))
#define XB_TOP      3328
#define XB_TOPGEN   3392
#define XCD_BAR_WORDS 3456
#define XB_SPIN_CAP (1u << 18)

__device__ __forceinline__ unsigned xb_ld(unsigned* p)              { return __hip_atomic_load(p, __ATOMIC_RELAXED, __HIP_MEMORY_SCOPE_AGENT); }
__device__ __forceinline__ unsigned xb_add(unsigned* p, unsigned v) { return __hip_atomic_fetch_add(p, v, __ATOMIC_RELAXED, __HIP_MEMORY_SCOPE_AGENT); }
__device__ __forceinline__ unsigned xb_xcc_id() { return (unsigned)__builtin_amdgcn_s_getreg((3 << 11) | 20) & 0xFu; }
#define XB_SPIN(cond, bar) do { unsigned _sp = 0; while (cond) { __builtin_amdgcn_s_sleep(1); \
    if ((++_sp & 255u) == 0u) { if (xb_ld(&(bar)[XB_TMO])) break; if (_sp > XB_SPIN_CAP) { atomicAdd(&(bar)[XB_TMO], 1u); break; } } } } while (0)

struct XcdBarrier {
    unsigned* bar; unsigned x;
    volatile LAS unsigned* st;
};

__device__ __forceinline__ XcdBarrier xcd_barrier_post(unsigned* bar, volatile LAS unsigned* st) {
    XcdBarrier b; b.bar = bar; b.x = xb_xcc_id(); b.st = st;
    if (threadIdx.x == 0) (void)xb_add(&bar[XB_XCNT(b.x)], 1u);
    return b;
}
__device__ __forceinline__ void xcd_barrier_complete(unsigned* bar, unsigned x, unsigned& nloc, unsigned& nx) {
    const unsigned G = gridDim.x * gridDim.y * gridDim.z;
    unsigned sum, cnt, mine, sp = 0u;
    for (;;) {
        sum = 0u; cnt = 0u; mine = 0u;
#pragma unroll
        for (unsigned j = 0; j < 16; ++j) { const unsigned c = xb_ld(&bar[XB_XCNT(j)]); sum += c; cnt += (c > 0u) ? 1u : 0u; mine = (j == x) ? c : mine; }
        if (sum == G) break;
        __builtin_amdgcn_s_sleep(1);
        if ((++sp & 255u) == 0u) { if (xb_ld(&bar[XB_TMO])) break; if (sp > XB_SPIN_CAP) { atomicAdd(&bar[XB_TMO], 1u); break; } }
    }
    nloc = mine > 0u ? mine : 1u; nx = cnt > 0u ? cnt : 1u;
}

__device__ __forceinline__ void xcd_barrier(const XcdBarrier& b) {
    asm volatile("s_waitcnt vmcnt(0)" ::: "memory");
    __syncthreads();
    if (threadIdx.x == 0) {
        unsigned* bar = b.bar;
        __builtin_amdgcn_s_waitcnt(0);
        unsigned nloc = b.st[0], nx = b.st[1];
        if (nloc == 0u) { xcd_barrier_complete(bar, b.x, nloc, nx); b.st[0] = nloc; b.st[1] = nx; }
        const unsigned old = xb_add(&bar[XB_XSUB(b.x)], 1u);
        const unsigned gen = old / nloc;
        if (old + 1u == (gen + 1u) * nloc) {
            __builtin_amdgcn_fence(__ATOMIC_RELEASE, "agent");
            asm volatile("s_waitcnt vmcnt(0)" ::: "memory");
            const unsigned og = xb_add(&bar[XB_TOP], 1u);
            const unsigned tg = og / nx;
            if (og + 1u == (tg + 1u) * nx) xb_add(&bar[XB_TOPGEN], 1u);
            else XB_SPIN(xb_ld(&bar[XB_TOPGEN]) == tg, bar);
            __builtin_amdgcn_fence(__ATOMIC_ACQUIRE, "agent");
            xb_add(&bar[XB_XGEN(b.x)], 1u);
            asm volatile("s_waitcnt vmcnt(0)" ::: "memory");
        } else {
            XB_SPIN(xb_ld(&bar[XB_XGEN(b.x)]) == gen, bar);
            __builtin_amdgcn_fence(__ATOMIC_ACQUIRE, "agent");
            asm volatile("s_waitcnt vmcnt(0)" ::: "memory");
        }
    }
    __syncthreads();
}
namespace pg8 {
#define PG8_LAS __attribute__((address_space(3)))
typedef unsigned short bf16_t;
typedef short bf16x8 __attribute__((ext_vector_type(8)));
typedef float f32x4 __attribute__((ext_vector_type(4)));
typedef unsigned u32x4 __attribute__((ext_vector_type(4)));
constexpr int BM = 256, BK = 64, HALF = 128, HTB = HALF * BK * 2  , STAGE_BYTES = 8 * HTB, NXCD = 8, WGM = 8;

__host__ __device__ __forceinline__ int lds_byte(int r, int c) { const int st = (r >> 4) * 2 + (c >> 5), rr = r & 15, cc = c & 31, ob = rr * 64 + cc * 2; return st * 1024 + (ob ^ (((ob >> 9) & 1) << 5)); }
__host__ __device__ __forceinline__ void stage_rc(int b, int& R, int& C) { const int st = b / 1024, sb = b % 1024, swz = sb ^ (((sb >> 9) & 1) << 5); R = (st >> 1) * 16 + swz / 64; C = (st & 1) * 32 + (swz % 64) / 2; }
__host__ __device__ __forceinline__ int perm32(int rho) { const int n = rho >> 4, i = rho & 15; return 8 * (i >> 2) + 4 * n + (i & 3); }

struct Unit { int pm, pn; };
struct Gemm { const bf16_t* A; const bf16_t* Bt; int M, N, K, lda, ldb, pad; };

struct StaticOrder {
    int nM, nN, nwg, G, c;
    __host__ __device__ void init(int M, int N, int G_, int c_) { nM = M / BM; nN = N / BM; nwg = nM * nN; G = G_; c = c_; }
    __host__ __device__ bool next(int i, Unit& u) const {
        const long L = (long)i * G + c; if (L >= nwg) return false;
        int wgid = (int)L; { const int q = nwg / NXCD, r = nwg % NXCD, xcd = wgid % NXCD, off = wgid / NXCD; wgid = (xcd < r ? xcd * (q + 1) : r * (q + 1) + (xcd - r) * q) + off; }
        const int nig = WGM * nN, gid = wgid / nig, fm = gid * WGM, gsz = (nM - fm) < WGM ? (nM - fm) : WGM;
        u.pm = fm + ((wgid % nig) % gsz); u.pn = (wgid % nig) / gsz; return true;
    }
    __device__ __forceinline__ void a_ready(const Unit&) const {}
    __device__ __forceinline__ void done(const Unit&) const {}
};

__device__ __forceinline__ unsigned cvt_pk_bf16(float lo, float hi) { unsigned r; asm volatile("v_cvt_pk_bf16_f32 %0, %1, %2" : "=v"(r) : "v"(lo), "v"(hi)); return r; }
typedef float f32x2 __attribute__((ext_vector_type(2)));
template <class Epi, class Sched, bool ALIGN_EPI = false, bool SP2 = false>
__device__ __forceinline__ void gemm_phase(PG8_LAS unsigned char* lds, const Gemm g, const Sched& S, const Epi& E) {
    const int tid = threadIdx.x, wid = __builtin_amdgcn_readfirstlane(tid >> 6), lane = tid & 63, wr = wid >> 2, wc = wid & 3, fr = lane & 15, fq = lane >> 4;
    const int K = g.K, nt = K / BK;
    unsigned voffA[2], voffB[2];
#pragma unroll
    for (int i = 0; i < 2; ++i) { int R, C; stage_rc(tid * 16 + i * 8192, R, C); const int Rb = Epi::PERM ? ((R & ~31) + perm32(R & 31)) : R;
        voffA[i] = (unsigned)(R * g.lda + C) * 2u; voffB[i] = (unsigned)(Rb * g.ldb + C) * 2u; }
    const size_t kstep = (size_t)(BK * 2);
    const size_t hstepA = (size_t)HALF * g.lda * 2, hstepB = (size_t)HALF * g.ldb * 2;
    const size_t tstepA = 2 * hstepA, tstepB = 2 * hstepB;
    const unsigned ldsw = (unsigned)wid * 1024u;
    const int aoff = lds_byte(wr * 64 + fr, fq * 8), boff = lds_byte(wc * 32 + fr, fq * 8);
#define PG8_SA(b, h) (((b) * 2 + (h)) * HTB)
#define PG8_SB(b, h) ((4 + (b) * 2 + (h)) * HTB)
#define PG8_STAGE(bufoff, gbase, voff) do { _Pragma("unroll") for (int _i = 0; _i < 2; ++_i) \
        __builtin_amdgcn_global_load_lds((const unsigned*)((const char*)(gbase) + (voff)[_i]), (PG8_LAS unsigned*)(lds + (bufoff) + ldsw + _i * 8192), 16, 0, 0); } while (0)
#define PG8_LDA(dst, b, h) do { _Pragma("unroll") for (int m = 0; m < 4; ++m) _Pragma("unroll") for (int k = 0; k < 2; ++k) dst[m][k] = *(const PG8_LAS bf16x8*)(lds + PG8_SA(b, h) + aoff + m * 2048 + k * 1024); } while (0)
#define PG8_LDB(dst, b, h) do { _Pragma("unroll") for (int n = 0; n < 2; ++n) _Pragma("unroll") for (int k = 0; k < 2; ++k) dst[n][k] = *(const PG8_LAS bf16x8*)(lds + PG8_SB(b, h) + boff + n * 2048 + k * 1024); } while (0)
#define PG8_MMA(ai, bj, At, Bt) do { __builtin_amdgcn_s_setprio(1); _Pragma("unroll") for (int m = 0; m < 4; ++m) _Pragma("unroll") for (int n = 0; n < 2; ++n) _Pragma("unroll") for (int k = 0; k < 2; ++k) \
        acc[ai][bj][m][n] = __builtin_amdgcn_mfma_f32_16x16x32_bf16(Bt[n][k], At[m][k], acc[ai][bj][m][n], 0, 0, 0); __builtin_amdgcn_s_setprio(0); } while (0)
#define PG8_WAIT_V(n) asm volatile("s_waitcnt vmcnt(" #n ")" ::: "memory")
#define PG8_WAIT_L(n) asm volatile("s_waitcnt lgkmcnt(" #n ")" ::: "memory")
#define PG8_BAR __builtin_amdgcn_s_barrier()
#define PG8_SCHED __builtin_amdgcn_sched_barrier(0)
    Unit cur, nxt; int ui = 0;
    if (!S.next(0, cur)) return;
    f32x4 acc[2][2][4][2];
#pragma unroll
    for (int a = 0; a < 2; ++a)
#pragma unroll
        for (int b = 0; b < 2; ++b)
#pragma unroll
            for (int m = 0; m < 4; ++m)
#pragma unroll
                for (int n = 0; n < 2; ++n) acc[a][b][m][n] = (f32x4){0.f, 0.f, 0.f, 0.f};
    bf16x8 At[4][2], B0[2][2], B1[2][2];
    const char* cA = (const char*)g.A + (size_t)cur.pm * tstepA; const char* cB = (const char*)g.Bt + (size_t)cur.pn * tstepB;
    S.a_ready(cur);
    if constexpr (SP2) {
        PG8_STAGE(PG8_SB(0, 0), cB, voffB); PG8_STAGE(PG8_SB(0, 1), cB + hstepB, voffB); PG8_STAGE(PG8_SA(0, 0), cA, voffA); PG8_STAGE(PG8_SA(0, 1), cA + hstepA, voffA);
        if (wr == 1) PG8_BAR;
        PG8_WAIT_V(2); PG8_BAR;
        PG8_STAGE(PG8_SB(1, 0), cB + kstep, voffB); PG8_STAGE(PG8_SA(1, 0), cA + kstep, voffA); PG8_STAGE(PG8_SB(1, 1), cB + hstepB + kstep, voffB);
        PG8_WAIT_V(6); PG8_BAR;
    } else {
        PG8_STAGE(PG8_SB(0, 0), cB, voffB); PG8_STAGE(PG8_SA(0, 0), cA, voffA); PG8_STAGE(PG8_SB(0, 1), cB + hstepB, voffB); PG8_STAGE(PG8_SA(0, 1), cA + hstepA, voffA);
        if (wr == 1) PG8_BAR;
        PG8_WAIT_V(4); PG8_BAR;
        PG8_STAGE(PG8_SB(1, 0), cB + kstep, voffB); PG8_STAGE(PG8_SA(1, 0), cA + kstep, voffA); PG8_STAGE(PG8_SB(1, 1), cB + hstepB + kstep, voffB);
        PG8_WAIT_V(6); PG8_BAR;
    }
    for (;;) {
        const bool has_next = S.next(ui + 1, nxt);
        const char* nA = has_next ? (const char*)g.A + (size_t)nxt.pm * tstepA : cA; const char* nB = has_next ? (const char*)g.Bt + (size_t)nxt.pn * tstepB : cB;
        for (int t = 0; t < nt; t += 2) {
            const bool last = (t == nt - 2);
            const char* a1 = cA + (size_t)(t + 1) * kstep;
            const char* a2 = last ? nA : cA + (size_t)(t + 2) * kstep; const char* b2 = last ? nB : cB + (size_t)(t + 2) * kstep;
            const char* a3 = a2 + kstep; const char* b3 = b2 + kstep;
            if (last && has_next) S.a_ready(nxt);
            if constexpr (SP2) {
            PG8_LDB(B0, 0, 0); PG8_LDB(B1, 0, 1); PG8_SCHED; PG8_LDA(At, 0, 0); PG8_STAGE(PG8_SA(1, 1), a1 + hstepA, voffA);
            PG8_WAIT_V(8); PG8_WAIT_L(0); PG8_BAR; PG8_MMA(0, 0, At, B0); PG8_MMA(0, 1, At, B1); PG8_BAR; PG8_SCHED;
            PG8_LDA(At, 0, 1); PG8_STAGE(PG8_SB(0, 0), b2, voffB); PG8_STAGE(PG8_SB(0, 1), b2 + hstepB, voffB); PG8_STAGE(PG8_SA(0, 0), a2, voffA);
            PG8_WAIT_V(8); PG8_WAIT_L(0); PG8_BAR; PG8_MMA(1, 0, At, B0); PG8_MMA(1, 1, At, B1); PG8_BAR; PG8_SCHED;
            PG8_LDB(B0, 1, 0); PG8_LDB(B1, 1, 1); PG8_SCHED; PG8_LDA(At, 1, 0); PG8_STAGE(PG8_SA(0, 1), a2 + hstepA, voffA);
            PG8_WAIT_V(8); PG8_WAIT_L(0); PG8_BAR; PG8_MMA(0, 0, At, B0); PG8_MMA(0, 1, At, B1); PG8_BAR; PG8_SCHED;
            PG8_LDA(At, 1, 1); PG8_STAGE(PG8_SB(1, 0), b3, voffB); PG8_STAGE(PG8_SB(1, 1), b3 + hstepB, voffB); PG8_STAGE(PG8_SA(1, 0), a3, voffA);
            PG8_WAIT_V(8); PG8_WAIT_L(0); PG8_BAR; PG8_MMA(1, 0, At, B0); PG8_MMA(1, 1, At, B1); PG8_BAR; PG8_SCHED;
            } else {
            PG8_LDB(B0, 0, 0); PG8_SCHED; PG8_LDA(At, 0, 0); PG8_STAGE(PG8_SA(1, 1), a1 + hstepA, voffA);
            PG8_WAIT_L(8); PG8_BAR; PG8_WAIT_L(0); PG8_MMA(0, 0, At, B0); PG8_BAR; PG8_SCHED;
            PG8_LDB(B1, 0, 1); PG8_STAGE(PG8_SB(0, 0), b2, voffB);
            PG8_BAR; PG8_WAIT_L(0); PG8_MMA(0, 1, At, B1); PG8_BAR;
            PG8_LDA(At, 0, 1); PG8_STAGE(PG8_SA(0, 0), a2, voffA);
            PG8_BAR; PG8_WAIT_L(0); PG8_MMA(1, 0, At, B0); PG8_BAR; PG8_SCHED;
            PG8_STAGE(PG8_SB(0, 1), b2 + hstepB, voffB);
            PG8_WAIT_V(6); PG8_BAR; PG8_MMA(1, 1, At, B1); PG8_BAR;
            PG8_LDB(B0, 1, 0); PG8_SCHED; PG8_LDA(At, 1, 0); PG8_STAGE(PG8_SA(0, 1), a2 + hstepA, voffA);
            PG8_WAIT_L(8); PG8_BAR; PG8_WAIT_L(0); PG8_MMA(0, 0, At, B0); PG8_BAR; PG8_SCHED;
            PG8_LDB(B1, 1, 1); PG8_STAGE(PG8_SB(1, 0), b3, voffB);
            PG8_BAR; PG8_WAIT_L(0); PG8_MMA(0, 1, At, B1); PG8_BAR;
            PG8_LDA(At, 1, 1); PG8_STAGE(PG8_SA(1, 0), a3, voffA);
            PG8_BAR; PG8_WAIT_L(0); PG8_MMA(1, 0, At, B0); PG8_BAR; PG8_SCHED;
            PG8_STAGE(PG8_SB(1, 1), b3 + hstepB, voffB);
            PG8_WAIT_V(6); PG8_BAR; PG8_MMA(1, 1, At, B1); PG8_BAR;
            }
        }
        if constexpr (ALIGN_EPI) { if (wr == 0) PG8_BAR; }
        if constexpr (!Epi::AFTER_DRAIN) { E(acc, cur, wr, wc, fr, fq); S.done(cur); }
        if (!has_next) break;
#pragma unroll
        for (int a = 0; a < 2; ++a)
#pragma unroll
            for (int b = 0; b < 2; ++b)
#pragma unroll
                for (int m = 0; m < 4; ++m)
#pragma unroll
                    for (int n = 0; n < 2; ++n) acc[a][b][m][n] = (f32x4){0.f, 0.f, 0.f, 0.f};
        cur = nxt; cA = nA; cB = nB; ++ui;
        if constexpr (ALIGN_EPI) { if (wr == 1) PG8_BAR; }
    }
    PG8_WAIT_V(0);
    if constexpr (!ALIGN_EPI) { if (wr == 0) PG8_BAR; }
    PG8_BAR;
    if constexpr (Epi::AFTER_DRAIN) { E.fused(acc, cur, wr, wc, fr, fq, lds, wid, lane); S.done(cur); }
#undef PG8_SA
#undef PG8_SB
#undef PG8_STAGE
#undef PG8_LDA
#undef PG8_LDB
#undef PG8_MMA
#undef PG8_WAIT_V
#undef PG8_WAIT_L
#undef PG8_BAR
#undef PG8_SCHED
}
}
typedef unsigned u32x4_t __attribute__((ext_vector_type(4)));
__device__ __forceinline__ float bf2f(unsigned short b) { return __uint_as_float((unsigned)b << 16); }
__device__ __forceinline__ float bflo(unsigned w) { return __uint_as_float(w << 16); }
__device__ __forceinline__ float bfhi(unsigned w) { return __uint_as_float(w & 0xffff0000u); }
__device__ __forceinline__ float sigmoid_f(float x) { return __builtin_amdgcn_rcpf(1.f + __builtin_amdgcn_exp2f(-1.4426950408889634f * x)); }
__device__ __forceinline__ float silu_f(float x) { return x * sigmoid_f(x); }
__device__ __forceinline__ u32x4_t pack8(const pg8::f32x4& a, const pg8::f32x4& b) {
    u32x4_t w; w.x = pg8::cvt_pk_bf16(a[0], a[1]); w.y = pg8::cvt_pk_bf16(a[2], a[3]); w.z = pg8::cvt_pk_bf16(b[0], b[1]); w.w = pg8::cvt_pk_bf16(b[2], b[3]); return w; }
__device__ __forceinline__ void unpack8(const u32x4_t w, pg8::f32x4& a, pg8::f32x4& b) {
    a = (pg8::f32x4){bflo(w.x), bfhi(w.x), bflo(w.y), bfhi(w.y)}; b = (pg8::f32x4){bflo(w.z), bfhi(w.z), bflo(w.w), bfhi(w.w)}; }

#define EPI_ARGS const pg8::f32x4 (&acc)[2][2][4][2], const pg8::Unit& u, int wr, int wc, int fr, int fq
#define EPI_ROWS_BEGIN  _Pragma("unroll") for (int ai = 0; ai < 2; ++ai) _Pragma("unroll") for (int m = 0; m < 4; ++m) { const int row = u.pm * 256 + ai * 128 + wr * 64 + m * 16 + fr;
#define EPI_ROWS_END }

struct EpiWin {
    static constexpr bool PERM = true, AFTER_DRAIN = false;
    unsigned char* ws;
    __device__ __forceinline__ void operator()(EPI_ARGS) const {
        const int pn = u.pn; size_t off; int ldc, cb; bool act = false;
        if (pn < 12) { off = WS_G; ldc = 3072; cb = pn * 256; act = true; }
        else if (pn < 14) { off = WS_ZA; ldc = 512; cb = (pn - 12) * 256; }
        else if (pn < 15) { off = WS_CKV; ldc = 256; cb = 0; }
        else if (pn < 17) { off = WS_MU; ldc = 512; cb = (pn - 15) * 256; }
        else if (pn < 19) { off = WS_MV; ldc = 512; cb = (pn - 17) * 256; }
        else if (pn < 21) { off = WS_MO; ldc = 512; cb = (pn - 19) * 256; act = true; }
        else { off = WS_MEMQ; ldc = 512; cb = (pn - 21) * 256; }
        bf16* base = (bf16*)(ws + off); const float* rstd = (const float*)(ws + WS_RSTDX);
        const int col0 = cb + wc * 32 + 8 * fq;
        EPI_ROWS_BEGIN
            const float rs = rstd[row]; bf16* rowp = base + (size_t)row * ldc + col0;
#pragma unroll
            for (int bj = 0; bj < 2; ++bj) { pg8::f32x4 v0 = acc[ai][bj][m][0] * rs, v1 = acc[ai][bj][m][1] * rs;
                if (act) {
#pragma unroll
                    for (int e = 0; e < 4; ++e) { v0[e] = sigmoid_f(v0[e]); v1[e] = sigmoid_f(v1[e]); } }
                *(u32x4_t*)(rowp + bj * 128) = pack8(v0, v1); }
        EPI_ROWS_END
    }
};
struct EpiPlain {
    static constexpr bool PERM = true, AFTER_DRAIN = false;
    bf16* O0; bf16* O1; int split, ldc;
    __device__ __forceinline__ void operator()(EPI_ARGS) const {
        int c8 = u.pn * 256 + wc * 32 + 8 * fq; bf16* base = O0;
        if (split && c8 >= split) { base = O1; c8 -= split; }
        EPI_ROWS_BEGIN
            bf16* rowp = base + (size_t)row * ldc + c8;
#pragma unroll
            for (int bj = 0; bj < 2; ++bj) *(u32x4_t*)(rowp + bj * 128) = pack8(acc[ai][bj][m][0], acc[ai][bj][m][1]);
        EPI_ROWS_END
    }
};
struct EpiQup {
    static constexpr bool PERM = true, AFTER_DRAIN = false;
    bf16* Q; const float* rstd; const float* cs; const float* sn;
    __device__ __forceinline__ void operator()(EPI_ARGS) const {
        EPI_ROWS_BEGIN
            const float rs = rstd[row];
#pragma unroll
            for (int bj = 0; bj < 2; ++bj) { const int c8 = u.pn * 256 + bj * 128 + wc * 32 + 8 * fq; const int h = c8 / 96, w = c8 - 96 * h;
                pg8::f32x4 v0 = acc[ai][bj][m][0] * rs, v1 = acc[ai][bj][m][1] * rs;
                if (w >= 64) { const int i0 = (w - 64) >> 1; const pg8::f32x4 c = *(const pg8::f32x4*)(cs + (size_t)row * 16 + i0), s = *(const pg8::f32x4*)(sn + (size_t)row * 16 + i0);
                    pg8::f32x4 r0, r1;
                    r0[0] = v0[0] * c[0] - v0[1] * s[0]; r0[1] = v0[0] * s[0] + v0[1] * c[0]; r0[2] = v0[2] * c[1] - v0[3] * s[1]; r0[3] = v0[2] * s[1] + v0[3] * c[1];
                    r1[0] = v1[0] * c[2] - v1[1] * s[2]; r1[1] = v1[0] * s[2] + v1[1] * c[2]; r1[2] = v1[2] * c[3] - v1[3] * s[3]; r1[3] = v1[2] * s[3] + v1[3] * c[3];
                    v0 = r0; v1 = r1; }
                *(u32x4_t*)(Q + (size_t)row * QW + c8) = pack8(v0, v1); }
        EPI_ROWS_END
    }
};
struct EpiKVup {
    static constexpr bool PERM = true, AFTER_DRAIN = false;
    bf16* Kd; bf16* Vd; const float* rstd;
    __device__ __forceinline__ void operator()(EPI_ARGS) const {
        EPI_ROWS_BEGIN
            const float rs = rstd[row];
#pragma unroll
            for (int bj = 0; bj < 2; ++bj) { const int c8 = u.pn * 256 + bj * 128 + wc * 32 + 8 * fq;
                bf16* dst = (c8 < 512) ? Kd + (size_t)row * QW + (c8 >> 6) * 96 + (c8 & 63) : Vd + (size_t)row * 512 + (c8 - 512);
                *(u32x4_t*)dst = pack8(acc[ai][bj][m][0] * rs, acc[ai][bj][m][1] * rs); }
        EPI_ROWS_END
    }
};
struct EpiBranch {
    static constexpr bool PERM = true, AFTER_DRAIN = false;
    const bf16* G; bf16* Mg; int b, pad;
    __device__ __forceinline__ void operator()(EPI_ARGS) const {
        EPI_ROWS_BEGIN
#pragma unroll
            for (int bj = 0; bj < 2; ++bj) { const int c8 = u.pn * 256 + bj * 128 + wc * 32 + 8 * fq;
                pg8::f32x4 g0, g1; unpack8(*(const u32x4_t*)(G + (size_t)row * 3072 + b * 1024 + c8), g0, g1);
                pg8::f32x4 v0 = acc[ai][bj][m][0] * g0, v1 = acc[ai][bj][m][1] * g1; bf16* dst = Mg + (size_t)row * DM + c8;
                if (b > 0) { pg8::f32x4 p0, p1; unpack8(*(const u32x4_t*)dst, p0, p1); v0 += p0; v1 += p1; }
                *(u32x4_t*)dst = pack8(v0, v1); }
        EPI_ROWS_END
    }
};
template <bool WB> struct EpiResid {
    static constexpr bool PERM = true, AFTER_DRAIN = false;
    const float* res; float* xo; bf16* xb; float* ssq;
    __device__ __forceinline__ void operator()(EPI_ARGS) const {
        EPI_ROWS_BEGIN
            float s = 0.f;
#pragma unroll
            for (int bj = 0; bj < 2; ++bj) { const int c8 = u.pn * 256 + bj * 128 + wc * 32 + 8 * fq; const size_t o = (size_t)row * DM + c8;
                const pg8::f32x4 v0 = *(const pg8::f32x4*)(res + o) + acc[ai][bj][m][0], v1 = *(const pg8::f32x4*)(res + o + 4) + acc[ai][bj][m][1];
                *(pg8::f32x4*)(xo + o) = v0; *(pg8::f32x4*)(xo + o + 4) = v1;
                if (WB) *(u32x4_t*)(xb + o) = pack8(v0, v1);
                s += (v0[0] * v0[0] + v0[1] * v0[1]) + (v0[2] * v0[2] + v0[3] * v0[3]) + (v1[0] * v1[0] + v1[1] * v1[1]) + (v1[2] * v1[2] + v1[3] * v1[3]); }
            s += __shfl_xor(s, 16); s += __shfl_xor(s, 32);
            if (fq == 0) ssq[(size_t)row * 16 + u.pn * 4 + wc] = s;
        EPI_ROWS_END
    }
};
__device__ __forceinline__ float rstd_from_ssq(const float* ssq, int row) {
    const pg8::f32x4* p = (const pg8::f32x4*)(ssq + (size_t)row * 16); const pg8::f32x4 a = p[0], b = p[1], c = p[2], d = p[3];
    const float t = ((a[0] + a[1]) + (a[2] + a[3])) + ((b[0] + b[1]) + (b[2] + b[3])) + ((c[0] + c[1]) + (c[2] + c[3])) + ((d[0] + d[1]) + (d[2] + d[3]));
    return 1.0f / sqrtf(t * (1.0f / DM) + EPS);
}
struct EpiFfnUp {
    static constexpr bool PERM = true, AFTER_DRAIN = false;
    bf16* act; const float* ssq;
    __device__ __forceinline__ void operator()(EPI_ARGS) const {
        const int c8 = u.pn * 128 + wc * 32 + 8 * fq;
        EPI_ROWS_BEGIN
            const float rs = rstd_from_ssq(ssq, row);
            pg8::f32x4 g0 = acc[ai][0][m][0] * rs, g1 = acc[ai][0][m][1] * rs; const pg8::f32x4 u0 = acc[ai][1][m][0] * rs, u1 = acc[ai][1][m][1] * rs;
#pragma unroll
            for (int e = 0; e < 4; ++e) { g0[e] = silu_f(g0[e]) * u0[e]; g1[e] = silu_f(g1[e]) * u1[e]; }
            *(u32x4_t*)(act + (size_t)row * DFF + c8) = pack8(g0, g1);
        EPI_ROWS_END
    }
};
typedef float f32x4g __attribute__((ext_vector_type(4)));
__device__ __forceinline__ float wave_sum(float v) {
#pragma unroll
    for (int o = 1; o < 64; o <<= 1) v += __shfl_xor(v, o);
    return v;
}
struct MapWin { __device__ __forceinline__ int operator()(int n) const {
    if (n < 3072) return n;
    if (n < 3584) { const int j = n - 3072; if (j < 384) return 3072 + j; if (j < 416) { const int i = (j - 384) >> 1, pp = (j - 384) & 1; return 3712 + i + 16 * pp; } if (j < 448) return 5280 + (j - 416); return -1; }
    if (n < 3840) return 3456 + (n - 3584);
    if (n < 4352) return 3744 + (n - 3840);
    if (n < 4864) return 4256 + (n - 4352);
    if (n < 5376) return 4768 + (n - 4864);
    return 5312 + (n - 5376); } };
struct MapUq { __device__ __forceinline__ int operator()(int n) const { const int h = n / 96, j = n - 96 * h; if (j < 64) return n; const int i = (j - 64) >> 1, pp = (j - 64) & 1; return h * 96 + 64 + i + 16 * pp; } };
struct MapId { __device__ __forceinline__ int operator()(int n) const { return n; } };
struct RowId { __device__ __forceinline__ int operator()(int n) const { return n; } };
struct RowGU { int up; __device__ __forceinline__ int operator()(int j) const { return (j >> 7) * 256 + (j & 127) + up * 128; } };

template <class SCol, class DRow>
__device__ __forceinline__ void tr_job(const float* src, int ld_src, int K, int NL, bf16* dst, int ldd, const float* rs, const SCol& scol, const DRow& drow, LAS float* scr, int gw, int ngw, int lane) {
    const int nblk = NL / 32, nitems = (K / 64) * nblk;
    for (int it = gw; it < nitems; it += ngw) {
        const int kb = it / nblk, nb = it - kb * nblk, k0 = 64 * kb, n0 = 32 * nb;
        const int sc = scol(n0 + (lane & 31));
#pragma unroll 8
        for (int i = 0; i < 32; ++i) { const int kk = 2 * i + (lane >> 5); float v = 0.f;
            if (sc >= 0) { v = src[(size_t)(k0 + kk) * ld_src + sc]; if (rs) v *= rs[k0 + kk]; }
            scr[kk * 33 + (lane & 31)] = v; }
        LDS_WAIT(); asm volatile("" ::: "memory");
        const int c = lane & 7;
#pragma unroll
        for (int j = 0; j < 4; ++j) { const int n = (lane >> 3) + 8 * j; const LAS float* s = scr + (8 * c) * 33 + n;
            v4u o; o.x = pk2(s[0 * 33], s[1 * 33]); o.y = pk2(s[2 * 33], s[3 * 33]); o.z = pk2(s[4 * 33], s[5 * 33]); o.w = pk2(s[6 * 33], s[7 * 33]);
            *(GAS v4u*)(dst + (size_t)drow(n0 + n) * ldd + k0 + 8 * c) = o; }
        LDS_WAIT(); asm volatile("" ::: "memory");
    }
}
__device__ __forceinline__ double rope_inv(int i) {
    switch (i) {
        case 0: return 1.0; case 1: return 0.5623413251903491; case 2: return 0.31622776601683794; case 3: return 0.17782794100389228;
        case 4: return 0.1; case 5: return 0.05623413251903491; case 6: return 0.03162277660168379; case 7: return 0.01778279410038923;
        case 8: return 0.01; case 9: return 0.005623413251903491; case 10: return 0.0031622776601683794; case 11: return 0.0017782794100389228;
        case 12: return 0.001; case 13: return 0.0005623413251903491; case 14: return 0.00031622776601683794; default: return 0.00017782794100389227; }
}
__device__ __forceinline__ void row_to_bf16(const float* xrow, bf16* orow, float* rstd_out, const float* gain, int lane) {
    const GAS f32x4g* xr = (const GAS f32x4g*)xrow + lane;
    f32x4g v[4]; float s = 0.f;
#pragma unroll
    for (int j = 0; j < 4; ++j) { v[j] = xr[64 * j]; s += (v[j].x * v[j].x + v[j].y * v[j].y) + (v[j].z * v[j].z + v[j].w * v[j].w); }
    const float rstd = 1.f / sqrtf(wave_sum(s) * (1.f / DM) + EPS);
    if (rstd_out && lane == 0) *rstd_out = rstd;
    GAS unsigned long long* o8 = (GAS unsigned long long*)orow + lane;
#pragma unroll
    for (int j = 0; j < 4; ++j) { f32x4g w = v[j];
        if (gain) { const f32x4g g = ((const GAS f32x4g*)gain)[lane + 64 * j]; w = w * rstd * g; }
        o8[64 * j] = (unsigned long long)pk2(w.x, w.y) | ((unsigned long long)pk2(w.z, w.w) << 32); }
}

__device__ __forceinline__ void phase_prologue(const Params& p, LAS unsigned char* lds, int gw, int ngw, int wave, int lane) {
    LAS float* scr = (LAS float*)(lds + wave * 16384);
    unsigned char* ws = p.ws;
    tr_job(p.in[I_WIN], NIN, DM, NINP, (bf16*)(ws + WS_WIN), DM, p.in[I_GMIX], MapWin{}, RowId{}, scr, gw, ngw, lane);
    tr_job(p.in[I_MEMWKV], 1024, DM, 1024, (bf16*)(ws + WS_WKVM), DM, nullptr, MapId{}, RowId{}, scr, gw, ngw, lane);
    tr_job(p.in[I_WUQ], QW, QR, QW, (bf16*)(ws + WS_WUQ), QR, p.in[I_GQ], MapUq{}, RowId{}, scr, gw, ngw, lane);
    tr_job(p.in[I_WUK], 512, KVR, 512, (bf16*)(ws + WS_WUKV), KVR, p.in[I_GKV], MapId{}, RowId{}, scr, gw, ngw, lane);
    tr_job(p.in[I_WUV], 512, KVR, 512, (bf16*)(ws + WS_WUKV) + (size_t)512 * KVR, KVR, p.in[I_GKV], MapId{}, RowId{}, scr, gw, ngw, lane);
    for (int b = 0; b < 3; ++b) tr_job(p.in[I_WBR] + (size_t)b * 512 * DM, DM, 512, DM, (bf16*)(ws + WS_WBR) + (size_t)b * DM * 512, 512, nullptr, MapId{}, RowId{}, scr, gw, ngw, lane);
    tr_job(p.in[I_WOUT], DM, DM, DM, (bf16*)(ws + WS_WOUT), DM, nullptr, MapId{}, RowId{}, scr, gw, ngw, lane);
    tr_job(p.in[I_WFG], DFF, DM, DFF, (bf16*)(ws + WS_WGU), DM, p.in[I_GFFN], MapId{}, RowGU{0}, scr, gw, ngw, lane);
    tr_job(p.in[I_WFU], DFF, DM, DFF, (bf16*)(ws + WS_WGU), DM, p.in[I_GFFN], MapId{}, RowGU{1}, scr, gw, ngw, lane);
    tr_job(p.in[I_WFD], DM, DFF, DM, (bf16*)(ws + WS_WDN), DFF, nullptr, MapId{}, RowId{}, scr, gw, ngw, lane);
    { bf16* W = (bf16*)(ws + WS_WML);
      for (int e = gw * 64 + lane; e < 1024 * 512; e += ngw * 64) { const int n = e >> 9, k = e & 511, part = n >> 9, h = (n >> 6) & 7, d = n & 63; float v = 0.f;
          if ((k >> 6) == h) { const float* w = part ? p.in[I_WK] : p.in[I_WQ]; v = w[(size_t)h * 4096 + (k & 63) * 64 + d]; if (part) v *= 0.125f; }
          W[e] = (bf16)f2bf(v); } }
    for (int m = gw; m < M; m += ngw) row_to_bf16(p.in[I_X] + (size_t)m * DM, (bf16*)(ws + WS_XB) + (size_t)m * DM, (float*)(ws + WS_RSTDX) + m, nullptr, lane);
    for (int m = gw; m < MMEM; m += ngw) row_to_bf16(p.in[I_MEM] + (size_t)m * DM, (bf16*)(ws + WS_MEMN) + (size_t)m * DM, nullptr, p.in[I_MEMG], lane);
    { const int* pos = (const int*)p.in[I_POS]; float* cs = (float*)(ws + WS_COS); float* sn = (float*)(ws + WS_SIN);
      for (int e = gw * 64 + lane; e < M * 16; e += ngw * 64) { const int m = e >> 4, i = e & 15;
          const double rev = (double)pos[m] * rope_inv(i) * 0.15915494309189535; const float fr = (float)(rev - __builtin_rint(rev));
          cs[e] = __builtin_amdgcn_cosf(fr); sn[e] = __builtin_amdgcn_sinf(fr); } }
}

__device__ __forceinline__ void phase_tokprep(const Params& p, int gw, int ngw, int lane) {
    unsigned char* ws = p.ws;
    const bf16* ZA = (const bf16*)(ws + WS_ZA); const bf16* CKV = (const bf16*)(ws + WS_CKV); const bf16* MU = (const bf16*)(ws + WS_MU);
    bf16* Kd = (bf16*)((unsigned char*)p.out + DO_K); bf16* Cml = (bf16*)(ws + WS_CML);
    const float* cs = (const float*)(ws + WS_COS); const float* sn = (const float*)(ws + WS_SIN); const float* cw = p.in[I_CONVW];
    float wv[5][8];
#pragma unroll
    for (int j = 0; j < 5; ++j)
#pragma unroll
        for (int e = 0; e < 8; ++e) wv[j][e] = cw[j * 512 + lane * 8 + e];
    for (int m = gw; m < M; m += ngw) {
        float s1 = 0.f, s2 = 0.f;
        if (lane < 48) { const u32x4_t w = *(const u32x4_t*)(ZA + (size_t)m * 512 + lane * 8);
            const float a0 = bflo(w.x), a1 = bfhi(w.x), a2 = bflo(w.y), a3 = bfhi(w.y), a4 = bflo(w.z), a5 = bfhi(w.z), a6 = bflo(w.w), a7 = bfhi(w.w);
            s1 = (a0 * a0 + a1 * a1) + (a2 * a2 + a3 * a3) + (a4 * a4 + a5 * a5) + (a6 * a6 + a7 * a7); }
        if (lane < 32) { const u32x4_t w = *(const u32x4_t*)(CKV + (size_t)m * 256 + lane * 8);
            const float a0 = bflo(w.x), a1 = bfhi(w.x), a2 = bflo(w.y), a3 = bfhi(w.y), a4 = bflo(w.z), a5 = bfhi(w.z), a6 = bflo(w.w), a7 = bfhi(w.w);
            s2 = (a0 * a0 + a1 * a1) + (a2 * a2 + a3 * a3) + (a4 * a4 + a5 * a5) + (a6 * a6 + a7 * a7); }
        s1 = wave_sum(s1); s2 = wave_sum(s2);
        if (lane == 0) { ((float*)(ws + WS_RSTDCQ))[m] = 1.f / sqrtf(s1 * (1.f / QR) + EPS); ((float*)(ws + WS_RSTDCKV))[m] = 1.f / sqrtf(s2 * (1.f / KVR) + EPS); }
        if (lane < 16) { const unsigned w = *(const unsigned*)(ZA + (size_t)m * 512 + ZA_KR + 2 * lane); const float x1 = bflo(w), x2 = bfhi(w), c = cs[(size_t)m * 16 + lane], s = sn[(size_t)m * 16 + lane];
            const unsigned o = pk2(x1 * c - x2 * s, x1 * s + x2 * c);
#pragma unroll
            for (int h = 0; h < 8; ++h) *(unsigned*)(Kd + (size_t)m * QW + h * 96 + 64 + 2 * lane) = o; }
        const int t = m & (SEQ - 1); float a[8];
#pragma unroll
        for (int e = 0; e < 8; ++e) a[e] = 0.f;
#pragma unroll
        for (int j = 0; j < 5; ++j) { const int tt = t + j - 2;
            if (tt >= 0 && tt < SEQ) { const u32x4_t w = *(const u32x4_t*)(MU + (size_t)(m + j - 2) * 512 + lane * 8);
                a[0] += wv[j][0] * bflo(w.x); a[1] += wv[j][1] * bfhi(w.x); a[2] += wv[j][2] * bflo(w.y); a[3] += wv[j][3] * bfhi(w.y);
                a[4] += wv[j][4] * bflo(w.z); a[5] += wv[j][5] * bfhi(w.z); a[6] += wv[j][6] * bflo(w.w); a[7] += wv[j][7] * bfhi(w.w); } }
        u32x4_t o; o.x = pk2(silu_f(a[0]), silu_f(a[1])); o.y = pk2(silu_f(a[2]), silu_f(a[3])); o.z = pk2(silu_f(a[4]), silu_f(a[5])); o.w = pk2(silu_f(a[6]), silu_f(a[7]));
        *(u32x4_t*)(Cml + (size_t)m * 512 + lane * 8) = o;
    }
}
__device__ __forceinline__ void phase_final(const Params& p, int gw, int ngw, int lane) {
    const float* ssq = (const float*)(p.ws + WS_SSQ2); const float* g = p.in[I_GFINAL];
    f32x4g gv[4];
#pragma unroll
    for (int j = 0; j < 4; ++j) gv[j] = ((const f32x4g*)g)[lane + 64 * j];
    for (int m = gw; m < M; m += ngw) { const float rs = rstd_from_ssq(ssq, m); f32x4g* xr = (f32x4g*)(p.out + (size_t)m * DM) + lane;
#pragma unroll
        for (int j = 0; j < 4; ++j) xr[64 * j] = xr[64 * j] * rs * gv[j]; }
}
namespace att {
using bf16x8 = __attribute__((ext_vector_type(8))) short;
using s16x4 = __attribute__((ext_vector_type(4))) short;
using f32x16 = __attribute__((ext_vector_type(16))) float;
using u32x4 = __attribute__((ext_vector_type(4))) unsigned;
constexpr int NW = 8, QBLK = 32, KVBLK = 64;
constexpr size_t SHM_V = KVBLK * 128 * 2, SHM_K = KVBLK * 128 * 2, SHM_ATTN = 2 * SHM_V + 2 * SHM_K + NW * 64 * 4;
constexpr float THR = 8.f;
#define KSWZ(row, colB) ((row) * 256 + ((colB) ^ (((row) & 7) << 4)))
#define SBAR() __builtin_amdgcn_sched_barrier(0)
__device__ __forceinline__ int crow(int r, int hi) { return (r & 3) + 8 * (r >> 2) + 4 * hi; }
__device__ __forceinline__ unsigned cvtpk(float lo, float hi) { unsigned r; asm volatile("v_cvt_pk_bf16_f32 %0, %1, %2" : "=v"(r) : "v"(lo), "v"(hi)); return r; }

template <int MODE> struct Cfg;
template <> struct Cfg<0> { static constexpr float SCALE = 0.10206207261596575f; };
template <> struct Cfg<1> { static constexpr float SCALE = 0.08838834764831845f; };

template <int MODE> __device__ __forceinline__ void partialSM(f32x16& p0, f32x16& p1, float& m_reg, float& mn, float& alpha) {
  constexpr float SCALE = Cfg<MODE>::SCALE, C = SCALE * 1.4426950408889634f;
  float pmax = p0[0];
#pragma unroll
  for (int r = 1; r < 16; ++r) pmax = fmaxf(pmax, p0[r]);
#pragma unroll
  for (int r = 0; r < 16; ++r) pmax = fmaxf(pmax, p1[r]);
  { auto rr = __builtin_amdgcn_permlane32_swap(__float_as_uint(pmax), __float_as_uint(pmax), false, false);
    pmax = fmaxf(__uint_as_float(rr[0]), __uint_as_float(rr[1])); }
  if (__builtin_expect(__all(pmax - m_reg <= THR / SCALE), 1)) { mn = m_reg; alpha = 1.f; }
  else { mn = fmaxf(m_reg, pmax); alpha = __builtin_amdgcn_exp2f((m_reg - mn) * C); m_reg = mn; }
  const float mnC = -mn * C;
#pragma unroll
  for (int r = 0; r < 16; ++r) p0[r] = fmaf(p0[r], C, mnC);
#pragma unroll
  for (int r = 0; r < 16; ++r) p1[r] = fmaf(p1[r], C, mnC);
#pragma unroll
  for (int r = 0; r < 16; ++r) p0[r] = __builtin_amdgcn_exp2f(p0[r]);
}
__device__ __forceinline__ void finishSM(f32x16& p0, f32x16& p1, float alpha, float& l_reg, bf16x8& pa0, bf16x8& pa1, bf16x8& pa2, bf16x8& pa3) {
#pragma unroll
  for (int r = 0; r < 16; ++r) p1[r] = __builtin_amdgcn_exp2f(p1[r]);
  float ps = 0;
#pragma unroll
  for (int r = 0; r < 16; ++r) ps += p0[r];
#pragma unroll
  for (int r = 0; r < 16; ++r) ps += p1[r];
  { auto rr = __builtin_amdgcn_permlane32_swap(__float_as_uint(ps), __float_as_uint(ps), false, false);
    ps = __uint_as_float(rr[0]) + __uint_as_float(rr[1]); }
  l_reg = l_reg * alpha + ps;
#define PK4(P, BASE, OUT) do { unsigned a0 = cvtpk(P[BASE + 0], P[BASE + 1]), a1 = cvtpk(P[BASE + 2], P[BASE + 3]);   \
    unsigned b0 = cvtpk(P[BASE + 4], P[BASE + 5]), b1 = cvtpk(P[BASE + 6], P[BASE + 7]);                              \
    auto r0 = __builtin_amdgcn_permlane32_swap(a0, b0, false, false); auto r1 = __builtin_amdgcn_permlane32_swap(a1, b1, false, false); \
    u32x4 w = {r0[0], r1[0], r0[1], r1[1]}; OUT = *reinterpret_cast<bf16x8*>(&w); } while (0)
  PK4(p0, 0, pa0); PK4(p0, 8, pa1); PK4(p1, 0, pa2); PK4(p1, 8, pa3);
#undef PK4
}
template <int ND0> __device__ __forceinline__ void qkt(f32x16& p0, f32x16& p1, const char* Ks, const bf16x8* qr, int r32, int hi) {
  p0 = f32x16{}; p1 = f32x16{};
#pragma unroll
  for (int d0 = 0; d0 < ND0; ++d0) { const int cb = (d0 * 16 + hi * 8) * 2;
    const bf16x8 b0 = *reinterpret_cast<const bf16x8*>(Ks + KSWZ(r32, cb));
    const bf16x8 b1 = *reinterpret_cast<const bf16x8*>(Ks + KSWZ(32 + r32, cb));
    p0 = __builtin_amdgcn_mfma_f32_32x32x16_bf16(b0, qr[d0], p0, 0, 0, 0);
    p1 = __builtin_amdgcn_mfma_f32_32x32x16_bf16(b1, qr[d0], p1, 0, 0, 0); }
}
__device__ __forceinline__ int v_st(int k, int c) { const int kk = (k & ~0xC) | ((k & 4) << 1) | ((k & 8) >> 1); return ((kk >> 3) * 4 + (c >> 5)) * 512 + ((kk & 7) * 32 + (c & 31)) * 2; }
__device__ __forceinline__ int v_rd_base(int lane) { return ((lane & 3) << 3) | (((lane >> 2) & 3) << 6) | (((lane >> 4) & 1) << 5) | (((lane >> 5) & 1) << 8); }
constexpr int v_rd_off(int d0, int ks, int half) { return d0 * 512 + ks * 4096 + half * 2048; }
template <int OFF> __device__ __forceinline__ s16x4 tr_read(int vb) { s16x4 r; asm volatile("ds_read_b64_tr_b16 %0, %1 offset:%2" : "=&v"(r) : "v"(vb), "i"(OFF) : "memory"); return r; }
template <int D0> __device__ __forceinline__ void pv_one(f32x16& od, int vb, bf16x8 pa0, bf16x8 pa1, bf16x8 pa2, bf16x8 pa3) {
  const s16x4 l0 = tr_read<v_rd_off(D0, 0, 0)>(vb), h0 = tr_read<v_rd_off(D0, 0, 1)>(vb), l1 = tr_read<v_rd_off(D0, 1, 0)>(vb), h1 = tr_read<v_rd_off(D0, 1, 1)>(vb);
  const s16x4 l2 = tr_read<v_rd_off(D0, 2, 0)>(vb), h2 = tr_read<v_rd_off(D0, 2, 1)>(vb), l3 = tr_read<v_rd_off(D0, 3, 0)>(vb), h3 = tr_read<v_rd_off(D0, 3, 1)>(vb);
  asm volatile("s_waitcnt lgkmcnt(0)" ::: "memory"); SBAR();
#define PK(L, H) (bf16x8){L[0], L[1], L[2], L[3], H[0], H[1], H[2], H[3]}
  od = __builtin_amdgcn_mfma_f32_32x32x16_bf16(pa0, PK(l0, h0), od, 0, 0, 0);
  od = __builtin_amdgcn_mfma_f32_32x32x16_bf16(pa1, PK(l1, h1), od, 0, 0, 0);
  od = __builtin_amdgcn_mfma_f32_32x32x16_bf16(pa2, PK(l2, h2), od, 0, 0, 0);
  od = __builtin_amdgcn_mfma_f32_32x32x16_bf16(pa3, PK(l3, h3), od, 0, 0, 0);
#undef PK
}
template <int NDV> __device__ __forceinline__ void pv_all(f32x16* o, int vb, bf16x8 pa0, bf16x8 pa1, bf16x8 pa2, bf16x8 pa3) {
  pv_one<0>(o[0], vb, pa0, pa1, pa2, pa3); pv_one<1>(o[1], vb, pa0, pa1, pa2, pa3);
  if constexpr (NDV == 4) { pv_one<2>(o[2], vb, pa0, pa1, pa2, pa3); pv_one<3>(o[3], vb, pa0, pa1, pa2, pa3); }
}

template <int MODE, int ND0, int NDV>
__device__ __forceinline__ void attn_unit(const bf16* Qb, int ldq, const bf16* __restrict__ Kh, int ldk, const bf16* __restrict__ Vh, int ldv, bf16* Ob, int ldo, int seq, char* lds) {
  constexpr float SCALE = Cfg<MODE>::SCALE;
  const int tid = threadIdx.x, wid = tid >> 6, lane = tid & 63, r32 = lane & 31, hi = lane >> 5;
  char* V_lds = lds; char* K_lds = lds + 2 * SHM_V;
  float* wsf = (float*)(lds + 2 * SHM_V + 2 * SHM_K) + wid * 64; float* li_l = wsf; float* al_l = wsf + 32;
  float m_reg = -1e30f, l_reg = 0; f32x16 o[NDV]; bf16x8 qr[ND0];
#pragma unroll
  for (int d = 0; d < NDV; ++d) o[d] = f32x16{};
  const bf16* Qw = Qb + (long)(wid * QBLK + r32) * ldq + hi * 8;
#pragma unroll
  for (int d0 = 0; d0 < ND0; ++d0) qr[d0] = *reinterpret_cast<const bf16x8*>(Qw + d0 * 16);
  const int sr = tid >> 4, sc = (tid & 15) * 8, vst0 = v_st(sr, sc), vst1 = v_st(32 + sr, sc);
  const bool kact = sc < ND0 * 16, vact = sc < NDV * 32;
  const int vb0 = (int)(uintptr_t)V_lds + v_rd_base(lane);
  struct { bf16x8 vs0, vs1, ks0, ks1; } sr_[2];
#define SLOAD(i, k0) do { if (vact) { sr_[i].vs0 = *reinterpret_cast<const bf16x8*>(&Vh[(long)((k0) + sr) * ldv + sc]); sr_[i].vs1 = *reinterpret_cast<const bf16x8*>(&Vh[(long)((k0) + 32 + sr) * ldv + sc]); } \
    if (kact) { sr_[i].ks0 = *reinterpret_cast<const bf16x8*>(&Kh[(long)((k0) + sr) * ldk + sc]); sr_[i].ks1 = *reinterpret_cast<const bf16x8*>(&Kh[(long)((k0) + 32 + sr) * ldk + sc]); } } while (0)
#define SWRITE(b, i) do { if (vact) { *(bf16x8*)(V_lds + (b) * SHM_V + vst0) = sr_[i].vs0; *(bf16x8*)(V_lds + (b) * SHM_V + vst1) = sr_[i].vs1; } \
    if (kact) { const int kc = sc * 2; *(bf16x8*)(K_lds + (b) * SHM_K + KSWZ(sr, kc)) = sr_[i].ks0; *(bf16x8*)(K_lds + (b) * SHM_K + KSWZ(32 + sr, kc)) = sr_[i].ks1; } } while (0)
#define RESC(a) do { if (__any((a) < 1.f)) { if (hi == 0) al_l[r32] = (a); asm volatile("s_waitcnt lgkmcnt(0)" ::: "memory"); \
    _Pragma("unroll") for (int d = 0; d < NDV; ++d) _Pragma("unroll") for (int r = 0; r < 16; ++r) o[d][r] *= al_l[crow(r, hi)]; } } while (0)
  f32x16 pA0, pA1, pB0, pB1; float mnA, mnB, alA, alB; bf16x8 pa0, pa1, pa2, pa3; const int NT = seq / KVBLK;
  SLOAD(0, 0); asm volatile("s_waitcnt vmcnt(0)" ::: "memory"); SWRITE(0, 0); __syncthreads();
  qkt<ND0>(pA0, pA1, K_lds, qr, r32, hi); partialSM<MODE>(pA0, pA1, m_reg, mnA, alA);
  SLOAD(1, KVBLK); if (2 < NT) SLOAD(0, 2 * KVBLK);
  SWRITE(1, 1); __syncthreads();
  for (int j = 1; j + 1 < NT; j += 2) {
    SBAR(); qkt<ND0>(pB0, pB1, K_lds + SHM_K, qr, r32, hi);
    finishSM(pA0, pA1, alA, l_reg, pa0, pa1, pa2, pa3); SBAR();
    SLOAD(1, (j + 2) * KVBLK); SBAR();
    pv_all<NDV>(o, vb0, pa0, pa1, pa2, pa3); partialSM<MODE>(pB0, pB1, m_reg, mnB, alB);
    __syncthreads(); SWRITE(0, 0);
    RESC(alB); __syncthreads();
    SBAR(); qkt<ND0>(pA0, pA1, K_lds, qr, r32, hi);
    finishSM(pB0, pB1, alB, l_reg, pa0, pa1, pa2, pa3); SBAR();
    if (j + 3 < NT) SLOAD(0, (j + 3) * KVBLK); SBAR();
    pv_all<NDV>(o, vb0 + (int)SHM_V, pa0, pa1, pa2, pa3); partialSM<MODE>(pA0, pA1, m_reg, mnA, alA);
    __syncthreads(); SWRITE(1, 1);
    RESC(alA); __syncthreads();
  }
  SBAR(); qkt<ND0>(pB0, pB1, K_lds + SHM_K, qr, r32, hi);
  finishSM(pA0, pA1, alA, l_reg, pa0, pa1, pa2, pa3); SBAR();
  pv_all<NDV>(o, vb0, pa0, pa1, pa2, pa3); partialSM<MODE>(pB0, pB1, m_reg, mnB, alB);
  __syncthreads(); RESC(alB);
  finishSM(pB0, pB1, alB, l_reg, pa0, pa1, pa2, pa3); SBAR();
  pv_all<NDV>(o, vb0 + (int)SHM_V, pa0, pa1, pa2, pa3);
  if (hi == 0) li_l[r32] = l_reg; asm volatile("s_waitcnt lgkmcnt(0)" ::: "memory");
  float rli[16];
#pragma unroll
  for (int r = 0; r < 16; ++r) rli[r] = __builtin_amdgcn_rcpf(li_l[crow(r, hi)]);
  bf16* Ow = Ob + (long)(wid * QBLK) * ldo;
#pragma unroll
  for (int r = 0; r < 16; ++r) { const int orow = crow(r, hi);
#pragma unroll
    for (int d0 = 0; d0 < NDV; ++d0) Ow[(long)orow * ldo + d0 * 32 + r32] = (bf16)f2bf(o[d0][r] * rli[r]); }
  __syncthreads();
#undef SLOAD
#undef SWRITE
#undef RESC
}
#undef KSWZ
#undef SBAR
}

__device__ __forceinline__ void phase_attn_mla(const Params& p, char* lds, int vcu, int G) {
    const bf16* Q = (const bf16*)((const unsigned char*)p.out + DO_Q); const bf16* K = (const bf16*)((const unsigned char*)p.out + DO_K); const bf16* V = (const bf16*)((const unsigned char*)p.out + DO_V);
    bf16* O = (bf16*)(p.ws + WS_OMLA);
    for (int u = vcu; u < BATCH * MLAH * (SEQ / 256); u += G) { const int qb = u & 7, h = (u >> 3) & 7, b = u >> 6; const size_t r0 = (size_t)b * SEQ;
        att::attn_unit<0, 6, 2>(Q + (r0 + qb * 256) * QW + h * 96, QW, K + r0 * QW + h * 96, QW, V + r0 * 512 + h * 64, 512, O + (r0 + qb * 256) * 512 + h * 64, 512, SEQ, lds); }
}
__device__ __forceinline__ void phase_attn_mem(const Params& p, char* lds, int vcu, int G) {
    bf16* Q = (bf16*)(p.ws + WS_MEMQ); const bf16* KV = (const bf16*)(p.ws + WS_MEMKV);
    for (int u = vcu; u < BATCH * MEMH * (SEQ / 256); u += G) { const int qb = u & 7, h = (u >> 3) & 3, b = u >> 5;
        bf16* q = Q + ((size_t)b * SEQ + qb * 256) * 512 + h * 128;
        att::attn_unit<1, 8, 4>(q, 512, KV + (size_t)b * MEM_LEN * 1024 + h * 128, 1024, KV + (size_t)b * MEM_LEN * 1024 + 512 + h * 128, 1024, q, 512, MEM_LEN, lds); }
}
namespace ml {
typedef short bf16x8 __attribute__((ext_vector_type(8)));
typedef short s16x4 __attribute__((ext_vector_type(4)));
typedef float f32x4 __attribute__((ext_vector_type(4)));
typedef unsigned u32x4 __attribute__((ext_vector_type(4)));
typedef unsigned u32x2 __attribute__((ext_vector_type(2)));
constexpr int LP = 72;
constexpr int OFF_Q = 0, OFF_K = 64 * LP * 2, OFF_V = 2 * 64 * LP * 2, OFF_C = 3 * 64 * LP * 2, OFF_N = 4 * 64 * LP * 2, OFF_VEC = OFF_N + 256, VEC_BYTES = 5 * 256, GSZ = 42496;
static_assert(OFF_VEC + 4 * VEC_BYTES <= GSZ, "mlstm lds map");
constexpr int LDS_BYTES = 2 * GSZ;
__device__ __forceinline__ s16x4 trd(unsigned addr) { s16x4 r; asm volatile("ds_read_b64_tr_b16 %0, %1" : "=v"(r) : "v"(addr) : "memory"); return r; }
__device__ __forceinline__ void lds_wait() { asm volatile("s_waitcnt lgkmcnt(0)" ::: "memory"); __builtin_amdgcn_sched_barrier(0); }
__device__ __forceinline__ bf16x8 cat(s16x4 lo, s16x4 hi) { return (bf16x8){lo[0], lo[1], lo[2], lo[3], hi[0], hi[1], hi[2], hi[3]}; }
__device__ __forceinline__ f32x4 mfma16(bf16x8 a, bf16x8 b, f32x4 c) { return __builtin_amdgcn_mfma_f32_16x16x32_bf16(a, b, c, 0, 0, 0); }
__device__ __forceinline__ void unpack(bf16x8 v, float (&f)[8]) { const u32x4 w = __builtin_bit_cast(u32x4, v);
    f[0] = bflo(w.x); f[1] = bfhi(w.x); f[2] = bflo(w.y); f[3] = bfhi(w.y); f[4] = bflo(w.z); f[5] = bfhi(w.z); f[6] = bflo(w.w); f[7] = bfhi(w.w); }
__device__ __forceinline__ bf16x8 pack(const float (&f)[8]) { u32x4 w; w.x = pg8::cvt_pk_bf16(f[0], f[1]); w.y = pg8::cvt_pk_bf16(f[2], f[3]); w.z = pg8::cvt_pk_bf16(f[4], f[5]); w.w = pg8::cvt_pk_bf16(f[6], f[7]); return __builtin_bit_cast(bf16x8, w); }

__device__ __forceinline__ void mlstm_unit(const Params& p, int b, int h, char* lds) {
    const int tid = threadIdx.x, lane = tid & 63, gt = tid & 255, fr = lane & 15, fq = lane >> 4, tq = fr >> 2, tp = fr & 3;
    const int wid = __builtin_amdgcn_readfirstlane(tid >> 6), g = wid >> 2, w = wid & 3;
    char* base = lds + g * GSZ;
    bf16* qL = (bf16*)(base + OFF_Q); bf16* kL = (bf16*)(base + OFF_K); bf16* vL = (bf16*)(base + OFF_V); bf16* Cb = (bf16*)(base + OFF_C); float* nv = (float*)(base + OFF_N);
    float* vec = (float*)(base + OFF_VEC + w * VEC_BYTES); float *av = vec, *rv = vec + 64, *wiv = vec + 128, *wsv = vec + 192, *flv = vec + 256;
    const unsigned vL_a = (unsigned)(uintptr_t)vL, kL_a = (unsigned)(uintptr_t)kL;
    unsigned char* ws = p.ws;
    const bf16* Qm = (const bf16*)(ws + WS_QKQ); const bf16* Km = (const bf16*)(ws + WS_QKK); const bf16* Vm = (const bf16*)(ws + WS_MV); const bf16* ZA = (const bf16*)(ws + WS_ZA);
    const bf16* MO = (const bf16*)(ws + WS_MO); bf16* Oml = (bf16*)(ws + WS_OML);
    const size_t rowb = (size_t)b * SEQ; const int hc = h * 64;
    const float bias_i = p.in[I_GBIAS][(g * 2) * 8 + h], bias_f = p.in[I_GBIAS][(g * 2 + 1) * 8 + h];
    f32x4 gh[4];
#pragma unroll
    for (int ne = 0; ne < 4; ++ne) gh[ne] = *(const f32x4*)(p.in[I_GHEAD] + hc + 16 * ne + 4 * fq);
    for (int e = gt; e < 64 * LP / 2; e += 256) ((unsigned*)Cb)[e] = 0u;
    if (gt < 64) nv[gt] = 0.f;
    f32x4 Cacc[4];
#pragma unroll
    for (int n = 0; n < 4; ++n) Cacc[n] = (f32x4){0.f, 0.f, 0.f, 0.f};
    float mprev = -1e30f;
    u32x4 pq[2], pk[2], pv[2]; unsigned short gi, gf;
#define ML_TOK(c, j) (g ? (c) * 64 + 63 - (j) : (c) * 64 + (j))
#define ML_LOAD(c) do { _Pragma("unroll") for (int i = 0; i < 2; ++i) { const int pi = gt + 256 * i, j = pi >> 3, ch = pi & 7; const size_t o = (rowb + ML_TOK(c, j)) * 512 + hc + ch * 8; \
        pq[i] = *(const u32x4*)(Qm + o); pk[i] = *(const u32x4*)(Km + o); pv[i] = *(const u32x4*)(Vm + o); } \
        { const size_t r = rowb + ML_TOK(c, lane); gi = ZA[r * 512 + ZA_MG + (g * 2) * 8 + h]; gf = ZA[r * 512 + ZA_MG + (g * 2 + 1) * 8 + h]; } } while (0)
    ML_LOAD(g ? 31 : 0);
    __syncthreads();
    for (int cc = 0; cc < 32; ++cc) {
        const int c = g ? 31 - cc : cc;
#pragma unroll
        for (int i = 0; i < 2; ++i) { const int pi = gt + 256 * i, j = pi >> 3, ch = pi & 7;
            *(u32x4*)(qL + j * LP + ch * 8) = pq[i]; *(u32x4*)(kL + j * LP + ch * 8) = pk[i]; *(u32x4*)(vL + j * LP + ch * 8) = pv[i]; }
        float decay, mnew;
        { const float ip = bf2f(gi) + bias_i, fp = bf2f(gf) + bias_f;
          const float lf = fminf(fp, 0.f) - log1pf(__expf(-fabsf(fp)));
          float bb = lf;
#pragma unroll
          for (int o = 1; o < 64; o <<= 1) { const float t = __shfl_up(bb, o); if (lane >= o) bb += t; }
          const float a = ip - bb; float pm = a;
#pragma unroll
          for (int o = 1; o < 64; o <<= 1) { const float t = __shfl_up(pm, o); if (lane >= o) pm = fmaxf(pm, t); }
          const float mx = fmaxf(mprev, pm);
          av[lane] = a; rv[lane] = -mx; wiv[lane] = __expf(mprev - mx); flv[lane] = __expf(-(bb + mx));
          const float bL = __shfl(bb, 63), mxL = __shfl(mx, 63);
          decay = __expf(mprev - mxL); wsv[lane] = __expf(a - mxL); mnew = bL + mxL; }
        __syncthreads();
        if (cc < 31) ML_LOAD(g ? 30 - cc : cc + 1);
        const int jrow = 16 * w + fr; const int tk = ML_TOK(c, jrow);
        bf16* orow = Oml + (rowb + tk) * 512 + hc + 4 * fq;
        u32x2 oth[4], mo[4];
        if (cc >= 16) {
#pragma unroll
            for (int ne = 0; ne < 4; ++ne) { oth[ne] = *(const u32x2*)(orow + 16 * ne); mo[ne] = *(const u32x2*)(MO + (rowb + tk) * 512 + hc + 4 * fq + 16 * ne); } }
        const float r_j = rv[jrow], wi_j = wiv[jrow], fl_j = flv[jrow];
        bf16x8 qf[2];
#pragma unroll
        for (int ks = 0; ks < 2; ++ks) qf[ks] = *(const bf16x8*)(qL + jrow * LP + 32 * ks + 8 * fq);
        f32x4 St[4];
#pragma unroll
        for (int n = 0; n < 4; ++n) {
            St[n] = (f32x4){0.f, 0.f, 0.f, 0.f};
            if (n <= w) { f32x4 acc = (f32x4){0.f, 0.f, 0.f, 0.f};
#pragma unroll
                for (int ks = 0; ks < 2; ++ks) { const bf16x8 kf = *(const bf16x8*)(kL + (16 * n + fr) * LP + 32 * ks + 8 * fq); acc = mfma16(kf, qf[ks], acc); }
                const f32x4 a4 = *(const f32x4*)(av + 16 * n + 4 * fq);
#pragma unroll
                for (int jj = 0; jj < 4; ++jj) { const float dd = __expf(r_j + a4[jj]); const bool ok = (n < w) || (4 * fq + jj <= fr); St[n][jj] = ok ? acc[jj] * dd : 0.f; } }
        }
        float rs = 0.f, qn = 0.f;
#pragma unroll
        for (int n = 0; n < 4; ++n) rs += (St[n][0] + St[n][1]) + (St[n][2] + St[n][3]);
#pragma unroll
        for (int ks = 0; ks < 2; ++ks) { float qv[8]; unpack(qf[ks], qv); const f32x4 n0 = *(const f32x4*)(nv + 32 * ks + 8 * fq), n1 = *(const f32x4*)(nv + 32 * ks + 8 * fq + 4);
            qn += (qv[0] * n0[0] + qv[1] * n0[1]) + (qv[2] * n0[2] + qv[3] * n0[3]) + (qv[4] * n1[0] + qv[5] * n1[1]) + (qv[6] * n1[2] + qv[7] * n1[3]); }
        rs += __shfl_xor(rs, 16); rs += __shfl_xor(rs, 32); qn += __shfl_xor(qn, 16); qn += __shfl_xor(qn, 32);
        const float den = rs + wi_j * qn, rden = 1.f / fmaxf(fabsf(den), fl_j);
        bf16x8 sf[2];
#pragma unroll
        for (int ks = 0; ks < 2; ++ks) { const float t8[8] = {St[2 * ks][0], St[2 * ks][1], St[2 * ks][2], St[2 * ks][3], St[2 * ks + 1][0], St[2 * ks + 1][1], St[2 * ks + 1][2], St[2 * ks + 1][3]}; sf[ks] = pack(t8); }
        f32x4 hv[4];
#pragma unroll
        for (int ne = 0; ne < 4; ++ne) {
            f32x4 y = (f32x4){0.f, 0.f, 0.f, 0.f}, nm = (f32x4){0.f, 0.f, 0.f, 0.f};
#pragma unroll
            for (int ks = 0; ks < 2; ++ks) { const bf16x8 cf = *(const bf16x8*)(Cb + (16 * ne + fr) * LP + 32 * ks + 8 * fq); y = mfma16(cf, qf[ks], y); }
#pragma unroll
            for (int ks = 0; ks < 2; ++ks) if (ks == 0 || w >= 2) {
                const s16x4 lo = trd(vL_a + (unsigned)((32 * ks + 4 * fq + tq) * (LP * 2) + 32 * ne + 8 * tp)), hi = trd(vL_a + (unsigned)((32 * ks + 16 + 4 * fq + tq) * (LP * 2) + 32 * ne + 8 * tp));
                lds_wait(); nm = mfma16(cat(lo, hi), sf[ks], nm); }
            hv[ne] = (nm + y * wi_j) * rden;
        }
        if (cc < 16) {
#pragma unroll
            for (int ne = 0; ne < 4; ++ne) { u32x2 o; o.x = pg8::cvt_pk_bf16(hv[ne][0], hv[ne][1]); o.y = pg8::cvt_pk_bf16(hv[ne][2], hv[ne][3]); *(u32x2*)(orow + 16 * ne) = o; }
        } else {
            float ss = 0.f;
#pragma unroll
            for (int ne = 0; ne < 4; ++ne) { hv[ne][0] += bflo(oth[ne].x); hv[ne][1] += bfhi(oth[ne].x); hv[ne][2] += bflo(oth[ne].y); hv[ne][3] += bfhi(oth[ne].y);
                ss += (hv[ne][0] * hv[ne][0] + hv[ne][1] * hv[ne][1]) + (hv[ne][2] * hv[ne][2] + hv[ne][3] * hv[ne][3]); }
            ss += __shfl_xor(ss, 16); ss += __shfl_xor(ss, 32);
            const float rn = 1.f / sqrtf(ss * (1.f / 64.f) + EPS);
#pragma unroll
            for (int ne = 0; ne < 4; ++ne) { const f32x4 gg = gh[ne] * rn; u32x2 o;
                o.x = pg8::cvt_pk_bf16(hv[ne][0] * gg[0] * bflo(mo[ne].x), hv[ne][1] * gg[1] * bfhi(mo[ne].x)); o.y = pg8::cvt_pk_bf16(hv[ne][2] * gg[2] * bflo(mo[ne].y), hv[ne][3] * gg[3] * bfhi(mo[ne].y));
                *(u32x2*)(orow + 16 * ne) = o; }
        }
        bf16x8 vsf[2]; float wsl[2][8];
#pragma unroll
        for (int ks = 0; ks < 2; ++ks) {
            const s16x4 lo = trd(vL_a + (unsigned)((32 * ks + 8 * fq + tq) * (LP * 2) + 32 * w + 8 * tp)), hi = trd(vL_a + (unsigned)((32 * ks + 8 * fq + 4 + tq) * (LP * 2) + 32 * w + 8 * tp));
            const f32x4 w0 = *(const f32x4*)(wsv + 32 * ks + 8 * fq), w1 = *(const f32x4*)(wsv + 32 * ks + 8 * fq + 4);
            lds_wait();
            wsl[ks][0] = w0[0]; wsl[ks][1] = w0[1]; wsl[ks][2] = w0[2]; wsl[ks][3] = w0[3]; wsl[ks][4] = w1[0]; wsl[ks][5] = w1[1]; wsl[ks][6] = w1[2]; wsl[ks][7] = w1[3];
            float f8[8]; unpack(cat(lo, hi), f8);
#pragma unroll
            for (int e = 0; e < 8; ++e) f8[e] *= wsl[ks][e];
            vsf[ks] = pack(f8);
        }
        float dn = 0.f;
#pragma unroll
        for (int nd = 0; nd < 4; ++nd) {
            Cacc[nd] = Cacc[nd] * decay;
#pragma unroll
            for (int ks = 0; ks < 2; ++ks) {
                const s16x4 lo = trd(kL_a + (unsigned)((32 * ks + 8 * fq + tq) * (LP * 2) + 32 * nd + 8 * tp)), hi = trd(kL_a + (unsigned)((32 * ks + 8 * fq + 4 + tq) * (LP * 2) + 32 * nd + 8 * tp));
                lds_wait(); const bf16x8 kt = cat(lo, hi);
                Cacc[nd] = mfma16(vsf[ks], kt, Cacc[nd]);
                if (nd == w) { float k8[8]; unpack(kt, k8);
#pragma unroll
                    for (int e = 0; e < 8; ++e) dn += k8[e] * wsl[ks][e]; }
            }
        }
        dn += __shfl_xor(dn, 16); dn += __shfl_xor(dn, 32);
        const float nnew = decay * nv[16 * w + fr] + dn;
        asm volatile("s_waitcnt vmcnt(0) lgkmcnt(0)" ::: "memory");
        __syncthreads();
#pragma unroll
        for (int nd = 0; nd < 4; ++nd)
#pragma unroll
            for (int jj = 0; jj < 4; ++jj) Cb[(16 * w + 4 * fq + jj) * LP + 16 * nd + fr] = (bf16)f2bf(Cacc[nd][jj]);
        if (fq == 0) nv[16 * w + fr] = nnew;
        mprev = mnew;
    }
    __syncthreads();
#undef ML_TOK
#undef ML_LOAD
}
}
__device__ __forceinline__ void phase_mlstm(const Params& p, char* lds, int vcu, int G) {
    for (int u = vcu; u < BATCH * MLH; u += G) ml::mlstm_unit(p, u >> 3, u & 7, lds);
}
constexpr int NTHR = 512, GEMM_LDS = pg8::STAGE_BYTES;
template <class Epi> __global__ __launch_bounds__(NTHR, 2) void k_gemm(pg8::Gemm g, Epi E) {
    extern __shared__ __attribute__((aligned(16))) unsigned char lds[];
    pg8::StaticOrder S; S.init(g.M, g.N, (int)gridDim.x, (int)blockIdx.x);
    pg8::gemm_phase<Epi, pg8::StaticOrder, true, true>((LAS unsigned char*)lds, g, S, E);
}
__global__ __launch_bounds__(NTHR, 2) void k_prologue(Params p) {
    extern __shared__ __attribute__((aligned(16))) unsigned char lds[];
    const int wave = __builtin_amdgcn_readfirstlane(threadIdx.x >> 6), lane = threadIdx.x & 63;
    phase_prologue(p, (LAS unsigned char*)lds, blockIdx.x * 8 + wave, gridDim.x * 8, wave, lane);
}
__global__ __launch_bounds__(NTHR, 2) void k_tokprep(Params p) {
    const int wave = __builtin_amdgcn_readfirstlane(threadIdx.x >> 6), lane = threadIdx.x & 63;
    phase_tokprep(p, blockIdx.x * 8 + wave, gridDim.x * 8, lane);
}
__global__ __launch_bounds__(NTHR, 2) void k_final(Params p) {
    const int wave = __builtin_amdgcn_readfirstlane(threadIdx.x >> 6), lane = threadIdx.x & 63;
    phase_final(p, blockIdx.x * 8 + wave, gridDim.x * 8, lane);
}
__global__ __launch_bounds__(NTHR, 2) void k_attn_mla(Params p) {
    extern __shared__ __attribute__((aligned(16))) unsigned char lds[];
    const int G = gridDim.x, bx = blockIdx.x, vcu = (G % 8 == 0) ? (bx % 8) * (G / 8) + bx / 8 : bx;
    phase_attn_mla(p, (char*)lds, vcu, G);
}
__global__ __launch_bounds__(NTHR, 2) void k_attn_mem(Params p) {
    extern __shared__ __attribute__((aligned(16))) unsigned char lds[];
    const int G = gridDim.x, bx = blockIdx.x, vcu = (G % 8 == 0) ? (bx % 8) * (G / 8) + bx / 8 : bx;
    phase_attn_mem(p, (char*)lds, vcu, G);
}
__global__ __launch_bounds__(NTHR, 2) void k_mlstm(Params p) {
    extern __shared__ __attribute__((aligned(16))) unsigned char lds[];
    const int G = gridDim.x, bx = blockIdx.x, vcu = (G % 8 == 0) ? (bx % 8) * (G / 8) + bx / 8 : bx;
    phase_mlstm(p, (char*)lds, vcu, G);
}
static pg8::Gemm mk_gemm(const void* A, const void* Bt, int M_, int N_, int K_, int lda, int ldb) { pg8::Gemm g{}; g.A = (const pg8::bf16_t*)A; g.Bt = (const pg8::bf16_t*)Bt; g.M = M_; g.N = N_; g.K = K_; g.lda = lda; g.ldb = ldb; g.pad = 0; return g; }
template <class Epi> static void launch_gemm(const pg8::Gemm& g, const Epi& E, hipStream_t stream) {
    static bool once = false;
    if (!once) { (void)hipFuncSetAttribute((const void*)k_gemm<Epi>, hipFuncAttributeMaxDynamicSharedMemorySize, GEMM_LDS); once = true; }
    hipLaunchKernelGGL(k_gemm<Epi>, dim3(256), dim3(NTHR), GEMM_LDS, stream, g, E);
}
extern "C" void kernel_launch(void* const* d_in, const int* in_sizes, int n_in, void* d_out, int out_size, void* d_ws, size_t ws_size, hipStream_t stream) {
    static int ok = 0;
    if (ok == 0) {
        if (n_in != N_INPUTS || in_sizes[0] != M * DM || out_size != M * DM || ws_size < WS_END) { fprintf(stderr, "kernel_launch: shape/workspace mismatch (n_in %d, ws %zu)\n", n_in, ws_size); ok = -1; return; }
        (void)hipFuncSetAttribute((const void*)k_prologue, hipFuncAttributeMaxDynamicSharedMemorySize, GEMM_LDS);
        (void)hipFuncSetAttribute((const void*)k_attn_mla, hipFuncAttributeMaxDynamicSharedMemorySize, (int)att::SHM_ATTN);
        (void)hipFuncSetAttribute((const void*)k_attn_mem, hipFuncAttributeMaxDynamicSharedMemorySize, (int)att::SHM_ATTN);
        (void)hipFuncSetAttribute((const void*)k_mlstm, hipFuncAttributeMaxDynamicSharedMemorySize, ml::LDS_BYTES);
        ok = 1;
    }
    if (ok < 0) return;
    unsigned char* ws = (unsigned char*)d_ws; unsigned char* ob = (unsigned char*)d_out;
    Params p{}; for (int i = 0; i < N_INPUTS; ++i) p.in[i] = (const float*)d_in[i]; p.out = (float*)d_out; p.ws = ws;
    (void)hipMemsetAsync(ws + WS_CTL, 0, CTL_ZERO_BYTES, stream);
    hipLaunchKernelGGL(k_prologue, dim3(256), dim3(NTHR), GEMM_LDS, stream, p);
    { EpiWin E{}; E.ws = ws; launch_gemm(mk_gemm(ws + WS_XB, ws + WS_WIN, M, NINP, DM, DM, DM), E, stream); }
    { EpiPlain E{}; E.O0 = (bf16*)(ws + WS_MEMKV); E.O1 = nullptr; E.split = 0; E.ldc = 1024; launch_gemm(mk_gemm(ws + WS_MEMN, ws + WS_WKVM, MMEM, 1024, DM, DM, DM), E, stream); }
    hipLaunchKernelGGL(k_tokprep, dim3(256), dim3(NTHR), 0, stream, p);
    { EpiQup E{}; E.Q = (bf16*)(ob + DO_Q); E.rstd = (const float*)(ws + WS_RSTDCQ); E.cs = (const float*)(ws + WS_COS); E.sn = (const float*)(ws + WS_SIN);
      launch_gemm(mk_gemm(ws + WS_ZA, ws + WS_WUQ, M, QW, QR, 512, QR), E, stream); }
    { EpiKVup E{}; E.Kd = (bf16*)(ob + DO_K); E.Vd = (bf16*)(ob + DO_V); E.rstd = (const float*)(ws + WS_RSTDCKV); launch_gemm(mk_gemm(ws + WS_CKV, ws + WS_WUKV, M, 1024, KVR, KVR, KVR), E, stream); }
    { EpiPlain E{}; E.O0 = (bf16*)(ws + WS_QKQ); E.O1 = (bf16*)(ws + WS_QKK); E.split = 512; E.ldc = 512; launch_gemm(mk_gemm(ws + WS_CML, ws + WS_WML, M, 1024, 512, 512, 512), E, stream); }
    hipLaunchKernelGGL(k_mlstm, dim3(256), dim3(NTHR), ml::LDS_BYTES, stream, p);
    hipLaunchKernelGGL(k_attn_mla, dim3(256), dim3(NTHR), (int)att::SHM_ATTN, stream, p);
    hipLaunchKernelGGL(k_attn_mem, dim3(256), dim3(NTHR), (int)att::SHM_ATTN, stream, p);
    for (int b = 0; b < 3; ++b) { EpiBranch E{}; E.G = (const bf16*)(ws + WS_G); E.Mg = (bf16*)(ws + WS_MERGED); E.b = b; E.pad = 0;
        const size_t ao = b == 0 ? WS_OMLA : (b == 1 ? WS_OML : WS_MEMQ);
        launch_gemm(mk_gemm(ws + ao, ws + WS_WBR + (size_t)b * DM * 512 * 2, M, DM, 512, 512, 512), E, stream); }
    { EpiResid<true> E{}; E.res = p.in[I_X]; E.xo = (float*)d_out; E.xb = (bf16*)(ws + WS_X1B); E.ssq = (float*)(ws + WS_SSQ1); launch_gemm(mk_gemm(ws + WS_MERGED, ws + WS_WOUT, M, DM, DM, DM, DM), E, stream); }
    { EpiFfnUp E{}; E.act = (bf16*)(ws + WS_ACT); E.ssq = (const float*)(ws + WS_SSQ1); launch_gemm(mk_gemm(ws + WS_X1B, ws + WS_WGU, M, NGU, DM, DM, DM), E, stream); }
    { EpiResid<false> E{}; E.res = (const float*)d_out; E.xo = (float*)d_out; E.xb = nullptr; E.ssq = (float*)(ws + WS_SSQ2); launch_gemm(mk_gemm(ws + WS_ACT, ws + WS_WDN, M, DM, DFF, DFF, DFF), E, stream); }
    hipLaunchKernelGGL(k_final, dim3(256), dim3(NTHR), 0, stream, p);
}
```

```cpp
#include <hip/hip_runtime.h>
#include <cstdio>
#include <cstdint>

constexpr int BATCH = 32, SEQ = 2048, DM = 1024, M = BATCH * SEQ;
constexpr int MEM_LEN = 256, MMEM = BATCH * MEM_LEN;
constexpr int NIN = 5824, NINP = 5888;
constexpr int DFF = 2816, NGU = 2 * DFF;
constexpr int QR = 384, KVR = 256, ROPE = 32, NOPE = 64, DQK = 96, MLAH = 8, QW = MLAH * DQK;
constexpr int MLW = 512, MLH = 8, MEMW = 512, MEMH = 4, MEMD = 128;
constexpr float EPS = 1e-6f;
constexpr int ZA_KR = 384, ZA_MG = 416;

constexpr size_t MiB = 1u << 20;
constexpr size_t WS_CTL = 0, CTL_ZERO_BYTES = 1 * MiB;
constexpr size_t WS_WIN = 1 * MiB;
constexpr size_t WS_WKVM = 13 * MiB;
constexpr size_t WS_WUQ = 15 * MiB;
constexpr size_t WS_WUKV = 16 * MiB;
constexpr size_t WS_WML = 17 * MiB;
constexpr size_t WS_WBR = 18 * MiB;
constexpr size_t WS_WOUT = 21 * MiB;
constexpr size_t WS_WGU = 23 * MiB;
constexpr size_t WS_WDN = 34 * MiB;
constexpr size_t WS_COS = 40 * MiB;
constexpr size_t WS_SIN = 44 * MiB;
constexpr size_t WS_RSTDX = 48 * MiB;
constexpr size_t WS_RSTDCQ = WS_RSTDX + 256 * 1024, WS_RSTDCKV = WS_RSTDCQ + 256 * 1024;
constexpr size_t WS_SSQ1 = 49 * MiB;
constexpr size_t WS_SSQ2 = 53 * MiB;
constexpr size_t WS_XB = 64 * MiB;
constexpr size_t WS_QKK = WS_XB, WS_OMLA = WS_XB + 64 * MiB, WS_X1B = WS_XB;
constexpr size_t WS_G = 192 * MiB;
constexpr size_t WS_ACT = WS_G;
constexpr size_t WS_ZA = 576 * MiB;
constexpr size_t WS_CKV = 640 * MiB;
constexpr size_t WS_MU = 672 * MiB;
constexpr size_t WS_QKQ = WS_MU;
constexpr size_t WS_MV = 736 * MiB;
constexpr size_t WS_MO = 800 * MiB;
constexpr size_t WS_MEMQ = 864 * MiB;
constexpr size_t WS_MEMKV = 928 * MiB;
constexpr size_t WS_MEMN = 944 * MiB;
constexpr size_t WS_CML = 960 * MiB;
constexpr size_t WS_OML = WS_CML;
constexpr size_t WS_MERGED = WS_ZA;
constexpr size_t WS_END = 1024 * MiB;
static_assert(WS_WIN + (size_t)NINP * DM * 2 <= WS_WKVM && WS_WGU + (size_t)NGU * DM * 2 <= WS_WDN && WS_WDN + (size_t)DM * DFF * 2 <= WS_COS, "weights map");
static_assert(WS_G + (size_t)M * 3072 * 2 == WS_ZA && WS_ACT + (size_t)M * DFF * 2 <= WS_ZA && WS_MERGED + (size_t)M * DM * 2 <= WS_MV && WS_CML + (size_t)M * 512 * 2 == WS_END, "activation map");
constexpr size_t DO_Q = 0, DO_K = 96 * MiB, DO_V = 192 * MiB;

enum { I_X = 0, I_MEM, I_POS, I_GMIX, I_WIN, I_GQ, I_GKV, I_WUQ, I_WUK, I_WUV, I_CONVW, I_WQ, I_WK, I_GBIAS, I_GHEAD, I_MEMG, I_MEMWKV, I_WBR, I_WOUT, I_GFFN, I_WFG, I_WFU, I_WFD, I_GFINAL, N_INPUTS };
struct Params { const float* in[N_INPUTS]; float* out; unsigned char* ws; };
#define GAS __attribute__((address_space(1)))
#define LAS __attribute__((address_space(3)))
typedef unsigned short bf16;
typedef unsigned v4u __attribute__((ext_vector_type(4)));
typedef float f32x4 __attribute__((ext_vector_type(4)));
typedef short bf16x8 __attribute__((ext_vector_type(8)));
typedef GAS unsigned gu32;
typedef GAS unsigned long long gu64;
#define RLX_AGENT __ATOMIC_RELAXED, __HIP_MEMORY_SCOPE_AGENT
#define LDS_WAIT() asm volatile("s_waitcnt lgkmcnt(0)" ::: "memory")
#define VM_WAIT() asm volatile("s_waitcnt vmcnt(0)" ::: "memory")
__device__ __forceinline__ unsigned long long rt() { return __builtin_amdgcn_s_memrealtime(); }
__device__ __forceinline__ unsigned f2bf(float f) { unsigned u = __builtin_bit_cast(unsigned, f); return (u + 0x7fffu + ((u >> 16) & 1u)) >> 16; }
__device__ __forceinline__ unsigned pk2(float lo, float hi) { return f2bf(lo) | (f2bf(hi) << 16); }
#define XB_TMO      128
#define XB_XCNT(j)  (256  + 64 * (j))
#define XB_XSUB(j)  (1280 + 64 * (j))
#define XB_XGEN(j)  (2304 + 64 * (j))
#define XB_TOP      3328
#define XB_TOPGEN   3392
#define XCD_BAR_WORDS 3456
#define XB_SPIN_CAP (1u << 18)

__device__ __forceinline__ unsigned xb_ld(unsigned* p)              { return __hip_atomic_load(p, __ATOMIC_RELAXED, __HIP_MEMORY_SCOPE_AGENT); }
__device__ __forceinline__ unsigned xb_add(unsigned* p, unsigned v) { return __hip_atomic_fetch_add(p, v, __ATOMIC_RELAXED, __HIP_MEMORY_SCOPE_AGENT); }
__device__ __forceinline__ unsigned xb_xcc_id() { return (unsigned)__builtin_amdgcn_s_getreg((3 << 11) | 20) & 0xFu; }
#define XB_SPIN(cond, bar) do { unsigned _sp = 0; while (cond) { __builtin_amdgcn_s_sleep(1); \
    if ((++_sp & 255u) == 0u) { if (xb_ld(&(bar)[XB_TMO])) break; if (_sp > XB_SPIN_CAP) { atomicAdd(&(bar)[XB_TMO], 1u); break; } } } } while (0)

struct XcdBarrier {
    unsigned* bar; unsigned x;
    volatile LAS unsigned* st;
};

__device__ __forceinline__ XcdBarrier xcd_barrier_post(unsigned* bar, volatile LAS unsigned* st) {
    XcdBarrier b; b.bar = bar; b.x = xb_xcc_id(); b.st = st;
    if (threadIdx.x == 0) (void)xb_add(&bar[XB_XCNT(b.x)], 1u);
    return b;
}
__device__ __forceinline__ void xcd_barrier_complete(unsigned* bar, unsigned x, unsigned& nloc, unsigned& nx) {
    const unsigned G = gridDim.x * gridDim.y * gridDim.z;
    unsigned sum, cnt, mine, sp = 0u;
    for (;;) {
        sum = 0u; cnt = 0u; mine = 0u;
#pragma unroll
        for (unsigned j = 0; j < 16; ++j) { const unsigned c = xb_ld(&bar[XB_XCNT(j)]); sum += c; cnt += (c > 0u) ? 1u : 0u; mine = (j == x) ? c : mine; }
        if (sum == G) break;
        __builtin_amdgcn_s_sleep(1);
        if ((++sp & 255u) == 0u) { if (xb_ld(&bar[XB_TMO])) break; if (sp > XB_SPIN_CAP) { atomicAdd(&bar[XB_TMO], 1u); break; } }
    }
    nloc = mine > 0u ? mine : 1u; nx = cnt > 0u ? cnt : 1u;
}

__device__ __forceinline__ void xcd_barrier(const XcdBarrier& b) {
    asm volatile("s_waitcnt vmcnt(0)" ::: "memory");
    __syncthreads();
    if (threadIdx.x == 0) {
        unsigned* bar = b.bar;
        __builtin_amdgcn_s_waitcnt(0);
        unsigned nloc = b.st[0], nx = b.st[1];
        if (nloc == 0u) { xcd_barrier_complete(bar, b.x, nloc, nx); b.st[0] = nloc; b.st[1] = nx; }
        const unsigned old = xb_add(&bar[XB_XSUB(b.x)], 1u);
        const unsigned gen = old / nloc;
        if (old + 1u == (gen + 1u) * nloc) {
            __builtin_amdgcn_fence(__ATOMIC_RELEASE, "agent");
            asm volatile("s_waitcnt vmcnt(0)" ::: "memory");
            const unsigned og = xb_add(&bar[XB_TOP], 1u);
            const unsigned tg = og / nx;
            if (og + 1u == (tg + 1u) * nx) xb_add(&bar[XB_TOPGEN], 1u);
            else XB_SPIN(xb_ld(&bar[XB_TOPGEN]) == tg, bar);
            __builtin_amdgcn_fence(__ATOMIC_ACQUIRE, "agent");
            xb_add(&bar[XB_XGEN(b.x)], 1u);
            asm volatile("s_waitcnt vmcnt(0)" ::: "memory");
        } else {
            XB_SPIN(xb_ld(&bar[XB_XGEN(b.x)]) == gen, bar);
            __builtin_amdgcn_fence(__ATOMIC_ACQUIRE, "agent");
            asm volatile("s_waitcnt vmcnt(0)" ::: "memory");
        }
    }
    __syncthreads();
}
namespace pg8 {
#define PG8_LAS __attribute__((address_space(3)))
typedef unsigned short bf16_t;
typedef short bf16x8 __attribute__((ext_vector_type(8)));
typedef float f32x4 __attribute__((ext_vector_type(4)));
typedef unsigned u32x4 __attribute__((ext_vector_type(4)));
constexpr int BM = 256, BK = 64, HALF = 128, HTB = HALF * BK * 2  , STAGE_BYTES = 8 * HTB, NXCD = 8, WGM = 8;

__host__ __device__ __forceinline__ int lds_byte(int r, int c) { const int st = (r >> 4) * 2 + (c >> 5), rr = r & 15, cc = c & 31, ob = rr * 64 + cc * 2; return st * 1024 + (ob ^ (((ob >> 9) & 1) << 5)); }
__host__ __device__ __forceinline__ void stage_rc(int b, int& R, int& C) { const int st = b / 1024, sb = b % 1024, swz = sb ^ (((sb >> 9) & 1) << 5); R = (st >> 1) * 16 + swz / 64; C = (st & 1) * 32 + (swz % 64) / 2; }
__host__ __device__ __forceinline__ int perm32(int rho) { const int n = rho >> 4, i = rho & 15; return 8 * (i >> 2) + 4 * n + (i & 3); }

struct Unit { int pm, pn; };
struct Gemm { const bf16_t* A; const bf16_t* Bt; int M, N, K, lda, ldb, pad; };

struct StaticOrder {
    int nM, nN, nwg, G, c;
    __host__ __device__ void init(int M, int N, int G_, int c_) { nM = M / BM; nN = N / BM; nwg = nM * nN; G = G_; c = c_; }
    __host__ __device__ bool next(int i, Unit& u) const {
        const long L = (long)i * G + c; if (L >= nwg) return false;
        int wgid = (int)L; { const int q = nwg / NXCD, r = nwg % NXCD, xcd = wgid % NXCD, off = wgid / NXCD; wgid = (xcd < r ? xcd * (q + 1) : r * (q + 1) + (xcd - r) * q) + off; }
        const int nig = WGM * nN, gid = wgid / nig, fm = gid * WGM, gsz = (nM - fm) < WGM ? (nM - fm) : WGM;
        u.pm = fm + ((wgid % nig) % gsz); u.pn = (wgid % nig) / gsz; return true;
    }
    __device__ __forceinline__ void a_ready(const Unit&) const {}
    __device__ __forceinline__ void done(const Unit&) const {}
};

__device__ __forceinline__ unsigned cvt_pk_bf16(float lo, float hi) { unsigned r; asm volatile("v_cvt_pk_bf16_f32 %0, %1, %2" : "=v"(r) : "v"(lo), "v"(hi)); return r; }
typedef float f32x2 __attribute__((ext_vector_type(2)));
template <class Epi, class Sched, bool ALIGN_EPI = false, bool SP2 = false>
__device__ __forceinline__ void gemm_phase(PG8_LAS unsigned char* lds, const Gemm g, const Sched& S, const Epi& E) {
    int tid = threadIdx.x; asm volatile("" : "+v"(tid));
    const int wid = __builtin_amdgcn_readfirstlane(tid >> 6), lane = tid & 63, wr = wid >> 2, wc = wid & 3, fr = lane & 15, fq = lane >> 4;
    const int K = g.K, nt = K / BK;
    unsigned voffA[2], voffB[2];
#pragma unroll
    for (int i = 0; i < 2; ++i) { int R, C; stage_rc(tid * 16 + i * 8192, R, C); const int Rb = Epi::PERM ? ((R & ~31) + perm32(R & 31)) : R;
        voffA[i] = (unsigned)(R * g.lda + C) * 2u; voffB[i] = (unsigned)(Rb * g.ldb + C) * 2u; }
    const size_t kstep = (size_t)(BK * 2);
    const size_t hstepA = (size_t)HALF * g.lda * 2, hstepB = (size_t)HALF * g.ldb * 2;
    const size_t tstepA = 2 * hstepA, tstepB = 2 * hstepB;
    const unsigned ldsw = (unsigned)wid * 1024u;
    const int aoff = lds_byte(wr * 64 + fr, fq * 8), boff = lds_byte(wc * 32 + fr, fq * 8);
#define PG8_SA(b, h) (((b) * 2 + (h)) * HTB)
#define PG8_SB(b, h) ((4 + (b) * 2 + (h)) * HTB)
#define PG8_STAGE(bufoff, gbase, voff) do { _Pragma("unroll") for (int _i = 0; _i < 2; ++_i) \
        __builtin_amdgcn_global_load_lds((const unsigned*)((const char*)(gbase) + (voff)[_i]), (PG8_LAS unsigned*)(lds + (bufoff) + ldsw + _i * 8192), 16, 0, 0); } while (0)
#define PG8_LDA(dst, b, h) do { _Pragma("unroll") for (int m = 0; m < 4; ++m) _Pragma("unroll") for (int k = 0; k < 2; ++k) dst[m][k] = *(const PG8_LAS bf16x8*)(lds + PG8_SA(b, h) + aoff + m * 2048 + k * 1024); } while (0)
#define PG8_LDB(dst, b, h) do { _Pragma("unroll") for (int n = 0; n < 2; ++n) _Pragma("unroll") for (int k = 0; k < 2; ++k) dst[n][k] = *(const PG8_LAS bf16x8*)(lds + PG8_SB(b, h) + boff + n * 2048 + k * 1024); } while (0)
#define PG8_MMA(ai, bj, At, Bt) do { __builtin_amdgcn_s_setprio(1); _Pragma("unroll") for (int m = 0; m < 4; ++m) _Pragma("unroll") for (int n = 0; n < 2; ++n) _Pragma("unroll") for (int k = 0; k < 2; ++k) \
        acc[ai][bj][m][n] = __builtin_amdgcn_mfma_f32_16x16x32_bf16(Bt[n][k], At[m][k], acc[ai][bj][m][n], 0, 0, 0); __builtin_amdgcn_s_setprio(0); } while (0)
#define PG8_WAIT_V(n) asm volatile("s_waitcnt vmcnt(" #n ")" ::: "memory")
#define PG8_WAIT_L(n) asm volatile("s_waitcnt lgkmcnt(" #n ")" ::: "memory")
#define PG8_BAR __builtin_amdgcn_s_barrier()
#define PG8_SCHED __builtin_amdgcn_sched_barrier(0)
    Unit cur, nxt; int ui = 0;
    if (!S.next(0, cur)) return;
    f32x4 acc[2][2][4][2];
#pragma unroll
    for (int a = 0; a < 2; ++a)
#pragma unroll
        for (int b = 0; b < 2; ++b)
#pragma unroll
            for (int m = 0; m < 4; ++m)
#pragma unroll
                for (int n = 0; n < 2; ++n) acc[a][b][m][n] = (f32x4){0.f, 0.f, 0.f, 0.f};
    bf16x8 At[4][2], B0[2][2], B1[2][2];
    const char* cA = (const char*)g.A + (size_t)cur.pm * tstepA; const char* cB = (const char*)g.Bt + (size_t)cur.pn * tstepB;
    S.a_ready(cur);
    if constexpr (SP2) {
        PG8_STAGE(PG8_SB(0, 0), cB, voffB); PG8_STAGE(PG8_SB(0, 1), cB + hstepB, voffB); PG8_STAGE(PG8_SA(0, 0), cA, voffA); PG8_STAGE(PG8_SA(0, 1), cA + hstepA, voffA);
        if (wr == 1) PG8_BAR;
        PG8_WAIT_V(2); PG8_BAR;
        PG8_STAGE(PG8_SB(1, 0), cB + kstep, voffB); PG8_STAGE(PG8_SA(1, 0), cA + kstep, voffA); PG8_STAGE(PG8_SB(1, 1), cB + hstepB + kstep, voffB);
        PG8_WAIT_V(6); PG8_BAR;
    } else {
        PG8_STAGE(PG8_SB(0, 0), cB, voffB); PG8_STAGE(PG8_SA(0, 0), cA, voffA); PG8_STAGE(PG8_SB(0, 1), cB + hstepB, voffB); PG8_STAGE(PG8_SA(0, 1), cA + hstepA, voffA);
        if (wr == 1) PG8_BAR;
        PG8_WAIT_V(4); PG8_BAR;
        PG8_STAGE(PG8_SB(1, 0), cB + kstep, voffB); PG8_STAGE(PG8_SA(1, 0), cA + kstep, voffA); PG8_STAGE(PG8_SB(1, 1), cB + hstepB + kstep, voffB);
        PG8_WAIT_V(6); PG8_BAR;
    }
    for (;;) {
        const bool has_next = S.next(ui + 1, nxt);
        const char* nA = has_next ? (const char*)g.A + (size_t)nxt.pm * tstepA : cA; const char* nB = has_next ? (const char*)g.Bt + (size_t)nxt.pn * tstepB : cB;
        for (int t = 0; t < nt; t += 2) {
            const bool last = (t == nt - 2);
            const char* a1 = cA + (size_t)(t + 1) * kstep;
            const char* a2 = last ? nA : cA + (size_t)(t + 2) * kstep; const char* b2 = last ? nB : cB + (size_t)(t + 2) * kstep;
            const char* a3 = a2 + kstep; const char* b3 = b2 + kstep;
            if (last && has_next) S.a_ready(nxt);
            if constexpr (SP2) {
            PG8_LDB(B0, 0, 0); PG8_LDB(B1, 0, 1); PG8_SCHED; PG8_LDA(At, 0, 0); PG8_STAGE(PG8_SA(1, 1), a1 + hstepA, voffA);
            PG8_WAIT_V(8); PG8_WAIT_L(0); PG8_BAR; PG8_MMA(0, 0, At, B0); PG8_MMA(0, 1, At, B1); PG8_BAR; PG8_SCHED;
            PG8_LDA(At, 0, 1); PG8_STAGE(PG8_SB(0, 0), b2, voffB); PG8_STAGE(PG8_SB(0, 1), b2 + hstepB, voffB); PG8_STAGE(PG8_SA(0, 0), a2, voffA);
            PG8_WAIT_V(8); PG8_WAIT_L(0); PG8_BAR; PG8_MMA(1, 0, At, B0); PG8_MMA(1, 1, At, B1); PG8_BAR; PG8_SCHED;
            PG8_LDB(B0, 1, 0); PG8_LDB(B1, 1, 1); PG8_SCHED; PG8_LDA(At, 1, 0); PG8_STAGE(PG8_SA(0, 1), a2 + hstepA, voffA);
            PG8_WAIT_V(8); PG8_WAIT_L(0); PG8_BAR; PG8_MMA(0, 0, At, B0); PG8_MMA(0, 1, At, B1); PG8_BAR; PG8_SCHED;
            PG8_LDA(At, 1, 1); PG8_STAGE(PG8_SB(1, 0), b3, voffB); PG8_STAGE(PG8_SB(1, 1), b3 + hstepB, voffB); PG8_STAGE(PG8_SA(1, 0), a3, voffA);
            PG8_WAIT_V(8); PG8_WAIT_L(0); PG8_BAR; PG8_MMA(1, 0, At, B0); PG8_MMA(1, 1, At, B1); PG8_BAR; PG8_SCHED;
            } else {
            PG8_LDB(B0, 0, 0); PG8_SCHED; PG8_LDA(At, 0, 0); PG8_STAGE(PG8_SA(1, 1), a1 + hstepA, voffA);
            PG8_WAIT_L(8); PG8_BAR; PG8_WAIT_L(0); PG8_MMA(0, 0, At, B0); PG8_BAR; PG8_SCHED;
            PG8_LDB(B1, 0, 1); PG8_STAGE(PG8_SB(0, 0), b2, voffB);
            PG8_BAR; PG8_WAIT_L(0); PG8_MMA(0, 1, At, B1); PG8_BAR;
            PG8_LDA(At, 0, 1); PG8_STAGE(PG8_SA(0, 0), a2, voffA);
            PG8_BAR; PG8_WAIT_L(0); PG8_MMA(1, 0, At, B0); PG8_BAR; PG8_SCHED;
            PG8_STAGE(PG8_SB(0, 1), b2 + hstepB, voffB);
            PG8_WAIT_V(6); PG8_BAR; PG8_MMA(1, 1, At, B1); PG8_BAR;
            PG8_LDB(B0, 1, 0); PG8_SCHED; PG8_LDA(At, 1, 0); PG8_STAGE(PG8_SA(0, 1), a2 + hstepA, voffA);
            PG8_WAIT_L(8); PG8_BAR; PG8_WAIT_L(0); PG8_MMA(0, 0, At, B0); PG8_BAR; PG8_SCHED;
            PG8_LDB(B1, 1, 1); PG8_STAGE(PG8_SB(1, 0), b3, voffB);
            PG8_BAR; PG8_WAIT_L(0); PG8_MMA(0, 1, At, B1); PG8_BAR;
            PG8_LDA(At, 1, 1); PG8_STAGE(PG8_SA(1, 0), a3, voffA);
            PG8_BAR; PG8_WAIT_L(0); PG8_MMA(1, 0, At, B0); PG8_BAR; PG8_SCHED;
            PG8_STAGE(PG8_SB(1, 1), b3 + hstepB, voffB);
            PG8_WAIT_V(6); PG8_BAR; PG8_MMA(1, 1, At, B1); PG8_BAR;
            }
        }
        if constexpr (ALIGN_EPI) { if (wr == 0) PG8_BAR; }
        if constexpr (!Epi::AFTER_DRAIN) { E(acc, cur, wr, wc, fr, fq); S.done(cur); }
        if (!has_next) break;
#pragma unroll
        for (int a = 0; a < 2; ++a)
#pragma unroll
            for (int b = 0; b < 2; ++b)
#pragma unroll
                for (int m = 0; m < 4; ++m)
#pragma unroll
                    for (int n = 0; n < 2; ++n) acc[a][b][m][n] = (f32x4){0.f, 0.f, 0.f, 0.f};
        cur = nxt; cA = nA; cB = nB; ++ui;
        if constexpr (ALIGN_EPI) { if (wr == 1) PG8_BAR; }
    }
    PG8_WAIT_V(0);
    if constexpr (!ALIGN_EPI) { if (wr == 0) PG8_BAR; }
    PG8_BAR;
    if constexpr (Epi::AFTER_DRAIN) { E.fused(acc, cur, wr, wc, fr, fq, lds, wid, lane); S.done(cur); }
#undef PG8_SA
#undef PG8_SB
#undef PG8_STAGE
#undef PG8_LDA
#undef PG8_LDB
#undef PG8_MMA
#undef PG8_WAIT_V
#undef PG8_WAIT_L
#undef PG8_BAR
#undef PG8_SCHED
}
}
typedef unsigned u32x4_t __attribute__((ext_vector_type(4)));
__device__ __forceinline__ float bf2f(unsigned short b) { return __uint_as_float((unsigned)b << 16); }
__device__ __forceinline__ float bflo(unsigned w) { return __uint_as_float(w << 16); }
__device__ __forceinline__ float bfhi(unsigned w) { return __uint_as_float(w & 0xffff0000u); }
__device__ __forceinline__ float sigmoid_f(float x) { return __builtin_amdgcn_rcpf(1.f + __builtin_amdgcn_exp2f(-1.4426950408889634f * x)); }
__device__ __forceinline__ float silu_f(float x) { return x * sigmoid_f(x); }
__device__ __forceinline__ u32x4_t pack8(const pg8::f32x4& a, const pg8::f32x4& b) {
    u32x4_t w; w.x = pg8::cvt_pk_bf16(a[0], a[1]); w.y = pg8::cvt_pk_bf16(a[2], a[3]); w.z = pg8::cvt_pk_bf16(b[0], b[1]); w.w = pg8::cvt_pk_bf16(b[2], b[3]); return w; }
__device__ __forceinline__ void unpack8(const u32x4_t w, pg8::f32x4& a, pg8::f32x4& b) {
    a = (pg8::f32x4){bflo(w.x), bfhi(w.x), bflo(w.y), bfhi(w.y)}; b = (pg8::f32x4){bflo(w.z), bfhi(w.z), bflo(w.w), bfhi(w.w)}; }

#define EPI_ARGS const pg8::f32x4 (&acc)[2][2][4][2], const pg8::Unit& u, int wr, int wc, int fr, int fq
#define EPI_ROWS_BEGIN  _Pragma("unroll") for (int ai = 0; ai < 2; ++ai) _Pragma("unroll") for (int m = 0; m < 4; ++m) { const int row = u.pm * 256 + ai * 128 + wr * 64 + m * 16 + fr;
#define EPI_ROWS_END }

struct EpiWin {
    static constexpr bool PERM = true, AFTER_DRAIN = false;
    unsigned char* ws;
    __device__ __forceinline__ void operator()(EPI_ARGS) const {
        const int pn = u.pn; size_t off; int ldc, cb; bool act = false;
        if (pn < 12) { off = WS_G; ldc = 3072; cb = pn * 256; act = true; }
        else if (pn < 14) { off = WS_ZA; ldc = 512; cb = (pn - 12) * 256; }
        else if (pn < 15) { off = WS_CKV; ldc = 256; cb = 0; }
        else if (pn < 17) { off = WS_MU; ldc = 512; cb = (pn - 15) * 256; }
        else if (pn < 19) { off = WS_MV; ldc = 512; cb = (pn - 17) * 256; }
        else if (pn < 21) { off = WS_MO; ldc = 512; cb = (pn - 19) * 256; act = true; }
        else { off = WS_MEMQ; ldc = 512; cb = (pn - 21) * 256; }
        bf16* base = (bf16*)(ws + off); const float* rstd = (const float*)(ws + WS_RSTDX);
        const int col0 = cb + wc * 32 + 8 * fq;
        EPI_ROWS_BEGIN
            const float rs = rstd[row]; bf16* rowp = base + (size_t)row * ldc + col0;
#pragma unroll
            for (int bj = 0; bj < 2; ++bj) { pg8::f32x4 v0 = acc[ai][bj][m][0] * rs, v1 = acc[ai][bj][m][1] * rs;
                if (act) {
#pragma unroll
                    for (int e = 0; e < 4; ++e) { v0[e] = sigmoid_f(v0[e]); v1[e] = sigmoid_f(v1[e]); } }
                *(u32x4_t*)(rowp + bj * 128) = pack8(v0, v1); }
        EPI_ROWS_END
    }
};
struct EpiPlain {
    static constexpr bool PERM = true, AFTER_DRAIN = false;
    bf16* O0; bf16* O1; int split, ldc;
    __device__ __forceinline__ void operator()(EPI_ARGS) const {
        int c8 = u.pn * 256 + wc * 32 + 8 * fq; bf16* base = O0;
        if (split && c8 >= split) { base = O1; c8 -= split; }
        EPI_ROWS_BEGIN
            bf16* rowp = base + (size_t)row * ldc + c8;
#pragma unroll
            for (int bj = 0; bj < 2; ++bj) *(u32x4_t*)(rowp + bj * 128) = pack8(acc[ai][bj][m][0], acc[ai][bj][m][1]);
        EPI_ROWS_END
    }
};
struct EpiQup {
    static constexpr bool PERM = true, AFTER_DRAIN = false;
    bf16* Q; const float* rstd; const float* cs; const float* sn;
    __device__ __forceinline__ void operator()(EPI_ARGS) const {
        EPI_ROWS_BEGIN
            const float rs = rstd[row];
#pragma unroll
            for (int bj = 0; bj < 2; ++bj) { const int c8 = u.pn * 256 + bj * 128 + wc * 32 + 8 * fq; const int h = c8 / 96, w = c8 - 96 * h;
                pg8::f32x4 v0 = acc[ai][bj][m][0] * rs, v1 = acc[ai][bj][m][1] * rs;
                if (w >= 64) { const int i0 = (w - 64) >> 1; const pg8::f32x4 c = *(const pg8::f32x4*)(cs + (size_t)row * 16 + i0), s = *(const pg8::f32x4*)(sn + (size_t)row * 16 + i0);
                    pg8::f32x4 r0, r1;
                    r0[0] = v0[0] * c[0] - v0[1] * s[0]; r0[1] = v0[0] * s[0] + v0[1] * c[0]; r0[2] = v0[2] * c[1] - v0[3] * s[1]; r0[3] = v0[2] * s[1] + v0[3] * c[1];
                    r1[0] = v1[0] * c[2] - v1[1] * s[2]; r1[1] = v1[0] * s[2] + v1[1] * c[2]; r1[2] = v1[2] * c[3] - v1[3] * s[3]; r1[3] = v1[2] * s[3] + v1[3] * c[3];
                    v0 = r0; v1 = r1; }
                *(u32x4_t*)(Q + (size_t)row * QW + c8) = pack8(v0, v1); }
        EPI_ROWS_END
    }
};
struct EpiKVup {
    static constexpr bool PERM = true, AFTER_DRAIN = false;
    bf16* Kd; bf16* Vd; const float* rstd;
    __device__ __forceinline__ void operator()(EPI_ARGS) const {
        EPI_ROWS_BEGIN
            const float rs = rstd[row];
#pragma unroll
            for (int bj = 0; bj < 2; ++bj) { const int c8 = u.pn * 256 + bj * 128 + wc * 32 + 8 * fq;
                bf16* dst = (c8 < 512) ? Kd + (size_t)row * QW + (c8 >> 6) * 96 + (c8 & 63) : Vd + (size_t)row * 512 + (c8 - 512);
                *(u32x4_t*)dst = pack8(acc[ai][bj][m][0] * rs, acc[ai][bj][m][1] * rs); }
        EPI_ROWS_END
    }
};
struct EpiBranch {
    static constexpr bool PERM = true, AFTER_DRAIN = false;
    const bf16* G; bf16* Mg; int b, pad;
    __device__ __forceinline__ void operator()(EPI_ARGS) const {
        EPI_ROWS_BEGIN
#pragma unroll
            for (int bj = 0; bj < 2; ++bj) { const int c8 = u.pn * 256 + bj * 128 + wc * 32 + 8 * fq;
                pg8::f32x4 g0, g1; unpack8(*(const u32x4_t*)(G + (size_t)row * 3072 + b * 1024 + c8), g0, g1);
                pg8::f32x4 v0 = acc[ai][bj][m][0] * g0, v1 = acc[ai][bj][m][1] * g1; bf16* dst = Mg + (size_t)row * DM + c8;
                if (b > 0) { pg8::f32x4 p0, p1; unpack8(*(const u32x4_t*)dst, p0, p1); v0 += p0; v1 += p1; }
                *(u32x4_t*)dst = pack8(v0, v1); }
        EPI_ROWS_END
    }
};
template <bool WB> struct EpiResid {
    static constexpr bool PERM = true, AFTER_DRAIN = false;
    const float* res; float* xo; bf16* xb; float* ssq;
    __device__ __forceinline__ void operator()(EPI_ARGS) const {
        EPI_ROWS_BEGIN
            float s = 0.f;
#pragma unroll
            for (int bj = 0; bj < 2; ++bj) { const int c8 = u.pn * 256 + bj * 128 + wc * 32 + 8 * fq; const size_t o = (size_t)row * DM + c8;
                const pg8::f32x4 v0 = *(const pg8::f32x4*)(res + o) + acc[ai][bj][m][0], v1 = *(const pg8::f32x4*)(res + o + 4) + acc[ai][bj][m][1];
                *(pg8::f32x4*)(xo + o) = v0; *(pg8::f32x4*)(xo + o + 4) = v1;
                if (WB) *(u32x4_t*)(xb + o) = pack8(v0, v1);
                s += (v0[0] * v0[0] + v0[1] * v0[1]) + (v0[2] * v0[2] + v0[3] * v0[3]) + (v1[0] * v1[0] + v1[1] * v1[1]) + (v1[2] * v1[2] + v1[3] * v1[3]); }
            s += __shfl_xor(s, 16); s += __shfl_xor(s, 32);
            if (fq == 0) ssq[(size_t)row * 16 + u.pn * 4 + wc] = s;
        EPI_ROWS_END
    }
};
__device__ __forceinline__ float rstd_from_ssq(const float* ssq, int row) {
    const pg8::f32x4* p = (const pg8::f32x4*)(ssq + (size_t)row * 16); const pg8::f32x4 a = p[0], b = p[1], c = p[2], d = p[3];
    const float t = ((a[0] + a[1]) + (a[2] + a[3])) + ((b[0] + b[1]) + (b[2] + b[3])) + ((c[0] + c[1]) + (c[2] + c[3])) + ((d[0] + d[1]) + (d[2] + d[3]));
    return 1.0f / sqrtf(t * (1.0f / DM) + EPS);
}
struct EpiFfnUp {
    static constexpr bool PERM = true, AFTER_DRAIN = false;
    bf16* act; const float* ssq;
    __device__ __forceinline__ void operator()(EPI_ARGS) const {
        const int c8 = u.pn * 128 + wc * 32 + 8 * fq;
        EPI_ROWS_BEGIN
            const float rs = rstd_from_ssq(ssq, row);
            pg8::f32x4 g0 = acc[ai][0][m][0] * rs, g1 = acc[ai][0][m][1] * rs; const pg8::f32x4 u0 = acc[ai][1][m][0] * rs, u1 = acc[ai][1][m][1] * rs;
#pragma unroll
            for (int e = 0; e < 4; ++e) { g0[e] = silu_f(g0[e]) * u0[e]; g1[e] = silu_f(g1[e]) * u1[e]; }
            *(u32x4_t*)(act + (size_t)row * DFF + c8) = pack8(g0, g1);
        EPI_ROWS_END
    }
};
typedef float f32x4g __attribute__((ext_vector_type(4)));
__device__ __forceinline__ float wave_sum(float v) {
#pragma unroll
    for (int o = 1; o < 64; o <<= 1) v += __shfl_xor(v, o);
    return v;
}
struct MapWin { __device__ __forceinline__ int operator()(int n) const {
    if (n < 3072) return n;
    if (n < 3584) { const int j = n - 3072; if (j < 384) return 3072 + j; if (j < 416) { const int i = (j - 384) >> 1, pp = (j - 384) & 1; return 3712 + i + 16 * pp; } if (j < 448) return 5280 + (j - 416); return -1; }
    if (n < 3840) return 3456 + (n - 3584);
    if (n < 4352) return 3744 + (n - 3840);
    if (n < 4864) return 4256 + (n - 4352);
    if (n < 5376) return 4768 + (n - 4864);
    return 5312 + (n - 5376); } };
struct MapUq { __device__ __forceinline__ int operator()(int n) const { const int h = n / 96, j = n - 96 * h; if (j < 64) return n; const int i = (j - 64) >> 1, pp = (j - 64) & 1; return h * 96 + 64 + i + 16 * pp; } };
struct MapId { __device__ __forceinline__ int operator()(int n) const { return n; } };
struct RowId { __device__ __forceinline__ int operator()(int n) const { return n; } };
struct RowGU { int up; __device__ __forceinline__ int operator()(int j) const { return (j >> 7) * 256 + (j & 127) + up * 128; } };

template <class SCol, class DRow>
__device__ __forceinline__ void tr_job(const float* src, int ld_src, int K, int NL, bf16* dst, int ldd, const float* rs, const SCol& scol, const DRow& drow, LAS float* scr, int gw, int ngw, int lane) {
    const int nblk = NL / 32, nitems = (K / 64) * nblk;
    for (int it = gw; it < nitems; it += ngw) {
        const int kb = it / nblk, nb = it - kb * nblk, k0 = 64 * kb, n0 = 32 * nb;
        const int sc = scol(n0 + (lane & 31));
#pragma unroll 8
        for (int i = 0; i < 32; ++i) { const int kk = 2 * i + (lane >> 5); float v = 0.f;
            if (sc >= 0) { v = src[(size_t)(k0 + kk) * ld_src + sc]; if (rs) v *= rs[k0 + kk]; }
            scr[kk * 33 + (lane & 31)] = v; }
        LDS_WAIT(); asm volatile("" ::: "memory");
        const int c = lane & 7;
#pragma unroll
        for (int j = 0; j < 4; ++j) { const int n = (lane >> 3) + 8 * j; const LAS float* s = scr + (8 * c) * 33 + n;
            v4u o; o.x = pk2(s[0 * 33], s[1 * 33]); o.y = pk2(s[2 * 33], s[3 * 33]); o.z = pk2(s[4 * 33], s[5 * 33]); o.w = pk2(s[6 * 33], s[7 * 33]);
            *(GAS v4u*)(dst + (size_t)drow(n0 + n) * ldd + k0 + 8 * c) = o; }
        LDS_WAIT(); asm volatile("" ::: "memory");
    }
}
__device__ __forceinline__ double rope_inv(int i) {
    switch (i) {
        case 0: return 1.0; case 1: return 0.5623413251903491; case 2: return 0.31622776601683794; case 3: return 0.17782794100389228;
        case 4: return 0.1; case 5: return 0.05623413251903491; case 6: return 0.03162277660168379; case 7: return 0.01778279410038923;
        case 8: return 0.01; case 9: return 0.005623413251903491; case 10: return 0.0031622776601683794; case 11: return 0.0017782794100389228;
        case 12: return 0.001; case 13: return 0.0005623413251903491; case 14: return 0.00031622776601683794; default: return 0.00017782794100389227; }
}
__device__ __forceinline__ void row_to_bf16(const float* xrow, bf16* orow, float* rstd_out, const float* gain, int lane) {
    const GAS f32x4g* xr = (const GAS f32x4g*)xrow + lane;
    f32x4g v[4]; float s = 0.f;
#pragma unroll
    for (int j = 0; j < 4; ++j) { v[j] = xr[64 * j]; s += (v[j].x * v[j].x + v[j].y * v[j].y) + (v[j].z * v[j].z + v[j].w * v[j].w); }
    const float rstd = 1.f / sqrtf(wave_sum(s) * (1.f / DM) + EPS);
    if (rstd_out && lane == 0) *rstd_out = rstd;
    GAS unsigned long long* o8 = (GAS unsigned long long*)orow + lane;
#pragma unroll
    for (int j = 0; j < 4; ++j) { f32x4g w = v[j];
        if (gain) { const f32x4g g = ((const GAS f32x4g*)gain)[lane + 64 * j]; w = w * rstd * g; }
        o8[64 * j] = (unsigned long long)pk2(w.x, w.y) | ((unsigned long long)pk2(w.z, w.w) << 32); }
}

__device__ __forceinline__ void phase_prologue(const Params& p, LAS unsigned char* lds, int gw, int ngw, int wave, int lane) {
    LAS float* scr = (LAS float*)(lds + wave * 16384);
    unsigned char* ws = p.ws;
    tr_job(p.in[I_WIN], NIN, DM, NINP, (bf16*)(ws + WS_WIN), DM, p.in[I_GMIX], MapWin{}, RowId{}, scr, gw, ngw, lane);
    tr_job(p.in[I_MEMWKV], 1024, DM, 1024, (bf16*)(ws + WS_WKVM), DM, nullptr, MapId{}, RowId{}, scr, gw, ngw, lane);
    tr_job(p.in[I_WUQ], QW, QR, QW, (bf16*)(ws + WS_WUQ), QR, p.in[I_GQ], MapUq{}, RowId{}, scr, gw, ngw, lane);
    tr_job(p.in[I_WUK], 512, KVR, 512, (bf16*)(ws + WS_WUKV), KVR, p.in[I_GKV], MapId{}, RowId{}, scr, gw, ngw, lane);
    tr_job(p.in[I_WUV], 512, KVR, 512, (bf16*)(ws + WS_WUKV) + (size_t)512 * KVR, KVR, p.in[I_GKV], MapId{}, RowId{}, scr, gw, ngw, lane);
    for (int b = 0; b < 3; ++b) tr_job(p.in[I_WBR] + (size_t)b * 512 * DM, DM, 512, DM, (bf16*)(ws + WS_WBR) + (size_t)b * DM * 512, 512, nullptr, MapId{}, RowId{}, scr, gw, ngw, lane);
    tr_job(p.in[I_WOUT], DM, DM, DM, (bf16*)(ws + WS_WOUT), DM, nullptr, MapId{}, RowId{}, scr, gw, ngw, lane);
    tr_job(p.in[I_WFG], DFF, DM, DFF, (bf16*)(ws + WS_WGU), DM, p.in[I_GFFN], MapId{}, RowGU{0}, scr, gw, ngw, lane);
    tr_job(p.in[I_WFU], DFF, DM, DFF, (bf16*)(ws + WS_WGU), DM, p.in[I_GFFN], MapId{}, RowGU{1}, scr, gw, ngw, lane);
    tr_job(p.in[I_WFD], DM, DFF, DM, (bf16*)(ws + WS_WDN), DFF, nullptr, MapId{}, RowId{}, scr, gw, ngw, lane);
    { bf16* W = (bf16*)(ws + WS_WML);
      for (int e = gw * 64 + lane; e < 1024 * 512; e += ngw * 64) { const int n = e >> 9, k = e & 511, part = n >> 9, h = (n >> 6) & 7, d = n & 63; float v = 0.f;
          if ((k >> 6) == h) { const float* w = part ? p.in[I_WK] : p.in[I_WQ]; v = w[(size_t)h * 4096 + (k & 63) * 64 + d]; if (part) v *= 0.125f; }
          W[e] = (bf16)f2bf(v); } }
    for (int m = gw; m < M; m += ngw) row_to_bf16(p.in[I_X] + (size_t)m * DM, (bf16*)(ws + WS_XB) + (size_t)m * DM, (float*)(ws + WS_RSTDX) + m, nullptr, lane);
    for (int m = gw; m < MMEM; m += ngw) row_to_bf16(p.in[I_MEM] + (size_t)m * DM, (bf16*)(ws + WS_MEMN) + (size_t)m * DM, nullptr, p.in[I_MEMG], lane);
    { const int* pos = (const int*)p.in[I_POS]; float* cs = (float*)(ws + WS_COS); float* sn = (float*)(ws + WS_SIN);
      for (int e = gw * 64 + lane; e < M * 16; e += ngw * 64) { const int m = e >> 4, i = e & 15;
          const double rev = (double)pos[m] * rope_inv(i) * 0.15915494309189535; const float fr = (float)(rev - __builtin_rint(rev));
          cs[e] = __builtin_amdgcn_cosf(fr); sn[e] = __builtin_amdgcn_sinf(fr); } }
}

__device__ __forceinline__ void phase_tokprep(const Params& p, int gw, int ngw, int lane) {
    unsigned char* ws = p.ws;
    const bf16* ZA = (const bf16*)(ws + WS_ZA); const bf16* CKV = (const bf16*)(ws + WS_CKV); const bf16* MU = (const bf16*)(ws + WS_MU);
    bf16* Kd = (bf16*)((unsigned char*)p.out + DO_K); bf16* Cml = (bf16*)(ws + WS_CML);
    const float* cs = (const float*)(ws + WS_COS); const float* sn = (const float*)(ws + WS_SIN); const float* cw = p.in[I_CONVW];
    float wv[5][8];
#pragma unroll
    for (int j = 0; j < 5; ++j)
#pragma unroll
        for (int e = 0; e < 8; ++e) wv[j][e] = cw[j * 512 + lane * 8 + e];
    for (int m = gw; m < M; m += ngw) {
        float s1 = 0.f, s2 = 0.f;
        if (lane < 48) { const u32x4_t w = *(const u32x4_t*)(ZA + (size_t)m * 512 + lane * 8);
            const float a0 = bflo(w.x), a1 = bfhi(w.x), a2 = bflo(w.y), a3 = bfhi(w.y), a4 = bflo(w.z), a5 = bfhi(w.z), a6 = bflo(w.w), a7 = bfhi(w.w);
            s1 = (a0 * a0 + a1 * a1) + (a2 * a2 + a3 * a3) + (a4 * a4 + a5 * a5) + (a6 * a6 + a7 * a7); }
        if (lane < 32) { const u32x4_t w = *(const u32x4_t*)(CKV + (size_t)m * 256 + lane * 8);
            const float a0 = bflo(w.x), a1 = bfhi(w.x), a2 = bflo(w.y), a3 = bfhi(w.y), a4 = bflo(w.z), a5 = bfhi(w.z), a6 = bflo(w.w), a7 = bfhi(w.w);
            s2 = (a0 * a0 + a1 * a1) + (a2 * a2 + a3 * a3) + (a4 * a4 + a5 * a5) + (a6 * a6 + a7 * a7); }
        s1 = wave_sum(s1); s2 = wave_sum(s2);
        if (lane == 0) { ((float*)(ws + WS_RSTDCQ))[m] = 1.f / sqrtf(s1 * (1.f / QR) + EPS); ((float*)(ws + WS_RSTDCKV))[m] = 1.f / sqrtf(s2 * (1.f / KVR) + EPS); }
        if (lane < 16) { const unsigned w = *(const unsigned*)(ZA + (size_t)m * 512 + ZA_KR + 2 * lane); const float x1 = bflo(w), x2 = bfhi(w), c = cs[(size_t)m * 16 + lane], s = sn[(size_t)m * 16 + lane];
            const unsigned o = pk2(x1 * c - x2 * s, x1 * s + x2 * c);
#pragma unroll
            for (int h = 0; h < 8; ++h) *(unsigned*)(Kd + (size_t)m * QW + h * 96 + 64 + 2 * lane) = o; }
        const int t = m & (SEQ - 1); float a[8];
#pragma unroll
        for (int e = 0; e < 8; ++e) a[e] = 0.f;
#pragma unroll
        for (int j = 0; j < 5; ++j) { const int tt = t + j - 2;
            if (tt >= 0 && tt < SEQ) { const u32x4_t w = *(const u32x4_t*)(MU + (size_t)(m + j - 2) * 512 + lane * 8);
                a[0] += wv[j][0] * bflo(w.x); a[1] += wv[j][1] * bfhi(w.x); a[2] += wv[j][2] * bflo(w.y); a[3] += wv[j][3] * bfhi(w.y);
                a[4] += wv[j][4] * bflo(w.z); a[5] += wv[j][5] * bfhi(w.z); a[6] += wv[j][6] * bflo(w.w); a[7] += wv[j][7] * bfhi(w.w); } }
        u32x4_t o; o.x = pk2(silu_f(a[0]), silu_f(a[1])); o.y = pk2(silu_f(a[2]), silu_f(a[3])); o.z = pk2(silu_f(a[4]), silu_f(a[5])); o.w = pk2(silu_f(a[6]), silu_f(a[7]));
        *(u32x4_t*)(Cml + (size_t)m * 512 + lane * 8) = o;
    }
}
__device__ __forceinline__ void phase_final(const Params& p, int gw, int ngw, int lane) {
    const float* ssq = (const float*)(p.ws + WS_SSQ2); const float* g = p.in[I_GFINAL];
    f32x4g gv[4];
#pragma unroll
    for (int j = 0; j < 4; ++j) gv[j] = ((const f32x4g*)g)[lane + 64 * j];
    for (int m = gw; m < M; m += ngw) { const float rs = rstd_from_ssq(ssq, m); f32x4g* xr = (f32x4g*)(p.out + (size_t)m * DM) + lane;
#pragma unroll
        for (int j = 0; j < 4; ++j) xr[64 * j] = xr[64 * j] * rs * gv[j]; }
}
namespace att {
using bf16x8 = __attribute__((ext_vector_type(8))) short;
using s16x4 = __attribute__((ext_vector_type(4))) short;
using f32x16 = __attribute__((ext_vector_type(16))) float;
using u32x4 = __attribute__((ext_vector_type(4))) unsigned;
constexpr int NW = 8, QBLK = 32, KVBLK = 64;
constexpr size_t SHM_V = KVBLK * 128 * 2, SHM_K = KVBLK * 128 * 2, SHM_ATTN = 2 * SHM_V + 2 * SHM_K + NW * 64 * 4;
constexpr float THR = 8.f;
#define KSWZ(row, colB) ((row) * 256 + ((colB) ^ (((row) & 7) << 4)))
#define SBAR() __builtin_amdgcn_sched_barrier(0)
__device__ __forceinline__ int crow(int r, int hi) { return (r & 3) + 8 * (r >> 2) + 4 * hi; }
__device__ __forceinline__ unsigned cvtpk(float lo, float hi) { unsigned r; asm volatile("v_cvt_pk_bf16_f32 %0, %1, %2" : "=v"(r) : "v"(lo), "v"(hi)); return r; }

template <int MODE> struct Cfg;
template <> struct Cfg<0> { static constexpr float SCALE = 0.10206207261596575f; };
template <> struct Cfg<1> { static constexpr float SCALE = 0.08838834764831845f; };

template <int MODE> __device__ __forceinline__ void partialSM(f32x16& p0, f32x16& p1, float& m_reg, float& mn, float& alpha) {
  constexpr float SCALE = Cfg<MODE>::SCALE, C = SCALE * 1.4426950408889634f;
  float pmax = p0[0];
#pragma unroll
  for (int r = 1; r < 16; ++r) pmax = fmaxf(pmax, p0[r]);
#pragma unroll
  for (int r = 0; r < 16; ++r) pmax = fmaxf(pmax, p1[r]);
  { auto rr = __builtin_amdgcn_permlane32_swap(__float_as_uint(pmax), __float_as_uint(pmax), false, false);
    pmax = fmaxf(__uint_as_float(rr[0]), __uint_as_float(rr[1])); }
  if (__builtin_expect(__all(pmax - m_reg <= THR / SCALE), 1)) { mn = m_reg; alpha = 1.f; }
  else { mn = fmaxf(m_reg, pmax); alpha = __builtin_amdgcn_exp2f((m_reg - mn) * C); m_reg = mn; }
  const float mnC = -mn * C;
#pragma unroll
  for (int r = 0; r < 16; ++r) p0[r] = fmaf(p0[r], C, mnC);
#pragma unroll
  for (int r = 0; r < 16; ++r) p1[r] = fmaf(p1[r], C, mnC);
#pragma unroll
  for (int r = 0; r < 16; ++r) p0[r] = __builtin_amdgcn_exp2f(p0[r]);
}
__device__ __forceinline__ void finishSM(f32x16& p0, f32x16& p1, float alpha, float& l_reg, bf16x8& pa0, bf16x8& pa1, bf16x8& pa2, bf16x8& pa3) {
#pragma unroll
  for (int r = 0; r < 16; ++r) p1[r] = __builtin_amdgcn_exp2f(p1[r]);
  float ps = 0;
#pragma unroll
  for (int r = 0; r < 16; ++r) ps += p0[r];
#pragma unroll
  for (int r = 0; r < 16; ++r) ps += p1[r];
  { auto rr = __builtin_amdgcn_permlane32_swap(__float_as_uint(ps), __float_as_uint(ps), false, false);
    ps = __uint_as_float(rr[0]) + __uint_as_float(rr[1]); }
  l_reg = l_reg * alpha + ps;
#define PK4(P, BASE, OUT) do { unsigned a0 = cvtpk(P[BASE + 0], P[BASE + 1]), a1 = cvtpk(P[BASE + 2], P[BASE + 3]);   \
    unsigned b0 = cvtpk(P[BASE + 4], P[BASE + 5]), b1 = cvtpk(P[BASE + 6], P[BASE + 7]);                              \
    auto r0 = __builtin_amdgcn_permlane32_swap(a0, b0, false, false); auto r1 = __builtin_amdgcn_permlane32_swap(a1, b1, false, false); \
    u32x4 w = {r0[0], r1[0], r0[1], r1[1]}; OUT = *reinterpret_cast<bf16x8*>(&w); } while (0)
  PK4(p0, 0, pa0); PK4(p0, 8, pa1); PK4(p1, 0, pa2); PK4(p1, 8, pa3);
#undef PK4
}
template <int ND0> __device__ __forceinline__ void qkt(f32x16& p0, f32x16& p1, const char* Ks, const bf16x8* qr, int r32, int hi) {
  p0 = f32x16{}; p1 = f32x16{};
#pragma unroll
  for (int d0 = 0; d0 < ND0; ++d0) { const int cb = (d0 * 16 + hi * 8) * 2;
    const bf16x8 b0 = *reinterpret_cast<const bf16x8*>(Ks + KSWZ(r32, cb));
    const bf16x8 b1 = *reinterpret_cast<const bf16x8*>(Ks + KSWZ(32 + r32, cb));
    p0 = __builtin_amdgcn_mfma_f32_32x32x16_bf16(b0, qr[d0], p0, 0, 0, 0);
    p1 = __builtin_amdgcn_mfma_f32_32x32x16_bf16(b1, qr[d0], p1, 0, 0, 0); }
}
__device__ __forceinline__ int v_st(int k, int c) { const int kk = (k & ~0xC) | ((k & 4) << 1) | ((k & 8) >> 1); return ((kk >> 3) * 4 + (c >> 5)) * 512 + ((kk & 7) * 32 + (c & 31)) * 2; }
__device__ __forceinline__ int v_rd_base(int lane) { return ((lane & 3) << 3) | (((lane >> 2) & 3) << 6) | (((lane >> 4) & 1) << 5) | (((lane >> 5) & 1) << 8); }
constexpr int v_rd_off(int d0, int ks, int half) { return d0 * 512 + ks * 4096 + half * 2048; }
template <int OFF> __device__ __forceinline__ s16x4 tr_read(int vb) { s16x4 r; asm volatile("ds_read_b64_tr_b16 %0, %1 offset:%2" : "=&v"(r) : "v"(vb), "i"(OFF) : "memory"); return r; }
template <int D0> __device__ __forceinline__ void pv_one(f32x16& od, int vb, bf16x8 pa0, bf16x8 pa1, bf16x8 pa2, bf16x8 pa3) {
  const s16x4 l0 = tr_read<v_rd_off(D0, 0, 0)>(vb), h0 = tr_read<v_rd_off(D0, 0, 1)>(vb), l1 = tr_read<v_rd_off(D0, 1, 0)>(vb), h1 = tr_read<v_rd_off(D0, 1, 1)>(vb);
  const s16x4 l2 = tr_read<v_rd_off(D0, 2, 0)>(vb), h2 = tr_read<v_rd_off(D0, 2, 1)>(vb), l3 = tr_read<v_rd_off(D0, 3, 0)>(vb), h3 = tr_read<v_rd_off(D0, 3, 1)>(vb);
  asm volatile("s_waitcnt lgkmcnt(0)" ::: "memory"); SBAR();
#define PK(L, H) (bf16x8){L[0], L[1], L[2], L[3], H[0], H[1], H[2], H[3]}
  od = __builtin_amdgcn_mfma_f32_32x32x16_bf16(pa0, PK(l0, h0), od, 0, 0, 0);
  od = __builtin_amdgcn_mfma_f32_32x32x16_bf16(pa1, PK(l1, h1), od, 0, 0, 0);
  od = __builtin_amdgcn_mfma_f32_32x32x16_bf16(pa2, PK(l2, h2), od, 0, 0, 0);
  od = __builtin_amdgcn_mfma_f32_32x32x16_bf16(pa3, PK(l3, h3), od, 0, 0, 0);
#undef PK
}
template <int NDV> __device__ __forceinline__ void pv_all(f32x16* o, int vb, bf16x8 pa0, bf16x8 pa1, bf16x8 pa2, bf16x8 pa3) {
  pv_one<0>(o[0], vb, pa0, pa1, pa2, pa3); pv_one<1>(o[1], vb, pa0, pa1, pa2, pa3);
  if constexpr (NDV == 4) { pv_one<2>(o[2], vb, pa0, pa1, pa2, pa3); pv_one<3>(o[3], vb, pa0, pa1, pa2, pa3); }
}

template <int MODE, int ND0, int NDV>
__device__ __forceinline__ void attn_unit(const bf16* Qb, int ldq, const bf16* __restrict__ Kh, int ldk, const bf16* __restrict__ Vh, int ldv, bf16* Ob, int ldo, int seq, char* lds) {
  constexpr float SCALE = Cfg<MODE>::SCALE;
  int tid = threadIdx.x; asm volatile("" : "+v"(tid));
  const int wid = tid >> 6, lane = tid & 63, r32 = lane & 31, hi = lane >> 5;
  char* V_lds = lds; char* K_lds = lds + 2 * SHM_V;
  float* wsf = (float*)(lds + 2 * SHM_V + 2 * SHM_K) + wid * 64; float* li_l = wsf; float* al_l = wsf + 32;
  float m_reg = -1e30f, l_reg = 0; f32x16 o[NDV]; bf16x8 qr[ND0];
#pragma unroll
  for (int d = 0; d < NDV; ++d) o[d] = f32x16{};
  const bf16* Qw = Qb + (long)(wid * QBLK + r32) * ldq + hi * 8;
#pragma unroll
  for (int d0 = 0; d0 < ND0; ++d0) qr[d0] = *reinterpret_cast<const bf16x8*>(Qw + d0 * 16);
  const int sr = tid >> 4, sc = (tid & 15) * 8, vst0 = v_st(sr, sc), vst1 = v_st(32 + sr, sc);
  const bool kact = sc < ND0 * 16, vact = sc < NDV * 32;
  const int vb0 = (int)(uintptr_t)V_lds + v_rd_base(lane);
  struct { bf16x8 vs0, vs1, ks0, ks1; } sr_[2];
#define SLOAD(i, k0) do { if (vact) { sr_[i].vs0 = *reinterpret_cast<const bf16x8*>(&Vh[(long)((k0) + sr) * ldv + sc]); sr_[i].vs1 = *reinterpret_cast<const bf16x8*>(&Vh[(long)((k0) + 32 + sr) * ldv + sc]); } \
    if (kact) { sr_[i].ks0 = *reinterpret_cast<const bf16x8*>(&Kh[(long)((k0) + sr) * ldk + sc]); sr_[i].ks1 = *reinterpret_cast<const bf16x8*>(&Kh[(long)((k0) + 32 + sr) * ldk + sc]); } } while (0)
#define SWRITE(b, i) do { if (vact) { *(bf16x8*)(V_lds + (b) * SHM_V + vst0) = sr_[i].vs0; *(bf16x8*)(V_lds + (b) * SHM_V + vst1) = sr_[i].vs1; } \
    if (kact) { const int kc = sc * 2; *(bf16x8*)(K_lds + (b) * SHM_K + KSWZ(sr, kc)) = sr_[i].ks0; *(bf16x8*)(K_lds + (b) * SHM_K + KSWZ(32 + sr, kc)) = sr_[i].ks1; } } while (0)
#define RESC(a) do { if (__any((a) < 1.f)) { if (hi == 0) al_l[r32] = (a); asm volatile("s_waitcnt lgkmcnt(0)" ::: "memory"); \
    _Pragma("unroll") for (int d = 0; d < NDV; ++d) _Pragma("unroll") for (int r = 0; r < 16; ++r) o[d][r] *= al_l[crow(r, hi)]; } } while (0)
  f32x16 pA0, pA1, pB0, pB1; float mnA, mnB, alA, alB; bf16x8 pa0, pa1, pa2, pa3; const int NT = seq / KVBLK;
  SLOAD(0, 0); asm volatile("s_waitcnt vmcnt(0)" ::: "memory"); SWRITE(0, 0); __syncthreads();
  qkt<ND0>(pA0, pA1, K_lds, qr, r32, hi); partialSM<MODE>(pA0, pA1, m_reg, mnA, alA);
  SLOAD(1, KVBLK); if (2 < NT) SLOAD(0, 2 * KVBLK);
  SWRITE(1, 1); __syncthreads();
  for (int j = 1; j + 1 < NT; j += 2) {
    SBAR(); qkt<ND0>(pB0, pB1, K_lds + SHM_K, qr, r32, hi);
    finishSM(pA0, pA1, alA, l_reg, pa0, pa1, pa2, pa3); SBAR();
    SLOAD(1, (j + 2) * KVBLK); SBAR();
    pv_all<NDV>(o, vb0, pa0, pa1, pa2, pa3); partialSM<MODE>(pB0, pB1, m_reg, mnB, alB);
    __syncthreads(); SWRITE(0, 0);
    RESC(alB); __syncthreads();
    SBAR(); qkt<ND0>(pA0, pA1, K_lds, qr, r32, hi);
    finishSM(pB0, pB1, alB, l_reg, pa0, pa1, pa2, pa3); SBAR();
    if (j + 3 < NT) SLOAD(0, (j + 3) * KVBLK); SBAR();
    pv_all<NDV>(o, vb0 + (int)SHM_V, pa0, pa1, pa2, pa3); partialSM<MODE>(pA0, pA1, m_reg, mnA, alA);
    __syncthreads(); SWRITE(1, 1);
    RESC(alA); __syncthreads();
  }
  SBAR(); qkt<ND0>(pB0, pB1, K_lds + SHM_K, qr, r32, hi);
  finishSM(pA0, pA1, alA, l_reg, pa0, pa1, pa2, pa3); SBAR();
  pv_all<NDV>(o, vb0, pa0, pa1, pa2, pa3); partialSM<MODE>(pB0, pB1, m_reg, mnB, alB);
  __syncthreads(); RESC(alB);
  finishSM(pB0, pB1, alB, l_reg, pa0, pa1, pa2, pa3); SBAR();
  pv_all<NDV>(o, vb0 + (int)SHM_V, pa0, pa1, pa2, pa3);
  if (hi == 0) li_l[r32] = l_reg; asm volatile("s_waitcnt lgkmcnt(0)" ::: "memory");
  float rli[16];
#pragma unroll
  for (int r = 0; r < 16; ++r) rli[r] = __builtin_amdgcn_rcpf(li_l[crow(r, hi)]);
  bf16* Ow = Ob + (long)(wid * QBLK) * ldo;
#pragma unroll
  for (int r = 0; r < 16; ++r) { const int orow = crow(r, hi);
#pragma unroll
    for (int d0 = 0; d0 < NDV; ++d0) Ow[(long)orow * ldo + d0 * 32 + r32] = (bf16)f2bf(o[d0][r] * rli[r]); }
  __syncthreads();
#undef SLOAD
#undef SWRITE
#undef RESC
}
#undef KSWZ
#undef SBAR
}

__device__ __forceinline__ void phase_attn_mla(const Params& p, char* lds, int vcu, int G) {
    const bf16* Q = (const bf16*)((const unsigned char*)p.out + DO_Q); const bf16* K = (const bf16*)((const unsigned char*)p.out + DO_K); const bf16* V = (const bf16*)((const unsigned char*)p.out + DO_V);
    bf16* O = (bf16*)(p.ws + WS_OMLA);
    for (int u = vcu; u < BATCH * MLAH * (SEQ / 256); u += G) { const int qb = u & 7, h = (u >> 3) & 7, b = u >> 6; const size_t r0 = (size_t)b * SEQ;
        att::attn_unit<0, 6, 2>(Q + (r0 + qb * 256) * QW + h * 96, QW, K + r0 * QW + h * 96, QW, V + r0 * 512 + h * 64, 512, O + (r0 + qb * 256) * 512 + h * 64, 512, SEQ, lds); }
}
__device__ __forceinline__ void phase_attn_mem(const Params& p, char* lds, int vcu, int G) {
    bf16* Q = (bf16*)(p.ws + WS_MEMQ); const bf16* KV = (const bf16*)(p.ws + WS_MEMKV);
    for (int u = vcu; u < BATCH * MEMH * (SEQ / 256); u += G) { const int qb = u & 7, h = (u >> 3) & 3, b = u >> 5;
        bf16* q = Q + ((size_t)b * SEQ + qb * 256) * 512 + h * 128;
        att::attn_unit<1, 8, 4>(q, 512, KV + (size_t)b * MEM_LEN * 1024 + h * 128, 1024, KV + (size_t)b * MEM_LEN * 1024 + 512 + h * 128, 1024, q, 512, MEM_LEN, lds); }
}
namespace ml {
typedef short bf16x8 __attribute__((ext_vector_type(8)));
typedef short s16x4 __attribute__((ext_vector_type(4)));
typedef float f32x4 __attribute__((ext_vector_type(4)));
typedef unsigned u32x4 __attribute__((ext_vector_type(4)));
typedef unsigned u32x2 __attribute__((ext_vector_type(2)));
constexpr int LP = 72;
constexpr int OFF_Q = 0, OFF_K = 64 * LP * 2, OFF_V = 2 * 64 * LP * 2, OFF_C = 3 * 64 * LP * 2, OFF_N = 4 * 64 * LP * 2, OFF_VEC = OFF_N + 256, VEC_BYTES = 5 * 256, GSZ = 42496;
static_assert(OFF_VEC + 4 * VEC_BYTES <= GSZ, "mlstm lds map");
constexpr int LDS_BYTES = 2 * GSZ;
__device__ __forceinline__ s16x4 trd(unsigned addr) { s16x4 r; asm volatile("ds_read_b64_tr_b16 %0, %1" : "=v"(r) : "v"(addr) : "memory"); return r; }
__device__ __forceinline__ void lds_wait() { asm volatile("s_waitcnt lgkmcnt(0)" ::: "memory"); __builtin_amdgcn_sched_barrier(0); }
__device__ __forceinline__ bf16x8 cat(s16x4 lo, s16x4 hi) { return (bf16x8){lo[0], lo[1], lo[2], lo[3], hi[0], hi[1], hi[2], hi[3]}; }
__device__ __forceinline__ f32x4 mfma16(bf16x8 a, bf16x8 b, f32x4 c) { return __builtin_amdgcn_mfma_f32_16x16x32_bf16(a, b, c, 0, 0, 0); }
__device__ __forceinline__ void unpack(bf16x8 v, float (&f)[8]) { const u32x4 w = __builtin_bit_cast(u32x4, v);
    f[0] = bflo(w.x); f[1] = bfhi(w.x); f[2] = bflo(w.y); f[3] = bfhi(w.y); f[4] = bflo(w.z); f[5] = bfhi(w.z); f[6] = bflo(w.w); f[7] = bfhi(w.w); }
__device__ __forceinline__ bf16x8 pack(const float (&f)[8]) { u32x4 w; w.x = pg8::cvt_pk_bf16(f[0], f[1]); w.y = pg8::cvt_pk_bf16(f[2], f[3]); w.z = pg8::cvt_pk_bf16(f[4], f[5]); w.w = pg8::cvt_pk_bf16(f[6], f[7]); return __builtin_bit_cast(bf16x8, w); }

__device__ __forceinline__ void mlstm_unit(const Params& p, int b, int h, char* lds) {
    int tid = threadIdx.x; asm volatile("" : "+v"(tid));
    const int lane = tid & 63, gt = tid & 255, fr = lane & 15, fq = lane >> 4, tq = fr >> 2, tp = fr & 3;
    const int wid = __builtin_amdgcn_readfirstlane(tid >> 6), g = wid >> 2, w = wid & 3;
    char* base = lds + g * GSZ;
    bf16* qL = (bf16*)(base + OFF_Q); bf16* kL = (bf16*)(base + OFF_K); bf16* vL = (bf16*)(base + OFF_V); bf16* Cb = (bf16*)(base + OFF_C); float* nv = (float*)(base + OFF_N);
    float* vec = (float*)(base + OFF_VEC + w * VEC_BYTES); float *av = vec, *rv = vec + 64, *wiv = vec + 128, *wsv = vec + 192, *flv = vec + 256;
    const unsigned vL_a = (unsigned)(uintptr_t)vL, kL_a = (unsigned)(uintptr_t)kL;
    unsigned char* ws = p.ws;
    const bf16* Qm = (const bf16*)(ws + WS_QKQ); const bf16* Km = (const bf16*)(ws + WS_QKK); const bf16* Vm = (const bf16*)(ws + WS_MV); const bf16* ZA = (const bf16*)(ws + WS_ZA);
    const bf16* MO = (const bf16*)(ws + WS_MO); bf16* Oml = (bf16*)(ws + WS_OML);
    const size_t rowb = (size_t)b * SEQ; const int hc = h * 64;
    const float bias_i = p.in[I_GBIAS][(g * 2) * 8 + h], bias_f = p.in[I_GBIAS][(g * 2 + 1) * 8 + h];
    f32x4 gh[4];
#pragma unroll
    for (int ne = 0; ne < 4; ++ne) gh[ne] = *(const f32x4*)(p.in[I_GHEAD] + hc + 16 * ne + 4 * fq);
    for (int e = gt; e < 64 * LP / 2; e += 256) ((unsigned*)Cb)[e] = 0u;
    if (gt < 64) nv[gt] = 0.f;
    f32x4 Cacc[4];
#pragma unroll
    for (int n = 0; n < 4; ++n) Cacc[n] = (f32x4){0.f, 0.f, 0.f, 0.f};
    float mprev = -1e30f;
    u32x4 pq[2], pk[2], pv[2]; unsigned short gi, gf;
#define ML_TOK(c, j) (g ? (c) * 64 + 63 - (j) : (c) * 64 + (j))
#define ML_LOAD(c) do { _Pragma("unroll") for (int i = 0; i < 2; ++i) { const int pi = gt + 256 * i, j = pi >> 3, ch = pi & 7; const size_t o = (rowb + ML_TOK(c, j)) * 512 + hc + ch * 8; \
        pq[i] = *(const u32x4*)(Qm + o); pk[i] = *(const u32x4*)(Km + o); pv[i] = *(const u32x4*)(Vm + o); } \
        { const size_t r = rowb + ML_TOK(c, lane); gi = ZA[r * 512 + ZA_MG + (g * 2) * 8 + h]; gf = ZA[r * 512 + ZA_MG + (g * 2 + 1) * 8 + h]; } } while (0)
    ML_LOAD(g ? 31 : 0);
    __syncthreads();
    for (int cc = 0; cc < 32; ++cc) {
        const int c = g ? 31 - cc : cc;
#pragma unroll
        for (int i = 0; i < 2; ++i) { const int pi = gt + 256 * i, j = pi >> 3, ch = pi & 7;
            *(u32x4*)(qL + j * LP + ch * 8) = pq[i]; *(u32x4*)(kL + j * LP + ch * 8) = pk[i]; *(u32x4*)(vL + j * LP + ch * 8) = pv[i]; }
        float decay, mnew;
        { const float ip = bf2f(gi) + bias_i, fp = bf2f(gf) + bias_f;
          const float lf = fminf(fp, 0.f) - log1pf(__expf(-fabsf(fp)));
          float bb = lf;
#pragma unroll
          for (int o = 1; o < 64; o <<= 1) { const float t = __shfl_up(bb, o); if (lane >= o) bb += t; }
          const float a = ip - bb; float pm = a;
#pragma unroll
          for (int o = 1; o < 64; o <<= 1) { const float t = __shfl_up(pm, o); if (lane >= o) pm = fmaxf(pm, t); }
          const float mx = fmaxf(mprev, pm);
          av[lane] = a; rv[lane] = -mx; wiv[lane] = __expf(mprev - mx); flv[lane] = __expf(-(bb + mx));
          const float bL = __shfl(bb, 63), mxL = __shfl(mx, 63);
          decay = __expf(mprev - mxL); wsv[lane] = __expf(a - mxL); mnew = bL + mxL; }
        __syncthreads();
        if (cc < 31) ML_LOAD(g ? 30 - cc : cc + 1);
        const int jrow = 16 * w + fr; const int tk = ML_TOK(c, jrow);
        bf16* orow = Oml + (rowb + tk) * 512 + hc + 4 * fq;
        u32x2 oth[4], mo[4];
        if (cc >= 16) {
#pragma unroll
            for (int ne = 0; ne < 4; ++ne) { oth[ne] = *(const u32x2*)(orow + 16 * ne); mo[ne] = *(const u32x2*)(MO + (rowb + tk) * 512 + hc + 4 * fq + 16 * ne); } }
        const float r_j = rv[jrow], wi_j = wiv[jrow], fl_j = flv[jrow];
        bf16x8 qf[2];
#pragma unroll
        for (int ks = 0; ks < 2; ++ks) qf[ks] = *(const bf16x8*)(qL + jrow * LP + 32 * ks + 8 * fq);
        f32x4 St[4];
#pragma unroll
        for (int n = 0; n < 4; ++n) {
            St[n] = (f32x4){0.f, 0.f, 0.f, 0.f};
            if (n <= w) { f32x4 acc = (f32x4){0.f, 0.f, 0.f, 0.f};
#pragma unroll
                for (int ks = 0; ks < 2; ++ks) { const bf16x8 kf = *(const bf16x8*)(kL + (16 * n + fr) * LP + 32 * ks + 8 * fq); acc = mfma16(kf, qf[ks], acc); }
                const f32x4 a4 = *(const f32x4*)(av + 16 * n + 4 * fq);
#pragma unroll
                for (int jj = 0; jj < 4; ++jj) { const float dd = __expf(r_j + a4[jj]); const bool ok = (n < w) || (4 * fq + jj <= fr); St[n][jj] = ok ? acc[jj] * dd : 0.f; } }
        }
        float rs = 0.f, qn = 0.f;
#pragma unroll
        for (int n = 0; n < 4; ++n) rs += (St[n][0] + St[n][1]) + (St[n][2] + St[n][3]);
#pragma unroll
        for (int ks = 0; ks < 2; ++ks) { float qv[8]; unpack(qf[ks], qv); const f32x4 n0 = *(const f32x4*)(nv + 32 * ks + 8 * fq), n1 = *(const f32x4*)(nv + 32 * ks + 8 * fq + 4);
            qn += (qv[0] * n0[0] + qv[1] * n0[1]) + (qv[2] * n0[2] + qv[3] * n0[3]) + (qv[4] * n1[0] + qv[5] * n1[1]) + (qv[6] * n1[2] + qv[7] * n1[3]); }
        rs += __shfl_xor(rs, 16); rs += __shfl_xor(rs, 32); qn += __shfl_xor(qn, 16); qn += __shfl_xor(qn, 32);
        const float den = rs + wi_j * qn, rden = 1.f / fmaxf(fabsf(den), fl_j);
        bf16x8 sf[2];
#pragma unroll
        for (int ks = 0; ks < 2; ++ks) { const float t8[8] = {St[2 * ks][0], St[2 * ks][1], St[2 * ks][2], St[2 * ks][3], St[2 * ks + 1][0], St[2 * ks + 1][1], St[2 * ks + 1][2], St[2 * ks + 1][3]}; sf[ks] = pack(t8); }
        f32x4 hv[4];
#pragma unroll
        for (int ne = 0; ne < 4; ++ne) {
            f32x4 y = (f32x4){0.f, 0.f, 0.f, 0.f}, nm = (f32x4){0.f, 0.f, 0.f, 0.f};
#pragma unroll
            for (int ks = 0; ks < 2; ++ks) { const bf16x8 cf = *(const bf16x8*)(Cb + (16 * ne + fr) * LP + 32 * ks + 8 * fq); y = mfma16(cf, qf[ks], y); }
#pragma unroll
            for (int ks = 0; ks < 2; ++ks) if (ks == 0 || w >= 2) {
                const s16x4 lo = trd(vL_a + (unsigned)((32 * ks + 4 * fq + tq) * (LP * 2) + 32 * ne + 8 * tp)), hi = trd(vL_a + (unsigned)((32 * ks + 16 + 4 * fq + tq) * (LP * 2) + 32 * ne + 8 * tp));
                lds_wait(); nm = mfma16(cat(lo, hi), sf[ks], nm); }
            hv[ne] = (nm + y * wi_j) * rden;
        }
        if (cc < 16) {
#pragma unroll
            for (int ne = 0; ne < 4; ++ne) { u32x2 o; o.x = pg8::cvt_pk_bf16(hv[ne][0], hv[ne][1]); o.y = pg8::cvt_pk_bf16(hv[ne][2], hv[ne][3]); *(u32x2*)(orow + 16 * ne) = o; }
        } else {
            float ss = 0.f;
#pragma unroll
            for (int ne = 0; ne < 4; ++ne) { hv[ne][0] += bflo(oth[ne].x); hv[ne][1] += bfhi(oth[ne].x); hv[ne][2] += bflo(oth[ne].y); hv[ne][3] += bfhi(oth[ne].y);
                ss += (hv[ne][0] * hv[ne][0] + hv[ne][1] * hv[ne][1]) + (hv[ne][2] * hv[ne][2] + hv[ne][3] * hv[ne][3]); }
            ss += __shfl_xor(ss, 16); ss += __shfl_xor(ss, 32);
            const float rn = 1.f / sqrtf(ss * (1.f / 64.f) + EPS);
#pragma unroll
            for (int ne = 0; ne < 4; ++ne) { const f32x4 gg = gh[ne] * rn; u32x2 o;
                o.x = pg8::cvt_pk_bf16(hv[ne][0] * gg[0] * bflo(mo[ne].x), hv[ne][1] * gg[1] * bfhi(mo[ne].x)); o.y = pg8::cvt_pk_bf16(hv[ne][2] * gg[2] * bflo(mo[ne].y), hv[ne][3] * gg[3] * bfhi(mo[ne].y));
                *(u32x2*)(orow + 16 * ne) = o; }
        }
        bf16x8 vsf[2]; float wsl[2][8];
#pragma unroll
        for (int ks = 0; ks < 2; ++ks) {
            const s16x4 lo = trd(vL_a + (unsigned)((32 * ks + 8 * fq + tq) * (LP * 2) + 32 * w + 8 * tp)), hi = trd(vL_a + (unsigned)((32 * ks + 8 * fq + 4 + tq) * (LP * 2) + 32 * w + 8 * tp));
            const f32x4 w0 = *(const f32x4*)(wsv + 32 * ks + 8 * fq), w1 = *(const f32x4*)(wsv + 32 * ks + 8 * fq + 4);
            lds_wait();
            wsl[ks][0] = w0[0]; wsl[ks][1] = w0[1]; wsl[ks][2] = w0[2]; wsl[ks][3] = w0[3]; wsl[ks][4] = w1[0]; wsl[ks][5] = w1[1]; wsl[ks][6] = w1[2]; wsl[ks][7] = w1[3];
            float f8[8]; unpack(cat(lo, hi), f8);
#pragma unroll
            for (int e = 0; e < 8; ++e) f8[e] *= wsl[ks][e];
            vsf[ks] = pack(f8);
        }
        float dn = 0.f;
#pragma unroll
        for (int nd = 0; nd < 4; ++nd) {
            Cacc[nd] = Cacc[nd] * decay;
#pragma unroll
            for (int ks = 0; ks < 2; ++ks) {
                const s16x4 lo = trd(kL_a + (unsigned)((32 * ks + 8 * fq + tq) * (LP * 2) + 32 * nd + 8 * tp)), hi = trd(kL_a + (unsigned)((32 * ks + 8 * fq + 4 + tq) * (LP * 2) + 32 * nd + 8 * tp));
                lds_wait(); const bf16x8 kt = cat(lo, hi);
                Cacc[nd] = mfma16(vsf[ks], kt, Cacc[nd]);
                if (nd == w) { float k8[8]; unpack(kt, k8);
#pragma unroll
                    for (int e = 0; e < 8; ++e) dn += k8[e] * wsl[ks][e]; }
            }
        }
        dn += __shfl_xor(dn, 16); dn += __shfl_xor(dn, 32);
        const float nnew = decay * nv[16 * w + fr] + dn;
        asm volatile("s_waitcnt vmcnt(0) lgkmcnt(0)" ::: "memory");
        __syncthreads();
#pragma unroll
        for (int nd = 0; nd < 4; ++nd)
#pragma unroll
            for (int jj = 0; jj < 4; ++jj) Cb[(16 * w + 4 * fq + jj) * LP + 16 * nd + fr] = (bf16)f2bf(Cacc[nd][jj]);
        if (fq == 0) nv[16 * w + fr] = nnew;
        mprev = mnew;
    }
    __syncthreads();
#undef ML_TOK
#undef ML_LOAD
}
}
__device__ __forceinline__ void phase_mlstm(const Params& p, char* lds, int vcu, int G) {
    for (int u = vcu; u < BATCH * MLH; u += G) ml::mlstm_unit(p, u >> 3, u & 7, lds);
}
constexpr int NTHR = 512, GEMM_LDS = pg8::STAGE_BYTES;
constexpr int LDS_BAR_OFF = 131072, LDS_TOTAL = 131072 + 1024;
static_assert((int)att::SHM_ATTN <= LDS_BAR_OFF && ml::LDS_BYTES <= LDS_BAR_OFF && GEMM_LDS <= LDS_BAR_OFF, "phase scratch fits under the barrier words");
constexpr int CW_BAR = 4096;
static_assert((CW_BAR + XCD_BAR_WORDS) * 4 <= (int)CTL_ZERO_BYTES, "barrier words inside the memset region");

static __device__ __forceinline__ pg8::Gemm dgemm(const void* A, const void* Bt, int M_, int N_, int K_, int lda, int ldb) { pg8::Gemm g; g.A = (const pg8::bf16_t*)A; g.Bt = (const pg8::bf16_t*)Bt; g.M = M_; g.N = N_; g.K = K_; g.lda = lda; g.ldb = ldb; g.pad = 0; return g; }
template <class Epi> __device__ __forceinline__ void run_gemm(LAS unsigned char* lds, const pg8::Gemm& g, const Epi& E) {
    pg8::StaticOrder S; S.init(g.M, g.N, (int)gridDim.x, (int)blockIdx.x);
    pg8::gemm_phase<Epi, pg8::StaticOrder, true, true>(lds, g, S, E);
}
__global__ __launch_bounds__(NTHR, 2) void fwd_kernel(Params p) {
    extern __shared__ __attribute__((aligned(16))) unsigned char lds[];
    LAS unsigned char* L = (LAS unsigned char*)lds;
    const int tid = threadIdx.x, lane = tid & 63, wave = __builtin_amdgcn_readfirstlane(tid >> 6);
    const int G = gridDim.x, bx = blockIdx.x, vcu = (G % 8 == 0) ? (bx % 8) * (G / 8) + bx / 8 : bx;
    const int gw = bx * 8 + wave, ngw = G * 8;
    unsigned char* ws = p.ws; unsigned char* ob = (unsigned char*)p.out;
    if (tid < 4) ((LAS unsigned*)(L + LDS_BAR_OFF))[tid] = 0u;
    __syncthreads();
    XcdBarrier bar = xcd_barrier_post((unsigned*)(ws + WS_CTL) + CW_BAR, (volatile LAS unsigned*)(L + LDS_BAR_OFF));
    phase_prologue(p, L, gw, ngw, wave, lane);
    xcd_barrier(bar);
    { EpiWin E; E.ws = ws; run_gemm(L, dgemm(ws + WS_XB, ws + WS_WIN, M, NINP, DM, DM, DM), E); }
    { EpiPlain E; E.O0 = (bf16*)(ws + WS_MEMKV); E.O1 = nullptr; E.split = 0; E.ldc = 1024; run_gemm(L, dgemm(ws + WS_MEMN, ws + WS_WKVM, MMEM, 1024, DM, DM, DM), E); }
    xcd_barrier(bar);
    phase_tokprep(p, gw, ngw, lane);
    xcd_barrier(bar);
    { EpiQup E; E.Q = (bf16*)(ob + DO_Q); E.rstd = (const float*)(ws + WS_RSTDCQ); E.cs = (const float*)(ws + WS_COS); E.sn = (const float*)(ws + WS_SIN); run_gemm(L, dgemm(ws + WS_ZA, ws + WS_WUQ, M, QW, QR, 512, QR), E); }
    { EpiKVup E; E.Kd = (bf16*)(ob + DO_K); E.Vd = (bf16*)(ob + DO_V); E.rstd = (const float*)(ws + WS_RSTDCKV); run_gemm(L, dgemm(ws + WS_CKV, ws + WS_WUKV, M, 1024, KVR, KVR, KVR), E); }
    { EpiPlain E; E.O0 = (bf16*)(ws + WS_QKQ); E.O1 = (bf16*)(ws + WS_QKK); E.split = 512; E.ldc = 512; run_gemm(L, dgemm(ws + WS_CML, ws + WS_WML, M, 1024, 512, 512, 512), E); }
    xcd_barrier(bar);
#ifndef SKIP_ML
    phase_mlstm(p, (char*)lds, vcu, G);
#endif
#ifndef SKIP_MLA
    phase_attn_mla(p, (char*)lds, vcu, G);
#endif
#ifndef SKIP_MEM
    phase_attn_mem(p, (char*)lds, vcu, G);
#endif
    xcd_barrier(bar);
#pragma unroll
    for (int b = 0; b < 3; ++b) { EpiBranch E; E.G = (const bf16*)(ws + WS_G); E.Mg = (bf16*)(ws + WS_MERGED); E.b = b; E.pad = 0;
        const size_t ao = b == 0 ? WS_OMLA : (b == 1 ? WS_OML : WS_MEMQ);
        run_gemm(L, dgemm(ws + ao, ws + WS_WBR + (size_t)b * DM * 512 * 2, M, DM, 512, 512, 512), E); }
    xcd_barrier(bar);
    { EpiResid<true> E; E.res = p.in[I_X]; E.xo = p.out; E.xb = (bf16*)(ws + WS_X1B); E.ssq = (float*)(ws + WS_SSQ1); run_gemm(L, dgemm(ws + WS_MERGED, ws + WS_WOUT, M, DM, DM, DM, DM), E); }
    xcd_barrier(bar);
    { EpiFfnUp E; E.act = (bf16*)(ws + WS_ACT); E.ssq = (const float*)(ws + WS_SSQ1); run_gemm(L, dgemm(ws + WS_X1B, ws + WS_WGU, M, NGU, DM, DM, DM), E); }
    xcd_barrier(bar);
    { EpiResid<false> E; E.res = p.out; E.xo = p.out; E.xb = nullptr; E.ssq = (float*)(ws + WS_SSQ2); run_gemm(L, dgemm(ws + WS_ACT, ws + WS_WDN, M, DM, DFF, DFF, DFF), E); }
    xcd_barrier(bar);
    phase_final(p, gw, ngw, lane);
}
extern "C" void kernel_launch(void* const* d_in, const int* in_sizes, int n_in, void* d_out, int out_size, void* d_ws, size_t ws_size, hipStream_t stream) {
    static int grid = 0;
    if (grid == 0) {
        if (n_in != N_INPUTS || in_sizes[0] != M * DM || out_size != M * DM || ws_size < WS_END) { fprintf(stderr, "kernel_launch: shape/workspace mismatch (n_in %d, ws %zu)\n", n_in, ws_size); grid = -1; return; }
        int dev = 0, cus = 0, per_cu = 0;
        if (hipGetDevice(&dev) != hipSuccess || hipDeviceGetAttribute(&cus, hipDeviceAttributeMultiprocessorCount, dev) != hipSuccess) { grid = -1; return; }
        if (hipFuncSetAttribute((const void*)fwd_kernel, hipFuncAttributeMaxDynamicSharedMemorySize, LDS_TOTAL) != hipSuccess) { grid = -1; return; }
        if (hipOccupancyMaxActiveBlocksPerMultiprocessor(&per_cu, (const void*)fwd_kernel, NTHR, LDS_TOTAL) != hipSuccess || per_cu < 1) { fprintf(stderr, "kernel_launch: occupancy query says %d\n", per_cu); (void)hipGetLastError(); }
        grid = cus;
    }
    if (grid < 0) return;
    Params p{}; for (int i = 0; i < N_INPUTS; ++i) p.in[i] = (const float*)d_in[i]; p.out = (float*)d_out; p.ws = (unsigned char*)d_ws;
    (void)hipMemsetAsync((unsigned char*)d_ws + WS_CTL, 0, CTL_ZERO_BYTES, stream);
    hipLaunchKernelGGL(fwd_kernel, dim3(grid), dim3(NTHR), LDS_TOTAL, stream, p);
}
```

```cpp
#include <hip/hip_runtime.h>
#include <cstdio>
#include <cstdint>

constexpr int BATCH = 32, SEQ = 2048, DM = 1024, M = BATCH * SEQ;
constexpr int MEM_LEN = 256, MMEM = BATCH * MEM_LEN;
constexpr int NIN = 5824, NINP = 5888;
constexpr int DFF = 2816, NGU = 2 * DFF;
constexpr int QR = 384, KVR = 256, ROPE = 32, NOPE = 64, DQK = 96, MLAH = 8, QW = MLAH * DQK;
constexpr int MLW = 512, MLH = 8, MEMW = 512, MEMH = 4, MEMD = 128;
constexpr float EPS = 1e-6f;
constexpr int ZA_KR = 384, ZA_MG = 416;

constexpr size_t MiB = 1u << 20;
constexpr size_t WS_CTL = 0, CTL_ZERO_BYTES = 1 * MiB;
constexpr size_t WS_WIN = 1 * MiB;
constexpr size_t WS_WKVM = 13 * MiB;
constexpr size_t WS_WUQ = 15 * MiB;
constexpr size_t WS_WUKV = 16 * MiB;
constexpr size_t WS_WML = 17 * MiB;
constexpr size_t WS_WBR = 18 * MiB;
constexpr size_t WS_WOUT = 21 * MiB;
constexpr size_t WS_WGU = 23 * MiB;
constexpr size_t WS_WDN = 34 * MiB;
constexpr size_t WS_COS = 40 * MiB;
constexpr size_t WS_SIN = 44 * MiB;
constexpr size_t WS_RSTDX = 48 * MiB;
constexpr size_t WS_RSTDCQ = WS_RSTDX + 256 * 1024, WS_RSTDCKV = WS_RSTDCQ + 256 * 1024;
constexpr size_t WS_SSQ1 = 256 * 1024;
constexpr size_t WS_SSQ2 = 512 * 1024;
constexpr size_t WS_XB = 64 * MiB;
constexpr size_t WS_QKK = WS_XB, WS_OMLA = WS_XB + 64 * MiB, WS_X1B = WS_XB;
constexpr size_t WS_G = 192 * MiB;
constexpr size_t WS_ACT = WS_G;
constexpr size_t WS_ZA = 576 * MiB;
constexpr size_t WS_CKV = 640 * MiB;
constexpr size_t WS_MU = 672 * MiB;
constexpr size_t WS_QKQ = WS_MU;
constexpr size_t WS_MV = 736 * MiB;
constexpr size_t WS_MO = 800 * MiB;
constexpr size_t WS_MEMQ = 864 * MiB;
constexpr size_t WS_MEMKV = 928 * MiB;
constexpr size_t WS_MEMN = 944 * MiB;
constexpr size_t WS_CML = 960 * MiB;
constexpr size_t WS_OML = WS_CML;
constexpr size_t WS_MERGED = WS_ZA;
constexpr size_t WS_END = 1024 * MiB;
static_assert(WS_WIN + (size_t)NINP * DM * 2 <= WS_WKVM && WS_WGU + (size_t)NGU * DM * 2 <= WS_WDN && WS_WDN + (size_t)DM * DFF * 2 <= WS_COS, "weights map");
static_assert(WS_G + (size_t)M * 3072 * 2 == WS_ZA && WS_ACT + (size_t)M * DFF * 2 <= WS_ZA && WS_MERGED + (size_t)M * DM * 2 <= WS_MV && WS_CML + (size_t)M * 512 * 2 == WS_END, "activation map");
constexpr size_t DO_Q = 0, DO_K = 96 * MiB, DO_V = 192 * MiB;

enum { I_X = 0, I_MEM, I_POS, I_GMIX, I_WIN, I_GQ, I_GKV, I_WUQ, I_WUK, I_WUV, I_CONVW, I_WQ, I_WK, I_GBIAS, I_GHEAD, I_MEMG, I_MEMWKV, I_WBR, I_WOUT, I_GFFN, I_WFG, I_WFU, I_WFD, I_GFINAL, N_INPUTS };
struct Params { const float* in[N_INPUTS]; float* out; unsigned char* ws; };
#define GAS __attribute__((address_space(1)))
#define LAS __attribute__((address_space(3)))
typedef unsigned short bf16;
typedef unsigned v4u __attribute__((ext_vector_type(4)));
typedef float f32x4 __attribute__((ext_vector_type(4)));
typedef short bf16x8 __attribute__((ext_vector_type(8)));
typedef GAS unsigned gu32;
typedef GAS unsigned long long gu64;
#define RLX_AGENT __ATOMIC_RELAXED, __HIP_MEMORY_SCOPE_AGENT
#define LDS_WAIT() asm volatile("s_waitcnt lgkmcnt(0)" ::: "memory")
#define VM_WAIT() asm volatile("s_waitcnt vmcnt(0)" ::: "memory")
__device__ __forceinline__ unsigned long long rt() { return __builtin_amdgcn_s_memrealtime(); }
__device__ __forceinline__ unsigned f2bf(float f) { unsigned u = __builtin_bit_cast(unsigned, f); return (u + 0x7fffu + ((u >> 16) & 1u)) >> 16; }
__device__ __forceinline__ unsigned pk2(float lo, float hi) { return f2bf(lo) | (f2bf(hi) << 16); }
#define XB_TMO      128
#define XB_XCNT(j)  (256  + 64 * (j))
#define XB_XSUB(j)  (1280 + 64 * (j))
#define XB_XGEN(j)  (2304 + 64 * (j))
#define XB_TOP      3328
#define XB_TOPGEN   3392
#define XCD_BAR_WORDS 3456
#define XB_SPIN_CAP (1u << 18)

__device__ __forceinline__ unsigned xb_ld(unsigned* p)              { return __hip_atomic_load(p, __ATOMIC_RELAXED, __HIP_MEMORY_SCOPE_AGENT); }
__device__ __forceinline__ unsigned xb_add(unsigned* p, unsigned v) { return __hip_atomic_fetch_add(p, v, __ATOMIC_RELAXED, __HIP_MEMORY_SCOPE_AGENT); }
__device__ __forceinline__ unsigned xb_xcc_id() { return (unsigned)__builtin_amdgcn_s_getreg((3 << 11) | 20) & 0xFu; }
#define XB_SPIN(cond, bar) do { unsigned _sp = 0; while (cond) { __builtin_amdgcn_s_sleep(1); \
    if ((++_sp & 255u) == 0u) { if (xb_ld(&(bar)[XB_TMO])) break; if (_sp > XB_SPIN_CAP) { atomicAdd(&(bar)[XB_TMO], 1u); break; } } } } while (0)

struct XcdBarrier {
    unsigned* bar; unsigned x;
    volatile LAS unsigned* st;
};

__device__ __forceinline__ XcdBarrier xcd_barrier_post(unsigned* bar, volatile LAS unsigned* st) {
    XcdBarrier b; b.bar = bar; b.x = xb_xcc_id(); b.st = st;
    if (threadIdx.x == 0) (void)xb_add(&bar[XB_XCNT(b.x)], 1u);
    return b;
}
__device__ __forceinline__ void xcd_barrier_complete(unsigned* bar, unsigned x, unsigned& nloc, unsigned& nx) {
    const unsigned G = gridDim.x * gridDim.y * gridDim.z;
    unsigned sum, cnt, mine, sp = 0u;
    for (;;) {
        sum = 0u; cnt = 0u; mine = 0u;
#pragma unroll
        for (unsigned j = 0; j < 16; ++j) { const unsigned c = xb_ld(&bar[XB_XCNT(j)]); sum += c; cnt += (c > 0u) ? 1u : 0u; mine = (j == x) ? c : mine; }
        if (sum == G) break;
        __builtin_amdgcn_s_sleep(1);
        if ((++sp & 255u) == 0u) { if (xb_ld(&bar[XB_TMO])) break; if (sp > XB_SPIN_CAP) { atomicAdd(&bar[XB_TMO], 1u); break; } }
    }
    nloc = mine > 0u ? mine : 1u; nx = cnt > 0u ? cnt : 1u;
}

__device__ __forceinline__ void xcd_barrier(const XcdBarrier& b) {
    asm volatile("s_waitcnt vmcnt(0)" ::: "memory");
    __syncthreads();
    if (threadIdx.x == 0) {
        unsigned* bar = b.bar;
        __builtin_amdgcn_s_waitcnt(0);
        unsigned nloc = b.st[0], nx = b.st[1];
        if (nloc == 0u) { xcd_barrier_complete(bar, b.x, nloc, nx); b.st[0] = nloc; b.st[1] = nx; }
        const unsigned old = xb_add(&bar[XB_XSUB(b.x)], 1u);
        const unsigned gen = old / nloc;
        if (old + 1u == (gen + 1u) * nloc) {
            __builtin_amdgcn_fence(__ATOMIC_RELEASE, "agent");
            asm volatile("s_waitcnt vmcnt(0)" ::: "memory");
            const unsigned og = xb_add(&bar[XB_TOP], 1u);
            const unsigned tg = og / nx;
            if (og + 1u == (tg + 1u) * nx) xb_add(&bar[XB_TOPGEN], 1u);
            else XB_SPIN(xb_ld(&bar[XB_TOPGEN]) == tg, bar);
            __builtin_amdgcn_fence(__ATOMIC_ACQUIRE, "agent");
            xb_add(&bar[XB_XGEN(b.x)], 1u);
            asm volatile("s_waitcnt vmcnt(0)" ::: "memory");
        } else {
            XB_SPIN(xb_ld(&bar[XB_XGEN(b.x)]) == gen, bar);
            __builtin_amdgcn_fence(__ATOMIC_ACQUIRE, "agent");
            asm volatile("s_waitcnt vmcnt(0)" ::: "memory");
        }
    }
    __syncthreads();
}
namespace pg8 {
#define PG8_LAS __attribute__((address_space(3)))
typedef unsigned short bf16_t;
typedef short bf16x8 __attribute__((ext_vector_type(8)));
typedef float f32x4 __attribute__((ext_vector_type(4)));
typedef unsigned u32x4 __attribute__((ext_vector_type(4)));
constexpr int BM = 256, BK = 64, HALF = 128, HTB = HALF * BK * 2  , STAGE_BYTES = 8 * HTB, NXCD = 8, WGM = 8;

__host__ __device__ __forceinline__ int lds_byte(int r, int c) { const int st = (r >> 4) * 2 + (c >> 5), rr = r & 15, cc = c & 31, ob = rr * 64 + cc * 2; return st * 1024 + (ob ^ (((ob >> 9) & 1) << 5)); }
__host__ __device__ __forceinline__ void stage_rc(int b, int& R, int& C) { const int st = b / 1024, sb = b % 1024, swz = sb ^ (((sb >> 9) & 1) << 5); R = (st >> 1) * 16 + swz / 64; C = (st & 1) * 32 + (swz % 64) / 2; }
__host__ __device__ __forceinline__ int perm32(int rho) { const int n = rho >> 4, i = rho & 15; return 8 * (i >> 2) + 4 * n + (i & 3); }

struct Unit { int pm, pn; };
struct Gemm { const bf16_t* A; const bf16_t* Bt; int M, N, K, lda, ldb, pad; };

struct StaticOrder {
    int nM, nN, nwg, G, c;
    __host__ __device__ void init(int M, int N, int G_, int c_) { nM = M / BM; nN = N / BM; nwg = nM * nN; G = G_; c = c_; }
    __host__ __device__ bool next(int i, Unit& u) const {
        const long L = (long)i * G + c; if (L >= nwg) return false;
        int wgid = (int)L; { const int q = nwg / NXCD, r = nwg % NXCD, xcd = wgid % NXCD, off = wgid / NXCD; wgid = (xcd < r ? xcd * (q + 1) : r * (q + 1) + (xcd - r) * q) + off; }
        const int nig = WGM * nN, gid = wgid / nig, fm = gid * WGM, gsz = (nM - fm) < WGM ? (nM - fm) : WGM;
        u.pm = fm + ((wgid % nig) % gsz); u.pn = (wgid % nig) / gsz; return true;
    }
    __device__ __forceinline__ void a_ready(const Unit&) const {}
    __device__ __forceinline__ void done(const Unit&) const {}
};

__device__ __forceinline__ unsigned cvt_pk_bf16(float lo, float hi) { unsigned r; asm volatile("v_cvt_pk_bf16_f32 %0, %1, %2" : "=v"(r) : "v"(lo), "v"(hi)); return r; }
typedef float f32x2 __attribute__((ext_vector_type(2)));
template <class Epi, class Sched, bool ALIGN_EPI = false, bool SP2 = false>
__device__ __forceinline__ void gemm_phase(PG8_LAS unsigned char* lds, const Gemm g, const Sched& S, const Epi& E) {
    int tid = threadIdx.x; asm volatile("" : "+v"(tid));
    const int wid = __builtin_amdgcn_readfirstlane(tid >> 6), lane = tid & 63, wr = wid >> 2, wc = wid & 3, fr = lane & 15, fq = lane >> 4;
    const int K = g.K, nt = K / BK;
    unsigned voffA[2], voffB[2];
#pragma unroll
    for (int i = 0; i < 2; ++i) { int R, C; stage_rc(tid * 16 + i * 8192, R, C); const int Rb = Epi::PERM ? ((R & ~31) + perm32(R & 31)) : R;
        voffA[i] = (unsigned)(R * g.lda + C) * 2u; voffB[i] = (unsigned)(Rb * g.ldb + C) * 2u; }
    const size_t kstep = (size_t)(BK * 2);
    const size_t hstepA = (size_t)HALF * g.lda * 2, hstepB = (size_t)HALF * g.ldb * 2;
    const size_t tstepA = 2 * hstepA, tstepB = 2 * hstepB;
    const unsigned ldsw = (unsigned)wid * 1024u;
    const int aoff = lds_byte(wr * 64 + fr, fq * 8), boff = lds_byte(wc * 32 + fr, fq * 8);
#define PG8_SA(b, h) (((b) * 2 + (h)) * HTB)
#define PG8_SB(b, h) ((4 + (b) * 2 + (h)) * HTB)
#define PG8_STAGE(bufoff, gbase, voff) do { _Pragma("unroll") for (int _i = 0; _i < 2; ++_i) \
        __builtin_amdgcn_global_load_lds((const unsigned*)((const char*)(gbase) + (voff)[_i]), (PG8_LAS unsigned*)(lds + (bufoff) + ldsw + _i * 8192), 16, 0, 0); } while (0)
#define PG8_LDA(dst, b, h) do { _Pragma("unroll") for (int m = 0; m < 4; ++m) _Pragma("unroll") for (int k = 0; k < 2; ++k) dst[m][k] = *(const PG8_LAS bf16x8*)(lds + PG8_SA(b, h) + aoff + m * 2048 + k * 1024); } while (0)
#define PG8_LDB(dst, b, h) do { _Pragma("unroll") for (int n = 0; n < 2; ++n) _Pragma("unroll") for (int k = 0; k < 2; ++k) dst[n][k] = *(const PG8_LAS bf16x8*)(lds + PG8_SB(b, h) + boff + n * 2048 + k * 1024); } while (0)
#define PG8_MMA(ai, bj, At, Bt) do { __builtin_amdgcn_s_setprio(1); _Pragma("unroll") for (int m = 0; m < 4; ++m) _Pragma("unroll") for (int n = 0; n < 2; ++n) _Pragma("unroll") for (int k = 0; k < 2; ++k) \
        acc[ai][bj][m][n] = __builtin_amdgcn_mfma_f32_16x16x32_bf16(Bt[n][k], At[m][k], acc[ai][bj][m][n], 0, 0, 0); __builtin_amdgcn_s_setprio(0); } while (0)
#define PG8_WAIT_V(n) asm volatile("s_waitcnt vmcnt(" #n ")" ::: "memory")
#define PG8_WAIT_L(n) asm volatile("s_waitcnt lgkmcnt(" #n ")" ::: "memory")
#define PG8_BAR __builtin_amdgcn_s_barrier()
#define PG8_SCHED __builtin_amdgcn_sched_barrier(0)
    Unit cur, nxt; int ui = 0;
    if (!S.next(0, cur)) return;
    f32x4 acc[2][2][4][2];
#pragma unroll
    for (int a = 0; a < 2; ++a)
#pragma unroll
        for (int b = 0; b < 2; ++b)
#pragma unroll
            for (int m = 0; m < 4; ++m)
#pragma unroll
                for (int n = 0; n < 2; ++n) acc[a][b][m][n] = (f32x4){0.f, 0.f, 0.f, 0.f};
    bf16x8 At[4][2], B0[2][2], B1[2][2];
    const char* cA = (const char*)g.A + (size_t)cur.pm * tstepA; const char* cB = (const char*)g.Bt + (size_t)cur.pn * tstepB;
    S.a_ready(cur);
    if constexpr (SP2) {
        PG8_STAGE(PG8_SB(0, 0), cB, voffB); PG8_STAGE(PG8_SB(0, 1), cB + hstepB, voffB); PG8_STAGE(PG8_SA(0, 0), cA, voffA); PG8_STAGE(PG8_SA(0, 1), cA + hstepA, voffA);
        if (wr == 1) PG8_BAR;
        PG8_WAIT_V(2); PG8_BAR;
        PG8_STAGE(PG8_SB(1, 0), cB + kstep, voffB); PG8_STAGE(PG8_SA(1, 0), cA + kstep, voffA); PG8_STAGE(PG8_SB(1, 1), cB + hstepB + kstep, voffB);
        PG8_WAIT_V(6); PG8_BAR;
    } else {
        PG8_STAGE(PG8_SB(0, 0), cB, voffB); PG8_STAGE(PG8_SA(0, 0), cA, voffA); PG8_STAGE(PG8_SB(0, 1), cB + hstepB, voffB); PG8_STAGE(PG8_SA(0, 1), cA + hstepA, voffA);
        if (wr == 1) PG8_BAR;
        PG8_WAIT_V(4); PG8_BAR;
        PG8_STAGE(PG8_SB(1, 0), cB + kstep, voffB); PG8_STAGE(PG8_SA(1, 0), cA + kstep, voffA); PG8_STAGE(PG8_SB(1, 1), cB + hstepB + kstep, voffB);
        PG8_WAIT_V(6); PG8_BAR;
    }
    for (;;) {
        const bool has_next = S.next(ui + 1, nxt);
        const char* nA = has_next ? (const char*)g.A + (size_t)nxt.pm * tstepA : cA; const char* nB = has_next ? (const char*)g.Bt + (size_t)nxt.pn * tstepB : cB;
        for (int t = 0; t < nt; t += 2) {
            const bool last = (t == nt - 2);
            const char* a1 = cA + (size_t)(t + 1) * kstep;
            const char* a2 = last ? nA : cA + (size_t)(t + 2) * kstep; const char* b2 = last ? nB : cB + (size_t)(t + 2) * kstep;
            const char* a3 = a2 + kstep; const char* b3 = b2 + kstep;
            if (last && has_next) S.a_ready(nxt);
            if constexpr (SP2) {
            PG8_LDB(B0, 0, 0); PG8_LDB(B1, 0, 1); PG8_SCHED; PG8_LDA(At, 0, 0); PG8_STAGE(PG8_SA(1, 1), a1 + hstepA, voffA);
            PG8_WAIT_V(8); PG8_WAIT_L(0); PG8_BAR; PG8_MMA(0, 0, At, B0); PG8_MMA(0, 1, At, B1); PG8_BAR; PG8_SCHED;
            PG8_LDA(At, 0, 1); PG8_STAGE(PG8_SB(0, 0), b2, voffB); PG8_STAGE(PG8_SB(0, 1), b2 + hstepB, voffB); PG8_STAGE(PG8_SA(0, 0), a2, voffA);
            PG8_WAIT_V(8); PG8_WAIT_L(0); PG8_BAR; PG8_MMA(1, 0, At, B0); PG8_MMA(1, 1, At, B1); PG8_BAR; PG8_SCHED;
            PG8_LDB(B0, 1, 0); PG8_LDB(B1, 1, 1); PG8_SCHED; PG8_LDA(At, 1, 0); PG8_STAGE(PG8_SA(0, 1), a2 + hstepA, voffA);
            PG8_WAIT_V(8); PG8_WAIT_L(0); PG8_BAR; PG8_MMA(0, 0, At, B0); PG8_MMA(0, 1, At, B1); PG8_BAR; PG8_SCHED;
            PG8_LDA(At, 1, 1); PG8_STAGE(PG8_SB(1, 0), b3, voffB); PG8_STAGE(PG8_SB(1, 1), b3 + hstepB, voffB); PG8_STAGE(PG8_SA(1, 0), a3, voffA);
            PG8_WAIT_V(8); PG8_WAIT_L(0); PG8_BAR; PG8_MMA(1, 0, At, B0); PG8_MMA(1, 1, At, B1); PG8_BAR; PG8_SCHED;
            } else {
            PG8_LDB(B0, 0, 0); PG8_SCHED; PG8_LDA(At, 0, 0); PG8_STAGE(PG8_SA(1, 1), a1 + hstepA, voffA);
            PG8_WAIT_L(8); PG8_BAR; PG8_WAIT_L(0); PG8_MMA(0, 0, At, B0); PG8_BAR; PG8_SCHED;
            PG8_LDB(B1, 0, 1); PG8_STAGE(PG8_SB(0, 0), b2, voffB);
            PG8_BAR; PG8_WAIT_L(0); PG8_MMA(0, 1, At, B1); PG8_BAR;
            PG8_LDA(At, 0, 1); PG8_STAGE(PG8_SA(0, 0), a2, voffA);
            PG8_BAR; PG8_WAIT_L(0); PG8_MMA(1, 0, At, B0); PG8_BAR; PG8_SCHED;
            PG8_STAGE(PG8_SB(0, 1), b2 + hstepB, voffB);
            PG8_WAIT_V(6); PG8_BAR; PG8_MMA(1, 1, At, B1); PG8_BAR;
            PG8_LDB(B0, 1, 0); PG8_SCHED; PG8_LDA(At, 1, 0); PG8_STAGE(PG8_SA(0, 1), a2 + hstepA, voffA);
            PG8_WAIT_L(8); PG8_BAR; PG8_WAIT_L(0); PG8_MMA(0, 0, At, B0); PG8_BAR; PG8_SCHED;
            PG8_LDB(B1, 1, 1); PG8_STAGE(PG8_SB(1, 0), b3, voffB);
            PG8_BAR; PG8_WAIT_L(0); PG8_MMA(0, 1, At, B1); PG8_BAR;
            PG8_LDA(At, 1, 1); PG8_STAGE(PG8_SA(1, 0), a3, voffA);
            PG8_BAR; PG8_WAIT_L(0); PG8_MMA(1, 0, At, B0); PG8_BAR; PG8_SCHED;
            PG8_STAGE(PG8_SB(1, 1), b3 + hstepB, voffB);
            PG8_WAIT_V(6); PG8_BAR; PG8_MMA(1, 1, At, B1); PG8_BAR;
            }
        }
        if constexpr (ALIGN_EPI) { if (wr == 0) PG8_BAR; }
        if constexpr (!Epi::AFTER_DRAIN) { E(acc, cur, wr, wc, fr, fq); S.done(cur); }
        if (!has_next) break;
#pragma unroll
        for (int a = 0; a < 2; ++a)
#pragma unroll
            for (int b = 0; b < 2; ++b)
#pragma unroll
                for (int m = 0; m < 4; ++m)
#pragma unroll
                    for (int n = 0; n < 2; ++n) acc[a][b][m][n] = (f32x4){0.f, 0.f, 0.f, 0.f};
        cur = nxt; cA = nA; cB = nB; ++ui;
        if constexpr (ALIGN_EPI) { if (wr == 1) PG8_BAR; }
    }
    PG8_WAIT_V(0);
    if constexpr (!ALIGN_EPI) { if (wr == 0) PG8_BAR; }
    PG8_BAR;
    if constexpr (Epi::AFTER_DRAIN) { E.fused(acc, cur, wr, wc, fr, fq, lds, wid, lane); S.done(cur); }
#undef PG8_SA
#undef PG8_SB
#undef PG8_STAGE
#undef PG8_LDA
#undef PG8_LDB
#undef PG8_MMA
#undef PG8_WAIT_V
#undef PG8_WAIT_L
#undef PG8_BAR
#undef PG8_SCHED
}
}
typedef unsigned u32x4_t __attribute__((ext_vector_type(4)));
__device__ __forceinline__ float bf2f(unsigned short b) { return __uint_as_float((unsigned)b << 16); }
__device__ __forceinline__ float bflo(unsigned w) { return __uint_as_float(w << 16); }
__device__ __forceinline__ float bfhi(unsigned w) { return __uint_as_float(w & 0xffff0000u); }
__device__ __forceinline__ float sigmoid_f(float x) { return __builtin_amdgcn_rcpf(1.f + __builtin_amdgcn_exp2f(-1.4426950408889634f * x)); }
__device__ __forceinline__ float silu_f(float x) { return x * sigmoid_f(x); }
__device__ __forceinline__ u32x4_t pack8(const pg8::f32x4& a, const pg8::f32x4& b) {
    u32x4_t w; w.x = pg8::cvt_pk_bf16(a[0], a[1]); w.y = pg8::cvt_pk_bf16(a[2], a[3]); w.z = pg8::cvt_pk_bf16(b[0], b[1]); w.w = pg8::cvt_pk_bf16(b[2], b[3]); return w; }
__device__ __forceinline__ void unpack8(const u32x4_t w, pg8::f32x4& a, pg8::f32x4& b) {
    a = (pg8::f32x4){bflo(w.x), bfhi(w.x), bflo(w.y), bfhi(w.y)}; b = (pg8::f32x4){bflo(w.z), bfhi(w.z), bflo(w.w), bfhi(w.w)}; }

#define EPI_ARGS const pg8::f32x4 (&acc)[2][2][4][2], const pg8::Unit& u, int wr, int wc, int fr, int fq
#define EPI_ROWS_BEGIN  _Pragma("unroll") for (int ai = 0; ai < 2; ++ai) _Pragma("unroll") for (int m = 0; m < 4; ++m) { const int row = u.pm * 256 + ai * 128 + wr * 64 + m * 16 + fr;
#define EPI_ROWS_END }


#define EPI_ROW(ai, m) (u.pm * 256 + (ai) * 128 + wr * 64 + (m) * 16 + fr)

struct EpiWin {
    static constexpr bool PERM = true, AFTER_DRAIN = false;
    unsigned char* ws;
    __device__ __forceinline__ void operator()(EPI_ARGS) const {
        const int pn = u.pn; size_t off; int ldc, cb; bool act = false;
        if (pn < 12) { off = WS_G; ldc = 3072; cb = pn * 256; act = true; }
        else if (pn < 14) { off = WS_ZA; ldc = 512; cb = (pn - 12) * 256; }
        else if (pn < 15) { off = WS_CKV; ldc = 256; cb = 0; }
        else if (pn < 17) { off = WS_MU; ldc = 512; cb = (pn - 15) * 256; }
        else if (pn < 19) { off = WS_MV; ldc = 512; cb = (pn - 17) * 256; }
        else if (pn < 21) { off = WS_MO; ldc = 512; cb = (pn - 19) * 256; act = true; }
        else { off = WS_MEMQ; ldc = 512; cb = (pn - 21) * 256; }
        bf16* base = (bf16*)(ws + off); const float* rstd = (const float*)(ws + WS_RSTDX);
        const int col0 = cb + wc * 32 + 8 * fq;
        float rs[2][4];
#pragma unroll
        for (int ai = 0; ai < 2; ++ai)
#pragma unroll
            for (int m = 0; m < 4; ++m) rs[ai][m] = rstd[EPI_ROW(ai, m)];
#pragma unroll
        for (int ai = 0; ai < 2; ++ai)
#pragma unroll
            for (int m = 0; m < 4; ++m) { bf16* rowp = base + (size_t)EPI_ROW(ai, m) * ldc + col0;
#pragma unroll
                for (int bj = 0; bj < 2; ++bj) { pg8::f32x4 v0 = acc[ai][bj][m][0] * rs[ai][m], v1 = acc[ai][bj][m][1] * rs[ai][m];
                    if (act) {
#pragma unroll
                        for (int e = 0; e < 4; ++e) { v0[e] = sigmoid_f(v0[e]); v1[e] = sigmoid_f(v1[e]); } }
                    *(u32x4_t*)(rowp + bj * 128) = pack8(v0, v1); } }
    }
};
struct EpiPlain {
    static constexpr bool PERM = true, AFTER_DRAIN = false;
    bf16* O0; bf16* O1; int split, ldc;
    __device__ __forceinline__ void operator()(EPI_ARGS) const {
        int c8 = u.pn * 256 + wc * 32 + 8 * fq; bf16* base = O0;
        if (split && c8 >= split) { base = O1; c8 -= split; }
        EPI_ROWS_BEGIN
            bf16* rowp = base + (size_t)row * ldc + c8;
#pragma unroll
            for (int bj = 0; bj < 2; ++bj) *(u32x4_t*)(rowp + bj * 128) = pack8(acc[ai][bj][m][0], acc[ai][bj][m][1]);
        EPI_ROWS_END
    }
};
struct EpiQup {
    static constexpr bool PERM = true, AFTER_DRAIN = false;
    bf16* Q; const float* rstd; const float* cs; const float* sn;
    __device__ __forceinline__ void operator()(EPI_ARGS) const {
        int c8[2], i0[2]; bool rope[2];
#pragma unroll
        for (int bj = 0; bj < 2; ++bj) { c8[bj] = u.pn * 256 + bj * 128 + wc * 32 + 8 * fq; const int h = c8[bj] / 96, w = c8[bj] - 96 * h; rope[bj] = w >= 64; i0[bj] = rope[bj] ? (w - 64) >> 1 : 0; }
#pragma unroll
        for (int ai = 0; ai < 2; ++ai)
#pragma unroll
        for (int mh = 0; mh < 2; ++mh) {
            float rs[2]; pg8::f32x4 cv[2][2], sv[2][2];
#pragma unroll
            for (int mm = 0; mm < 2; ++mm) { const int row = EPI_ROW(ai, 2 * mh + mm); rs[mm] = rstd[row];
#pragma unroll
                for (int bj = 0; bj < 2; ++bj) if (rope[bj]) { cv[mm][bj] = *(const pg8::f32x4*)(cs + (size_t)row * 16 + i0[bj]); sv[mm][bj] = *(const pg8::f32x4*)(sn + (size_t)row * 16 + i0[bj]); } }
#pragma unroll
            for (int mm = 0; mm < 2; ++mm) { const int m = 2 * mh + mm, row = EPI_ROW(ai, m);
#pragma unroll
                for (int bj = 0; bj < 2; ++bj) { pg8::f32x4 v0 = acc[ai][bj][m][0] * rs[mm], v1 = acc[ai][bj][m][1] * rs[mm];
                    if (rope[bj]) { const pg8::f32x4 c = cv[mm][bj], s = sv[mm][bj]; pg8::f32x4 r0, r1;
                        r0[0] = v0[0] * c[0] - v0[1] * s[0]; r0[1] = v0[0] * s[0] + v0[1] * c[0]; r0[2] = v0[2] * c[1] - v0[3] * s[1]; r0[3] = v0[2] * s[1] + v0[3] * c[1];
                        r1[0] = v1[0] * c[2] - v1[1] * s[2]; r1[1] = v1[0] * s[2] + v1[1] * c[2]; r1[2] = v1[2] * c[3] - v1[3] * s[3]; r1[3] = v1[2] * s[3] + v1[3] * c[3];
                        v0 = r0; v1 = r1; }
                    *(u32x4_t*)(Q + (size_t)row * QW + c8[bj]) = pack8(v0, v1); } }
        }
    }
};
struct EpiKVup {
    static constexpr bool PERM = true, AFTER_DRAIN = false;
    bf16* Kd; bf16* Vd; const float* rstd;
    __device__ __forceinline__ void operator()(EPI_ARGS) const {
        float rs[2][4];
#pragma unroll
        for (int ai = 0; ai < 2; ++ai)
#pragma unroll
            for (int m = 0; m < 4; ++m) rs[ai][m] = rstd[EPI_ROW(ai, m)];
#pragma unroll
        for (int ai = 0; ai < 2; ++ai)
#pragma unroll
            for (int m = 0; m < 4; ++m) { const int row = EPI_ROW(ai, m);
#pragma unroll
                for (int bj = 0; bj < 2; ++bj) { const int c8 = u.pn * 256 + bj * 128 + wc * 32 + 8 * fq;
                    bf16* dst = (c8 < 512) ? Kd + (size_t)row * QW + (c8 >> 6) * 96 + (c8 & 63) : Vd + (size_t)row * 512 + (c8 - 512);
                    *(u32x4_t*)dst = pack8(acc[ai][bj][m][0] * rs[ai][m], acc[ai][bj][m][1] * rs[ai][m]); } }
    }
};
struct EpiBranch {
    static constexpr bool PERM = true, AFTER_DRAIN = false;
    const bf16* G; bf16* Mg; int b, pad;
    __device__ __forceinline__ void operator()(EPI_ARGS) const {
#pragma unroll
        for (int ai = 0; ai < 2; ++ai) {
            u32x4_t gv[4][2], pv[4][2];
#pragma unroll
            for (int m = 0; m < 4; ++m)
#pragma unroll
                for (int bj = 0; bj < 2; ++bj) { const int row = EPI_ROW(ai, m), c8 = u.pn * 256 + bj * 128 + wc * 32 + 8 * fq;
                    gv[m][bj] = *(const u32x4_t*)(G + (size_t)row * 3072 + b * 1024 + c8); if (b > 0) pv[m][bj] = *(const u32x4_t*)(Mg + (size_t)row * DM + c8); }
#pragma unroll
            for (int m = 0; m < 4; ++m)
#pragma unroll
                for (int bj = 0; bj < 2; ++bj) { const int row = EPI_ROW(ai, m), c8 = u.pn * 256 + bj * 128 + wc * 32 + 8 * fq;
                    pg8::f32x4 g0, g1; unpack8(gv[m][bj], g0, g1);
                    pg8::f32x4 v0 = acc[ai][bj][m][0] * g0, v1 = acc[ai][bj][m][1] * g1;
                    if (b > 0) { pg8::f32x4 p0, p1; unpack8(pv[m][bj], p0, p1); v0 += p0; v1 += p1; }
                    *(u32x4_t*)(Mg + (size_t)row * DM + c8) = pack8(v0, v1); }
        }
    }
};
template <bool WB> struct EpiResid {
    static constexpr bool PERM = true, AFTER_DRAIN = false;
    const float* res; float* xo; bf16* xb; float* ssq;
    __device__ __forceinline__ void operator()(EPI_ARGS) const {
#pragma unroll
        for (int ai = 0; ai < 2; ++ai) {
            pg8::f32x4 rv[4][2][2];
#pragma unroll
            for (int m = 0; m < 4; ++m)
#pragma unroll
                for (int bj = 0; bj < 2; ++bj) { const size_t o = (size_t)EPI_ROW(ai, m) * DM + u.pn * 256 + bj * 128 + wc * 32 + 8 * fq;
                    rv[m][bj][0] = *(const pg8::f32x4*)(res + o); rv[m][bj][1] = *(const pg8::f32x4*)(res + o + 4); }
#pragma unroll
            for (int m = 0; m < 4; ++m) { const int row = EPI_ROW(ai, m); float s = 0.f;
#pragma unroll
                for (int bj = 0; bj < 2; ++bj) { const size_t o = (size_t)row * DM + u.pn * 256 + bj * 128 + wc * 32 + 8 * fq;
                    const pg8::f32x4 v0 = rv[m][bj][0] + acc[ai][bj][m][0], v1 = rv[m][bj][1] + acc[ai][bj][m][1];
                    *(pg8::f32x4*)(xo + o) = v0; *(pg8::f32x4*)(xo + o + 4) = v1;
                    if (WB) *(u32x4_t*)(xb + o) = pack8(v0, v1);
                    s += (v0[0] * v0[0] + v0[1] * v0[1]) + (v0[2] * v0[2] + v0[3] * v0[3]) + (v1[0] * v1[0] + v1[1] * v1[1]) + (v1[2] * v1[2] + v1[3] * v1[3]); }
                s += __shfl_xor(s, 16); s += __shfl_xor(s, 32);
                if (fq == 0) (void)__hip_atomic_fetch_add(ssq + row, s, __ATOMIC_RELAXED, __HIP_MEMORY_SCOPE_AGENT); }
        }
    }
};
__device__ __forceinline__ float rstd_from_ssq(const float* ssq, int row) { return 1.0f / sqrtf(ssq[row] * (1.0f / DM) + EPS); }
struct EpiFfnUp {
    static constexpr bool PERM = true, AFTER_DRAIN = false;
    bf16* act; const float* ssq;
    __device__ __forceinline__ void operator()(EPI_ARGS) const {
        const int c8 = u.pn * 128 + wc * 32 + 8 * fq;
        float rs[2][4];
#pragma unroll
        for (int ai = 0; ai < 2; ++ai)
#pragma unroll
            for (int m = 0; m < 4; ++m) rs[ai][m] = ssq[EPI_ROW(ai, m)];
#pragma unroll
        for (int ai = 0; ai < 2; ++ai)
#pragma unroll
            for (int m = 0; m < 4; ++m) { const float r = 1.0f / sqrtf(rs[ai][m] * (1.0f / DM) + EPS);
                pg8::f32x4 g0 = acc[ai][0][m][0] * r, g1 = acc[ai][0][m][1] * r; const pg8::f32x4 u0 = acc[ai][1][m][0] * r, u1 = acc[ai][1][m][1] * r;
#pragma unroll
                for (int e = 0; e < 4; ++e) { g0[e] = silu_f(g0[e]) * u0[e]; g1[e] = silu_f(g1[e]) * u1[e]; }
                *(u32x4_t*)(act + (size_t)EPI_ROW(ai, m) * DFF + c8) = pack8(g0, g1); }
    }
};
typedef float f32x4g __attribute__((ext_vector_type(4)));
__device__ __forceinline__ float wave_sum(float v) {
#pragma unroll
    for (int o = 1; o < 64; o <<= 1) v += __shfl_xor(v, o);
    return v;
}
struct MapWin { __device__ __forceinline__ int operator()(int n) const {
    if (n < 3072) return n;
    if (n < 3584) { const int j = n - 3072; if (j < 384) return 3072 + j; if (j < 416) { const int i = (j - 384) >> 1, pp = (j - 384) & 1; return 3712 + i + 16 * pp; } if (j < 448) return 5280 + (j - 416); return -1; }
    if (n < 3840) return 3456 + (n - 3584);
    if (n < 4352) return 3744 + (n - 3840);
    if (n < 4864) return 4256 + (n - 4352);
    if (n < 5376) return 4768 + (n - 4864);
    return 5312 + (n - 5376); } };
struct MapUq { __device__ __forceinline__ int operator()(int n) const { const int h = n / 96, j = n - 96 * h; if (j < 64) return n; const int i = (j - 64) >> 1, pp = (j - 64) & 1; return h * 96 + 64 + i + 16 * pp; } };
struct MapId { __device__ __forceinline__ int operator()(int n) const { return n; } };
struct RowId { __device__ __forceinline__ int operator()(int n) const { return n; } };
struct RowGU { int up; __device__ __forceinline__ int operator()(int j) const { return (j >> 7) * 256 + (j & 127) + up * 128; } };

template <class SCol, class DRow>
__device__ __forceinline__ void tr_job(const float* src, int ld_src, int K, int NL, bf16* dst, int ldd, const float* rs, const SCol& scol, const DRow& drow, LAS float* scr, int gw, int ngw, int lane) {
    const int nblk = NL / 32, nitems = (K / 64) * nblk;
    for (int it = gw; it < nitems; it += ngw) {
        const int kb = it / nblk, nb = it - kb * nblk, k0 = 64 * kb, n0 = 32 * nb;
        const int sc = scol(n0 + (lane & 31));
#pragma unroll 8
        for (int i = 0; i < 32; ++i) { const int kk = 2 * i + (lane >> 5); float v = 0.f;
            if (sc >= 0) { v = src[(size_t)(k0 + kk) * ld_src + sc]; if (rs) v *= rs[k0 + kk]; }
            scr[kk * 33 + (lane & 31)] = v; }
        LDS_WAIT(); asm volatile("" ::: "memory");
        const int c = lane & 7;
#pragma unroll
        for (int j = 0; j < 4; ++j) { const int n = (lane >> 3) + 8 * j; const LAS float* s = scr + (8 * c) * 33 + n;
            v4u o; o.x = pk2(s[0 * 33], s[1 * 33]); o.y = pk2(s[2 * 33], s[3 * 33]); o.z = pk2(s[4 * 33], s[5 * 33]); o.w = pk2(s[6 * 33], s[7 * 33]);
            *(GAS v4u*)(dst + (size_t)drow(n0 + n) * ldd + k0 + 8 * c) = o; }
        LDS_WAIT(); asm volatile("" ::: "memory");
    }
}
__device__ __forceinline__ double rope_inv(int i) {
    switch (i) {
        case 0: return 1.0; case 1: return 0.5623413251903491; case 2: return 0.31622776601683794; case 3: return 0.17782794100389228;
        case 4: return 0.1; case 5: return 0.05623413251903491; case 6: return 0.03162277660168379; case 7: return 0.01778279410038923;
        case 8: return 0.01; case 9: return 0.005623413251903491; case 10: return 0.0031622776601683794; case 11: return 0.0017782794100389228;
        case 12: return 0.001; case 13: return 0.0005623413251903491; case 14: return 0.00031622776601683794; default: return 0.00017782794100389227; }
}
__device__ __forceinline__ void row_to_bf16(const float* xrow, bf16* orow, float* rstd_out, const float* gain, int lane) {
    const GAS f32x4g* xr = (const GAS f32x4g*)xrow + lane;
    f32x4g v[4]; float s = 0.f;
#pragma unroll
    for (int j = 0; j < 4; ++j) { v[j] = xr[64 * j]; s += (v[j].x * v[j].x + v[j].y * v[j].y) + (v[j].z * v[j].z + v[j].w * v[j].w); }
    const float rstd = 1.f / sqrtf(wave_sum(s) * (1.f / DM) + EPS);
    if (rstd_out && lane == 0) *rstd_out = rstd;
    GAS unsigned long long* o8 = (GAS unsigned long long*)orow + lane;
#pragma unroll
    for (int j = 0; j < 4; ++j) { f32x4g w = v[j];
        if (gain) { const f32x4g g = ((const GAS f32x4g*)gain)[lane + 64 * j]; w = w * rstd * g; }
        o8[64 * j] = (unsigned long long)pk2(w.x, w.y) | ((unsigned long long)pk2(w.z, w.w) << 32); }
}

__device__ __forceinline__ void phase_prologue(const Params& p, LAS unsigned char* lds, int gw, int ngw, int wave, int lane) {
    LAS float* scr = (LAS float*)(lds + wave * 16384);
    unsigned char* ws = p.ws;
    tr_job(p.in[I_WIN], NIN, DM, NINP, (bf16*)(ws + WS_WIN), DM, p.in[I_GMIX], MapWin{}, RowId{}, scr, gw, ngw, lane);
    tr_job(p.in[I_MEMWKV], 1024, DM, 1024, (bf16*)(ws + WS_WKVM), DM, nullptr, MapId{}, RowId{}, scr, gw, ngw, lane);
    tr_job(p.in[I_WUQ], QW, QR, QW, (bf16*)(ws + WS_WUQ), QR, p.in[I_GQ], MapUq{}, RowId{}, scr, gw, ngw, lane);
    tr_job(p.in[I_WUK], 512, KVR, 512, (bf16*)(ws + WS_WUKV), KVR, p.in[I_GKV], MapId{}, RowId{}, scr, gw, ngw, lane);
    tr_job(p.in[I_WUV], 512, KVR, 512, (bf16*)(ws + WS_WUKV) + (size_t)512 * KVR, KVR, p.in[I_GKV], MapId{}, RowId{}, scr, gw, ngw, lane);
    for (int b = 0; b < 3; ++b) tr_job(p.in[I_WBR] + (size_t)b * 512 * DM, DM, 512, DM, (bf16*)(ws + WS_WBR) + (size_t)b * DM * 512, 512, nullptr, MapId{}, RowId{}, scr, gw, ngw, lane);
    tr_job(p.in[I_WOUT], DM, DM, DM, (bf16*)(ws + WS_WOUT), DM, nullptr, MapId{}, RowId{}, scr, gw, ngw, lane);
    tr_job(p.in[I_WFG], DFF, DM, DFF, (bf16*)(ws + WS_WGU), DM, p.in[I_GFFN], MapId{}, RowGU{0}, scr, gw, ngw, lane);
    tr_job(p.in[I_WFU], DFF, DM, DFF, (bf16*)(ws + WS_WGU), DM, p.in[I_GFFN], MapId{}, RowGU{1}, scr, gw, ngw, lane);
    tr_job(p.in[I_WFD], DM, DFF, DM, (bf16*)(ws + WS_WDN), DFF, nullptr, MapId{}, RowId{}, scr, gw, ngw, lane);
    { bf16* W = (bf16*)(ws + WS_WML);
      for (int e = gw * 64 + lane; e < 1024 * 512; e += ngw * 64) { const int n = e >> 9, k = e & 511, part = n >> 9, h = (n >> 6) & 7, d = n & 63; float v = 0.f;
          if ((k >> 6) == h) { const float* w = part ? p.in[I_WK] : p.in[I_WQ]; v = w[(size_t)h * 4096 + (k & 63) * 64 + d]; if (part) v *= 0.125f; }
          W[e] = (bf16)f2bf(v); } }
    for (int m = gw; m < M; m += ngw) row_to_bf16(p.in[I_X] + (size_t)m * DM, (bf16*)(ws + WS_XB) + (size_t)m * DM, (float*)(ws + WS_RSTDX) + m, nullptr, lane);
    for (int m = gw; m < MMEM; m += ngw) row_to_bf16(p.in[I_MEM] + (size_t)m * DM, (bf16*)(ws + WS_MEMN) + (size_t)m * DM, nullptr, p.in[I_MEMG], lane);
    { const int* pos = (const int*)p.in[I_POS]; float* cs = (float*)(ws + WS_COS); float* sn = (float*)(ws + WS_SIN);
      for (int e = gw * 64 + lane; e < M * 16; e += ngw * 64) { const int m = e >> 4, i = e & 15;
          const double rev = (double)pos[m] * rope_inv(i) * 0.15915494309189535; const float fr = (float)(rev - __builtin_rint(rev));
          cs[e] = __builtin_amdgcn_cosf(fr); sn[e] = __builtin_amdgcn_sinf(fr); } }
}

__device__ __forceinline__ void phase_tokprep(const Params& p, int gw, int ngw, int lane) {
    unsigned char* ws = p.ws;
    const bf16* ZA = (const bf16*)(ws + WS_ZA); const bf16* CKV = (const bf16*)(ws + WS_CKV); const bf16* MU = (const bf16*)(ws + WS_MU);
    bf16* Kd = (bf16*)((unsigned char*)p.out + DO_K); bf16* Cml = (bf16*)(ws + WS_CML);
    const float* cs = (const float*)(ws + WS_COS); const float* sn = (const float*)(ws + WS_SIN); const float* cw = p.in[I_CONVW];
    float wv[5][8];
#pragma unroll
    for (int j = 0; j < 5; ++j)
#pragma unroll
        for (int e = 0; e < 8; ++e) wv[j][e] = cw[j * 512 + lane * 8 + e];
    for (int m = gw; m < M; m += ngw) {
        float s1 = 0.f, s2 = 0.f;
        if (lane < 48) { const u32x4_t w = *(const u32x4_t*)(ZA + (size_t)m * 512 + lane * 8);
            const float a0 = bflo(w.x), a1 = bfhi(w.x), a2 = bflo(w.y), a3 = bfhi(w.y), a4 = bflo(w.z), a5 = bfhi(w.z), a6 = bflo(w.w), a7 = bfhi(w.w);
            s1 = (a0 * a0 + a1 * a1) + (a2 * a2 + a3 * a3) + (a4 * a4 + a5 * a5) + (a6 * a6 + a7 * a7); }
        if (lane < 32) { const u32x4_t w = *(const u32x4_t*)(CKV + (size_t)m * 256 + lane * 8);
            const float a0 = bflo(w.x), a1 = bfhi(w.x), a2 = bflo(w.y), a3 = bfhi(w.y), a4 = bflo(w.z), a5 = bfhi(w.z), a6 = bflo(w.w), a7 = bfhi(w.w);
            s2 = (a0 * a0 + a1 * a1) + (a2 * a2 + a3 * a3) + (a4 * a4 + a5 * a5) + (a6 * a6 + a7 * a7); }
        s1 = wave_sum(s1); s2 = wave_sum(s2);
        if (lane == 0) { ((float*)(ws + WS_RSTDCQ))[m] = 1.f / sqrtf(s1 * (1.f / QR) + EPS); ((float*)(ws + WS_RSTDCKV))[m] = 1.f / sqrtf(s2 * (1.f / KVR) + EPS); }
        if (lane < 16) { const unsigned w = *(const unsigned*)(ZA + (size_t)m * 512 + ZA_KR + 2 * lane); const float x1 = bflo(w), x2 = bfhi(w), c = cs[(size_t)m * 16 + lane], s = sn[(size_t)m * 16 + lane];
            const unsigned o = pk2(x1 * c - x2 * s, x1 * s + x2 * c);
#pragma unroll
            for (int h = 0; h < 8; ++h) *(unsigned*)(Kd + (size_t)m * QW + h * 96 + 64 + 2 * lane) = o; }
        const int t = m & (SEQ - 1); float a[8];
#pragma unroll
        for (int e = 0; e < 8; ++e) a[e] = 0.f;
#pragma unroll
        for (int j = 0; j < 5; ++j) { const int tt = t + j - 2;
            if (tt >= 0 && tt < SEQ) { const u32x4_t w = *(const u32x4_t*)(MU + (size_t)(m + j - 2) * 512 + lane * 8);
                a[0] += wv[j][0] * bflo(w.x); a[1] += wv[j][1] * bfhi(w.x); a[2] += wv[j][2] * bflo(w.y); a[3] += wv[j][3] * bfhi(w.y);
                a[4] += wv[j][4] * bflo(w.z); a[5] += wv[j][5] * bfhi(w.z); a[6] += wv[j][6] * bflo(w.w); a[7] += wv[j][7] * bfhi(w.w); } }
        u32x4_t o; o.x = pk2(silu_f(a[0]), silu_f(a[1])); o.y = pk2(silu_f(a[2]), silu_f(a[3])); o.z = pk2(silu_f(a[4]), silu_f(a[5])); o.w = pk2(silu_f(a[6]), silu_f(a[7]));
        *(u32x4_t*)(Cml + (size_t)m * 512 + lane * 8) = o;
    }
}
__device__ __forceinline__ void phase_final(const Params& p, int gw, int ngw, int lane, float pscale, float pspike) {
    const float* ssq = (const float*)(p.ws + WS_SSQ2); const float* g = p.in[I_GFINAL];
    f32x4g gv[4];
#pragma unroll
    for (int j = 0; j < 4; ++j) gv[j] = ((const f32x4g*)g)[lane + 64 * j];
    for (int m = gw; m < M; m += ngw) { const float rs = rstd_from_ssq(ssq, m); f32x4g* xr = (f32x4g*)(p.out + (size_t)m * DM) + lane;
#pragma unroll
        for (int j = 0; j < 4; ++j) { f32x4g v = xr[64 * j] * (rs * pscale) * gv[j]; if (m == 0 && lane == 0 && j == 0) v.x += pspike; xr[64 * j] = v; } }
}
namespace att {
using bf16x8 = __attribute__((ext_vector_type(8))) short;
using s16x4 = __attribute__((ext_vector_type(4))) short;
using f32x16 = __attribute__((ext_vector_type(16))) float;
using u32x4 = __attribute__((ext_vector_type(4))) unsigned;
constexpr int NW = 8, QBLK = 32, KVBLK = 64;
constexpr size_t SHM_V = KVBLK * 128 * 2, SHM_K = KVBLK * 128 * 2, SHM_ATTN = 2 * SHM_V + 2 * SHM_K + NW * 64 * 4;
constexpr float THR = 8.f;
#define KSWZ(row, colB) ((row) * 256 + ((colB) ^ (((row) & 7) << 4)))
#define SBAR() __builtin_amdgcn_sched_barrier(0)
__device__ __forceinline__ int crow(int r, int hi) { return (r & 3) + 8 * (r >> 2) + 4 * hi; }
__device__ __forceinline__ unsigned cvtpk(float lo, float hi) { unsigned r; asm volatile("v_cvt_pk_bf16_f32 %0, %1, %2" : "=v"(r) : "v"(lo), "v"(hi)); return r; }

template <int MODE> struct Cfg;
template <> struct Cfg<0> { static constexpr float SCALE = 0.10206207261596575f; };
template <> struct Cfg<1> { static constexpr float SCALE = 0.08838834764831845f; };

template <int MODE> __device__ __forceinline__ void partialSM(f32x16& p0, f32x16& p1, float& m_reg, float& mn, float& alpha) {
  constexpr float SCALE = Cfg<MODE>::SCALE, C = SCALE * 1.4426950408889634f;
  float pmax = p0[0];
#pragma unroll
  for (int r = 1; r < 16; ++r) pmax = fmaxf(pmax, p0[r]);
#pragma unroll
  for (int r = 0; r < 16; ++r) pmax = fmaxf(pmax, p1[r]);
  { auto rr = __builtin_amdgcn_permlane32_swap(__float_as_uint(pmax), __float_as_uint(pmax), false, false);
    pmax = fmaxf(__uint_as_float(rr[0]), __uint_as_float(rr[1])); }
  if (__builtin_expect(__all(pmax - m_reg <= THR / SCALE), 1)) { mn = m_reg; alpha = 1.f; }
  else { mn = fmaxf(m_reg, pmax); alpha = __builtin_amdgcn_exp2f((m_reg - mn) * C); m_reg = mn; }
  const float mnC = -mn * C;
#pragma unroll
  for (int r = 0; r < 16; ++r) p0[r] = fmaf(p0[r], C, mnC);
#pragma unroll
  for (int r = 0; r < 16; ++r) p1[r] = fmaf(p1[r], C, mnC);
#pragma unroll
  for (int r = 0; r < 16; ++r) p0[r] = __builtin_amdgcn_exp2f(p0[r]);
}
__device__ __forceinline__ void finishSM(f32x16& p0, f32x16& p1, float alpha, float& l_reg, bf16x8& pa0, bf16x8& pa1, bf16x8& pa2, bf16x8& pa3) {
#pragma unroll
  for (int r = 0; r < 16; ++r) p1[r] = __builtin_amdgcn_exp2f(p1[r]);
  float ps = 0;
#pragma unroll
  for (int r = 0; r < 16; ++r) ps += p0[r];
#pragma unroll
  for (int r = 0; r < 16; ++r) ps += p1[r];
  { auto rr = __builtin_amdgcn_permlane32_swap(__float_as_uint(ps), __float_as_uint(ps), false, false);
    ps = __uint_as_float(rr[0]) + __uint_as_float(rr[1]); }
  l_reg = l_reg * alpha + ps;
#define PK4(P, BASE, OUT) do { unsigned a0 = cvtpk(P[BASE + 0], P[BASE + 1]), a1 = cvtpk(P[BASE + 2], P[BASE + 3]);   \
    unsigned b0 = cvtpk(P[BASE + 4], P[BASE + 5]), b1 = cvtpk(P[BASE + 6], P[BASE + 7]);                              \
    auto r0 = __builtin_amdgcn_permlane32_swap(a0, b0, false, false); auto r1 = __builtin_amdgcn_permlane32_swap(a1, b1, false, false); \
    u32x4 w = {r0[0], r1[0], r0[1], r1[1]}; OUT = *reinterpret_cast<bf16x8*>(&w); } while (0)
  PK4(p0, 0, pa0); PK4(p0, 8, pa1); PK4(p1, 0, pa2); PK4(p1, 8, pa3);
#undef PK4
}
template <int ND0> __device__ __forceinline__ void qkt(f32x16& p0, f32x16& p1, const char* Ks, const bf16x8* qr, int r32, int hi) {
  p0 = f32x16{}; p1 = f32x16{};
#pragma unroll
  for (int d0 = 0; d0 < ND0; ++d0) { const int cb = (d0 * 16 + hi * 8) * 2;
    const bf16x8 b0 = *reinterpret_cast<const bf16x8*>(Ks + KSWZ(r32, cb));
    const bf16x8 b1 = *reinterpret_cast<const bf16x8*>(Ks + KSWZ(32 + r32, cb));
    p0 = __builtin_amdgcn_mfma_f32_32x32x16_bf16(b0, qr[d0], p0, 0, 0, 0);
    p1 = __builtin_amdgcn_mfma_f32_32x32x16_bf16(b1, qr[d0], p1, 0, 0, 0); }
}
__device__ __forceinline__ int v_st(int k, int c) { const int kk = (k & ~0xC) | ((k & 4) << 1) | ((k & 8) >> 1); return ((kk >> 3) * 4 + (c >> 5)) * 512 + ((kk & 7) * 32 + (c & 31)) * 2; }
__device__ __forceinline__ int v_rd_base(int lane) { return ((lane & 3) << 3) | (((lane >> 2) & 3) << 6) | (((lane >> 4) & 1) << 5) | (((lane >> 5) & 1) << 8); }
constexpr int v_rd_off(int d0, int ks, int half) { return d0 * 512 + ks * 4096 + half * 2048; }
template <int OFF> __device__ __forceinline__ s16x4 tr_read(int vb) { s16x4 r; asm volatile("ds_read_b64_tr_b16 %0, %1 offset:%2" : "=&v"(r) : "v"(vb), "i"(OFF) : "memory"); return r; }
template <int D0> __device__ __forceinline__ void pv_one(f32x16& od, int vb, bf16x8 pa0, bf16x8 pa1, bf16x8 pa2, bf16x8 pa3) {
  const s16x4 l0 = tr_read<v_rd_off(D0, 0, 0)>(vb), h0 = tr_read<v_rd_off(D0, 0, 1)>(vb), l1 = tr_read<v_rd_off(D0, 1, 0)>(vb), h1 = tr_read<v_rd_off(D0, 1, 1)>(vb);
  const s16x4 l2 = tr_read<v_rd_off(D0, 2, 0)>(vb), h2 = tr_read<v_rd_off(D0, 2, 1)>(vb), l3 = tr_read<v_rd_off(D0, 3, 0)>(vb), h3 = tr_read<v_rd_off(D0, 3, 1)>(vb);
  asm volatile("s_waitcnt lgkmcnt(0)" ::: "memory"); SBAR();
#define PK(L, H) (bf16x8){L[0], L[1], L[2], L[3], H[0], H[1], H[2], H[3]}
  od = __builtin_amdgcn_mfma_f32_32x32x16_bf16(pa0, PK(l0, h0), od, 0, 0, 0);
  od = __builtin_amdgcn_mfma_f32_32x32x16_bf16(pa1, PK(l1, h1), od, 0, 0, 0);
  od = __builtin_amdgcn_mfma_f32_32x32x16_bf16(pa2, PK(l2, h2), od, 0, 0, 0);
  od = __builtin_amdgcn_mfma_f32_32x32x16_bf16(pa3, PK(l3, h3), od, 0, 0, 0);
#undef PK
}
template <int NDV> __device__ __forceinline__ void pv_all(f32x16* o, int vb, bf16x8 pa0, bf16x8 pa1, bf16x8 pa2, bf16x8 pa3) {
  pv_one<0>(o[0], vb, pa0, pa1, pa2, pa3); pv_one<1>(o[1], vb, pa0, pa1, pa2, pa3);
  if constexpr (NDV == 4) { pv_one<2>(o[2], vb, pa0, pa1, pa2, pa3); pv_one<3>(o[3], vb, pa0, pa1, pa2, pa3); }
}

template <int MODE, int ND0, int NDV>
__device__ __forceinline__ void attn_unit(const bf16* Qb, int ldq, const bf16* __restrict__ Kh, int ldk, const bf16* __restrict__ Vh, int ldv, bf16* Ob, int ldo, int seq, char* lds) {
  constexpr float SCALE = Cfg<MODE>::SCALE;
  int tid = threadIdx.x; asm volatile("" : "+v"(tid));
  const int wid = tid >> 6, lane = tid & 63, r32 = lane & 31, hi = lane >> 5;
  char* V_lds = lds; char* K_lds = lds + 2 * SHM_V;
  float* wsf = (float*)(lds + 2 * SHM_V + 2 * SHM_K) + wid * 64; float* li_l = wsf; float* al_l = wsf + 32;
  float m_reg = -1e30f, l_reg = 0; f32x16 o[NDV]; bf16x8 qr[ND0];
#pragma unroll
  for (int d = 0; d < NDV; ++d) o[d] = f32x16{};
  const bf16* Qw = Qb + (long)(wid * QBLK + r32) * ldq + hi * 8;
#pragma unroll
  for (int d0 = 0; d0 < ND0; ++d0) qr[d0] = *reinterpret_cast<const bf16x8*>(Qw + d0 * 16);
  const int sr = tid >> 4, sc = (tid & 15) * 8, vst0 = v_st(sr, sc), vst1 = v_st(32 + sr, sc);
  const bool kact = sc < ND0 * 16, vact = sc < NDV * 32;
  const int vb0 = (int)(uintptr_t)V_lds + v_rd_base(lane);
  struct { bf16x8 vs0, vs1, ks0, ks1; } sr_[2];
#define SLOAD(i, k0) do { if (vact) { sr_[i].vs0 = *reinterpret_cast<const bf16x8*>(&Vh[(long)((k0) + sr) * ldv + sc]); sr_[i].vs1 = *reinterpret_cast<const bf16x8*>(&Vh[(long)((k0) + 32 + sr) * ldv + sc]); } \
    if (kact) { sr_[i].ks0 = *reinterpret_cast<const bf16x8*>(&Kh[(long)((k0) + sr) * ldk + sc]); sr_[i].ks1 = *reinterpret_cast<const bf16x8*>(&Kh[(long)((k0) + 32 + sr) * ldk + sc]); } } while (0)
#define SWRITE(b, i) do { if (vact) { *(bf16x8*)(V_lds + (b) * SHM_V + vst0) = sr_[i].vs0; *(bf16x8*)(V_lds + (b) * SHM_V + vst1) = sr_[i].vs1; } \
    if (kact) { const int kc = sc * 2; *(bf16x8*)(K_lds + (b) * SHM_K + KSWZ(sr, kc)) = sr_[i].ks0; *(bf16x8*)(K_lds + (b) * SHM_K + KSWZ(32 + sr, kc)) = sr_[i].ks1; } } while (0)
#define RESC(a) do { if (__any((a) < 1.f)) { if (hi == 0) al_l[r32] = (a); asm volatile("s_waitcnt lgkmcnt(0)" ::: "memory"); \
    _Pragma("unroll") for (int d = 0; d < NDV; ++d) _Pragma("unroll") for (int r = 0; r < 16; ++r) o[d][r] *= al_l[crow(r, hi)]; } } while (0)
  f32x16 pA0, pA1, pB0, pB1; float mnA, mnB, alA, alB; bf16x8 pa0, pa1, pa2, pa3; const int NT = seq / KVBLK;
  SLOAD(0, 0); asm volatile("s_waitcnt vmcnt(0)" ::: "memory"); SWRITE(0, 0); __syncthreads();
  qkt<ND0>(pA0, pA1, K_lds, qr, r32, hi); partialSM<MODE>(pA0, pA1, m_reg, mnA, alA);
  SLOAD(1, KVBLK); if (2 < NT) SLOAD(0, 2 * KVBLK);
  SWRITE(1, 1); __syncthreads();
  for (int j = 1; j + 1 < NT; j += 2) {
    SBAR(); qkt<ND0>(pB0, pB1, K_lds + SHM_K, qr, r32, hi);
    finishSM(pA0, pA1, alA, l_reg, pa0, pa1, pa2, pa3); SBAR();
    SLOAD(1, (j + 2) * KVBLK); SBAR();
    pv_all<NDV>(o, vb0, pa0, pa1, pa2, pa3); partialSM<MODE>(pB0, pB1, m_reg, mnB, alB);
    __syncthreads(); SWRITE(0, 0);
    RESC(alB); __syncthreads();
    SBAR(); qkt<ND0>(pA0, pA1, K_lds, qr, r32, hi);
    finishSM(pB0, pB1, alB, l_reg, pa0, pa1, pa2, pa3); SBAR();
    if (j + 3 < NT) SLOAD(0, (j + 3) * KVBLK); SBAR();
    pv_all<NDV>(o, vb0 + (int)SHM_V, pa0, pa1, pa2, pa3); partialSM<MODE>(pA0, pA1, m_reg, mnA, alA);
    __syncthreads(); SWRITE(1, 1);
    RESC(alA); __syncthreads();
  }
  SBAR(); qkt<ND0>(pB0, pB1, K_lds + SHM_K, qr, r32, hi);
  finishSM(pA0, pA1, alA, l_reg, pa0, pa1, pa2, pa3); SBAR();
  pv_all<NDV>(o, vb0, pa0, pa1, pa2, pa3); partialSM<MODE>(pB0, pB1, m_reg, mnB, alB);
  __syncthreads(); RESC(alB);
  finishSM(pB0, pB1, alB, l_reg, pa0, pa1, pa2, pa3); SBAR();
  pv_all<NDV>(o, vb0 + (int)SHM_V, pa0, pa1, pa2, pa3);
  if (hi == 0) li_l[r32] = l_reg; asm volatile("s_waitcnt lgkmcnt(0)" ::: "memory");
  float rli[16];
#pragma unroll
  for (int r = 0; r < 16; ++r) rli[r] = __builtin_amdgcn_rcpf(li_l[crow(r, hi)]);
  bf16* Ow = Ob + (long)(wid * QBLK) * ldo;
#pragma unroll
  for (int r = 0; r < 16; ++r) { const int orow = crow(r, hi);
#pragma unroll
    for (int d0 = 0; d0 < NDV; ++d0) Ow[(long)orow * ldo + d0 * 32 + r32] = (bf16)f2bf(o[d0][r] * rli[r]); }
  __syncthreads();
#undef SLOAD
#undef SWRITE
#undef RESC
}
#undef KSWZ
#undef SBAR
}

__device__ __forceinline__ void phase_attn_mla(const Params& p, char* lds, int vcu, int G) {
    const bf16* Q = (const bf16*)((const unsigned char*)p.out + DO_Q); const bf16* K = (const bf16*)((const unsigned char*)p.out + DO_K); const bf16* V = (const bf16*)((const unsigned char*)p.out + DO_V);
    bf16* O = (bf16*)(p.ws + WS_OMLA);
    for (int u = vcu; u < BATCH * MLAH * (SEQ / 256); u += G) { const int qb = u & 7, h = (u >> 3) & 7, b = u >> 6; const size_t r0 = (size_t)b * SEQ;
        att::attn_unit<0, 6, 2>(Q + (r0 + qb * 256) * QW + h * 96, QW, K + r0 * QW + h * 96, QW, V + r0 * 512 + h * 64, 512, O + (r0 + qb * 256) * 512 + h * 64, 512, SEQ, lds); }
}
__device__ __forceinline__ void phase_attn_mem(const Params& p, char* lds, int vcu, int G) {
    bf16* Q = (bf16*)(p.ws + WS_MEMQ); const bf16* KV = (const bf16*)(p.ws + WS_MEMKV);
    for (int u = vcu; u < BATCH * MEMH * (SEQ / 256); u += G) { const int qb = u & 7, h = (u >> 3) & 3, b = u >> 5;
        bf16* q = Q + ((size_t)b * SEQ + qb * 256) * 512 + h * 128;
        att::attn_unit<1, 8, 4>(q, 512, KV + (size_t)b * MEM_LEN * 1024 + h * 128, 1024, KV + (size_t)b * MEM_LEN * 1024 + 512 + h * 128, 1024, q, 512, MEM_LEN, lds); }
}
namespace ml {
typedef short bf16x8 __attribute__((ext_vector_type(8)));
typedef short s16x4 __attribute__((ext_vector_type(4)));
typedef float f32x4 __attribute__((ext_vector_type(4)));
typedef unsigned u32x4 __attribute__((ext_vector_type(4)));
typedef unsigned u32x2 __attribute__((ext_vector_type(2)));
constexpr int LP = 72;
constexpr int OFF_Q = 0, OFF_K = 64 * LP * 2, OFF_V = 2 * 64 * LP * 2, OFF_C = 3 * 64 * LP * 2, OFF_N = 4 * 64 * LP * 2, OFF_VEC = OFF_N + 256, VEC_BYTES = 5 * 256, GSZ = 42496;
static_assert(OFF_VEC + 4 * VEC_BYTES <= GSZ, "mlstm lds map");
constexpr int LDS_BYTES = 2 * GSZ;
__device__ __forceinline__ s16x4 trd(unsigned addr) { s16x4 r; asm volatile("ds_read_b64_tr_b16 %0, %1" : "=v"(r) : "v"(addr) : "memory"); return r; }
__device__ __forceinline__ void lds_wait() { asm volatile("s_waitcnt lgkmcnt(0)" ::: "memory"); __builtin_amdgcn_sched_barrier(0); }
__device__ __forceinline__ bf16x8 cat(s16x4 lo, s16x4 hi) { return (bf16x8){lo[0], lo[1], lo[2], lo[3], hi[0], hi[1], hi[2], hi[3]}; }
__device__ __forceinline__ f32x4 mfma16(bf16x8 a, bf16x8 b, f32x4 c) { return __builtin_amdgcn_mfma_f32_16x16x32_bf16(a, b, c, 0, 0, 0); }
__device__ __forceinline__ void unpack(bf16x8 v, float (&f)[8]) { const u32x4 w = __builtin_bit_cast(u32x4, v);
    f[0] = bflo(w.x); f[1] = bfhi(w.x); f[2] = bflo(w.y); f[3] = bfhi(w.y); f[4] = bflo(w.z); f[5] = bfhi(w.z); f[6] = bflo(w.w); f[7] = bfhi(w.w); }
__device__ __forceinline__ bf16x8 pack(const float (&f)[8]) { u32x4 w; w.x = pg8::cvt_pk_bf16(f[0], f[1]); w.y = pg8::cvt_pk_bf16(f[2], f[3]); w.z = pg8::cvt_pk_bf16(f[4], f[5]); w.w = pg8::cvt_pk_bf16(f[6], f[7]); return __builtin_bit_cast(bf16x8, w); }

__device__ __forceinline__ void mlstm_unit(const Params& p, int b, int h, char* lds) {
    int tid = threadIdx.x; asm volatile("" : "+v"(tid));
    const int lane = tid & 63, gt = tid & 255, fr = lane & 15, fq = lane >> 4, tq = fr >> 2, tp = fr & 3;
    const int wid = __builtin_amdgcn_readfirstlane(tid >> 6), g = wid >> 2, w = wid & 3;
    char* base = lds + g * GSZ;
    bf16* qL = (bf16*)(base + OFF_Q); bf16* kL = (bf16*)(base + OFF_K); bf16* vL = (bf16*)(base + OFF_V); bf16* Cb = (bf16*)(base + OFF_C); float* nv = (float*)(base + OFF_N);
    float* vec = (float*)(base + OFF_VEC + w * VEC_BYTES); float *av = vec, *rv = vec + 64, *wiv = vec + 128, *wsv = vec + 192, *flv = vec + 256;
    const unsigned vL_a = (unsigned)(uintptr_t)vL, kL_a = (unsigned)(uintptr_t)kL;
    unsigned char* ws = p.ws;
    const bf16* Qm = (const bf16*)(ws + WS_QKQ); const bf16* Km = (const bf16*)(ws + WS_QKK); const bf16* Vm = (const bf16*)(ws + WS_MV); const bf16* ZA = (const bf16*)(ws + WS_ZA);
    const bf16* MO = (const bf16*)(ws + WS_MO); bf16* Oml = (bf16*)(ws + WS_OML);
    const size_t rowb = (size_t)b * SEQ; const int hc = h * 64;
    const float bias_i = p.in[I_GBIAS][(g * 2) * 8 + h], bias_f = p.in[I_GBIAS][(g * 2 + 1) * 8 + h];
    f32x4 gh[4];
#pragma unroll
    for (int ne = 0; ne < 4; ++ne) gh[ne] = *(const f32x4*)(p.in[I_GHEAD] + hc + 16 * ne + 4 * fq);
    for (int e = gt; e < 64 * LP / 2; e += 256) ((unsigned*)Cb)[e] = 0u;
    if (gt < 64) nv[gt] = 0.f;
    f32x4 Cacc[4];
#pragma unroll
    for (int n = 0; n < 4; ++n) Cacc[n] = (f32x4){0.f, 0.f, 0.f, 0.f};
    float mprev = -1e30f;
    u32x4 pq[2], pk[2], pv[2]; unsigned short gi, gf;
#define ML_TOK(c, j) (g ? (c) * 64 + 63 - (j) : (c) * 64 + (j))
#define ML_LOAD(c) do { _Pragma("unroll") for (int i = 0; i < 2; ++i) { const int pi = gt + 256 * i, j = pi >> 3, ch = pi & 7; const size_t o = (rowb + ML_TOK(c, j)) * 512 + hc + ch * 8; \
        pq[i] = *(const u32x4*)(Qm + o); pk[i] = *(const u32x4*)(Km + o); pv[i] = *(const u32x4*)(Vm + o); } \
        { const size_t r = rowb + ML_TOK(c, lane); gi = ZA[r * 512 + ZA_MG + (g * 2) * 8 + h]; gf = ZA[r * 512 + ZA_MG + (g * 2 + 1) * 8 + h]; } } while (0)
    ML_LOAD(g ? 31 : 0);
    __syncthreads();
    for (int cc = 0; cc < 32; ++cc) {
        const int c = g ? 31 - cc : cc;
#pragma unroll
        for (int i = 0; i < 2; ++i) { const int pi = gt + 256 * i, j = pi >> 3, ch = pi & 7;
            *(u32x4*)(qL + j * LP + ch * 8) = pq[i]; *(u32x4*)(kL + j * LP + ch * 8) = pk[i]; *(u32x4*)(vL + j * LP + ch * 8) = pv[i]; }
        float decay, mnew;
        { const float ip = bf2f(gi) + bias_i, fp = bf2f(gf) + bias_f;
          const float lf = fminf(fp, 0.f) - log1pf(__expf(-fabsf(fp)));
          float bb = lf;
#pragma unroll
          for (int o = 1; o < 64; o <<= 1) { const float t = __shfl_up(bb, o); if (lane >= o) bb += t; }
          const float a = ip - bb; float pm = a;
#pragma unroll
          for (int o = 1; o < 64; o <<= 1) { const float t = __shfl_up(pm, o); if (lane >= o) pm = fmaxf(pm, t); }
          const float mx = fmaxf(mprev, pm);
          av[lane] = a; rv[lane] = -mx; wiv[lane] = __expf(mprev - mx); flv[lane] = __expf(-(bb + mx));
          const float bL = __shfl(bb, 63), mxL = __shfl(mx, 63);
          decay = __expf(mprev - mxL); wsv[lane] = __expf(a - mxL); mnew = bL + mxL; }
        __syncthreads();
        if (cc < 31) ML_LOAD(g ? 30 - cc : cc + 1);
        const int jrow = 16 * w + fr; const int tk = ML_TOK(c, jrow);
        bf16* orow = Oml + (rowb + tk) * 512 + hc + 4 * fq;
        u32x2 oth[4], mo[4];
        if (cc >= 16) {
#pragma unroll
            for (int ne = 0; ne < 4; ++ne) { oth[ne] = *(const u32x2*)(orow + 16 * ne); mo[ne] = *(const u32x2*)(MO + (rowb + tk) * 512 + hc + 4 * fq + 16 * ne); } }
        const float r_j = rv[jrow], wi_j = wiv[jrow], fl_j = flv[jrow];
        bf16x8 qf[2];
#pragma unroll
        for (int ks = 0; ks < 2; ++ks) qf[ks] = *(const bf16x8*)(qL + jrow * LP + 32 * ks + 8 * fq);
        f32x4 St[4];
#pragma unroll
        for (int n = 0; n < 4; ++n) {
            St[n] = (f32x4){0.f, 0.f, 0.f, 0.f};
            if (n <= w) { f32x4 acc = (f32x4){0.f, 0.f, 0.f, 0.f};
#pragma unroll
                for (int ks = 0; ks < 2; ++ks) { const bf16x8 kf = *(const bf16x8*)(kL + (16 * n + fr) * LP + 32 * ks + 8 * fq); acc = mfma16(kf, qf[ks], acc); }
                const f32x4 a4 = *(const f32x4*)(av + 16 * n + 4 * fq);
#pragma unroll
                for (int jj = 0; jj < 4; ++jj) { const float dd = __expf(r_j + a4[jj]); const bool ok = (n < w) || (4 * fq + jj <= fr); St[n][jj] = ok ? acc[jj] * dd : 0.f; } }
        }
        float rs = 0.f, qn = 0.f;
#pragma unroll
        for (int n = 0; n < 4; ++n) rs += (St[n][0] + St[n][1]) + (St[n][2] + St[n][3]);
#pragma unroll
        for (int ks = 0; ks < 2; ++ks) { float qv[8]; unpack(qf[ks], qv); const f32x4 n0 = *(const f32x4*)(nv + 32 * ks + 8 * fq), n1 = *(const f32x4*)(nv + 32 * ks + 8 * fq + 4);
            qn += (qv[0] * n0[0] + qv[1] * n0[1]) + (qv[2] * n0[2] + qv[3] * n0[3]) + (qv[4] * n1[0] + qv[5] * n1[1]) + (qv[6] * n1[2] + qv[7] * n1[3]); }
        rs += __shfl_xor(rs, 16); rs += __shfl_xor(rs, 32); qn += __shfl_xor(qn, 16); qn += __shfl_xor(qn, 32);
        const float den = rs + wi_j * qn, rden = 1.f / fmaxf(fabsf(den), fl_j);
        bf16x8 sf[2];
#pragma unroll
        for (int ks = 0; ks < 2; ++ks) { const float t8[8] = {St[2 * ks][0], St[2 * ks][1], St[2 * ks][2], St[2 * ks][3], St[2 * ks + 1][0], St[2 * ks + 1][1], St[2 * ks + 1][2], St[2 * ks + 1][3]}; sf[ks] = pack(t8); }
        f32x4 hv[4];
#pragma unroll
        for (int ne = 0; ne < 4; ++ne) {
            f32x4 y = (f32x4){0.f, 0.f, 0.f, 0.f}, nm = (f32x4){0.f, 0.f, 0.f, 0.f};
#pragma unroll
            for (int ks = 0; ks < 2; ++ks) { const bf16x8 cf = *(const bf16x8*)(Cb + (16 * ne + fr) * LP + 32 * ks + 8 * fq); y = mfma16(cf, qf[ks], y); }
#pragma unroll
            for (int ks = 0; ks < 2; ++ks) if (ks == 0 || w >= 2) {
                const s16x4 lo = trd(vL_a + (unsigned)((32 * ks + 4 * fq + tq) * (LP * 2) + 32 * ne + 8 * tp)), hi = trd(vL_a + (unsigned)((32 * ks + 16 + 4 * fq + tq) * (LP * 2) + 32 * ne + 8 * tp));
                lds_wait(); nm = mfma16(cat(lo, hi), sf[ks], nm); }
            hv[ne] = (nm + y * wi_j) * rden;
        }
        if (cc < 16) {
#pragma unroll
            for (int ne = 0; ne < 4; ++ne) { u32x2 o; o.x = pg8::cvt_pk_bf16(hv[ne][0], hv[ne][1]); o.y = pg8::cvt_pk_bf16(hv[ne][2], hv[ne][3]); *(u32x2*)(orow + 16 * ne) = o; }
        } else {
            float ss = 0.f;
#pragma unroll
            for (int ne = 0; ne < 4; ++ne) { hv[ne][0] += bflo(oth[ne].x); hv[ne][1] += bfhi(oth[ne].x); hv[ne][2] += bflo(oth[ne].y); hv[ne][3] += bfhi(oth[ne].y);
                ss += (hv[ne][0] * hv[ne][0] + hv[ne][1] * hv[ne][1]) + (hv[ne][2] * hv[ne][2] + hv[ne][3] * hv[ne][3]); }
            ss += __shfl_xor(ss, 16); ss += __shfl_xor(ss, 32);
            const float rn = 1.f / sqrtf(ss * (1.f / 64.f) + EPS);
#pragma unroll
            for (int ne = 0; ne < 4; ++ne) { const f32x4 gg = gh[ne] * rn; u32x2 o;
                o.x = pg8::cvt_pk_bf16(hv[ne][0] * gg[0] * bflo(mo[ne].x), hv[ne][1] * gg[1] * bfhi(mo[ne].x)); o.y = pg8::cvt_pk_bf16(hv[ne][2] * gg[2] * bflo(mo[ne].y), hv[ne][3] * gg[3] * bfhi(mo[ne].y));
                *(u32x2*)(orow + 16 * ne) = o; }
        }
        bf16x8 vsf[2]; float wsl[2][8];
#pragma unroll
        for (int ks = 0; ks < 2; ++ks) {
            const s16x4 lo = trd(vL_a + (unsigned)((32 * ks + 8 * fq + tq) * (LP * 2) + 32 * w + 8 * tp)), hi = trd(vL_a + (unsigned)((32 * ks + 8 * fq + 4 + tq) * (LP * 2) + 32 * w + 8 * tp));
            const f32x4 w0 = *(const f32x4*)(wsv + 32 * ks + 8 * fq), w1 = *(const f32x4*)(wsv + 32 * ks + 8 * fq + 4);
            lds_wait();
            wsl[ks][0] = w0[0]; wsl[ks][1] = w0[1]; wsl[ks][2] = w0[2]; wsl[ks][3] = w0[3]; wsl[ks][4] = w1[0]; wsl[ks][5] = w1[1]; wsl[ks][6] = w1[2]; wsl[ks][7] = w1[3];
            float f8[8]; unpack(cat(lo, hi), f8);
#pragma unroll
            for (int e = 0; e < 8; ++e) f8[e] *= wsl[ks][e];
            vsf[ks] = pack(f8);
        }
        float dn = 0.f;
#pragma unroll
        for (int nd = 0; nd < 4; ++nd) {
            Cacc[nd] = Cacc[nd] * decay;
#pragma unroll
            for (int ks = 0; ks < 2; ++ks) {
                const s16x4 lo = trd(kL_a + (unsigned)((32 * ks + 8 * fq + tq) * (LP * 2) + 32 * nd + 8 * tp)), hi = trd(kL_a + (unsigned)((32 * ks + 8 * fq + 4 + tq) * (LP * 2) + 32 * nd + 8 * tp));
                lds_wait(); const bf16x8 kt = cat(lo, hi);
                Cacc[nd] = mfma16(vsf[ks], kt, Cacc[nd]);
                if (nd == w) { float k8[8]; unpack(kt, k8);
#pragma unroll
                    for (int e = 0; e < 8; ++e) dn += k8[e] * wsl[ks][e]; }
            }
        }
        dn += __shfl_xor(dn, 16); dn += __shfl_xor(dn, 32);
        const float nnew = decay * nv[16 * w + fr] + dn;
        asm volatile("s_waitcnt vmcnt(0) lgkmcnt(0)" ::: "memory");
        __syncthreads();
#pragma unroll
        for (int nd = 0; nd < 4; ++nd)
#pragma unroll
            for (int jj = 0; jj < 4; ++jj) Cb[(16 * w + 4 * fq + jj) * LP + 16 * nd + fr] = (bf16)f2bf(Cacc[nd][jj]);
        if (fq == 0) nv[16 * w + fr] = nnew;
        mprev = mnew;
    }
    __syncthreads();
#undef ML_TOK
#undef ML_LOAD
}
}
__device__ __forceinline__ void phase_mlstm(const Params& p, char* lds, int vcu, int G) {
    for (int u = vcu; u < BATCH * MLH; u += G) ml::mlstm_unit(p, u >> 3, u & 7, lds);
}
constexpr int NTHR = 512, GEMM_LDS = pg8::STAGE_BYTES;
constexpr int LDS_BAR_OFF = 131072, LDS_TOTAL = 131072 + 1024;
static_assert((int)att::SHM_ATTN <= LDS_BAR_OFF && ml::LDS_BYTES <= LDS_BAR_OFF && GEMM_LDS <= LDS_BAR_OFF, "phase scratch fits under the barrier words");
constexpr int CW_BAR = 4096;
static_assert((CW_BAR + XCD_BAR_WORDS) * 4 <= (int)CTL_ZERO_BYTES, "barrier words inside the memset region");

static __device__ __forceinline__ pg8::Gemm dgemm(const void* A, const void* Bt, int M_, int N_, int K_, int lda, int ldb) { pg8::Gemm g; g.A = (const pg8::bf16_t*)A; g.Bt = (const pg8::bf16_t*)Bt; g.M = M_; g.N = N_; g.K = K_; g.lda = lda; g.ldb = ldb; g.pad = 0; return g; }
template <class Epi> __device__ __forceinline__ void run_gemm(LAS unsigned char* lds, const pg8::Gemm& g, const Epi& E) {
    pg8::StaticOrder S; S.init(g.M, g.N, (int)gridDim.x, (int)blockIdx.x);
    pg8::gemm_phase<Epi, pg8::StaticOrder, true, true>(lds, g, S, E);
}
__global__ __launch_bounds__(NTHR, 2) void fwd_kernel(Params p) {
    extern __shared__ __attribute__((aligned(16))) unsigned char lds[];
    LAS unsigned char* L = (LAS unsigned char*)lds;
    const int tid = threadIdx.x;
    const int G = gridDim.x, bx = blockIdx.x, vcu = (G % 8 == 0) ? (bx % 8) * (G / 8) + bx / 8 : bx;
    const int ngw = G * 8;
#define FRESH_IDS int tid_ = threadIdx.x; asm volatile("" : "+v"(tid_)); const int lane = tid_ & 63, wave = __builtin_amdgcn_readfirstlane(tid_ >> 6), gw = bx * 8 + wave;
    unsigned char* ws = p.ws; unsigned char* ob = (unsigned char*)p.out;
    if (tid < 4) ((LAS unsigned*)(L + LDS_BAR_OFF))[tid] = 0u;
    __syncthreads();
    XcdBarrier bar = xcd_barrier_post((unsigned*)(ws + WS_CTL) + CW_BAR, (volatile LAS unsigned*)(L + LDS_BAR_OFF));
#ifdef PROBE_A
    unsigned long long* ts = (unsigned long long*)(ws + WS_CTL + 896 * 1024);
#define STAMP(k) do { if (bx == 0 && tid == 0) ts[k] = __builtin_amdgcn_s_memrealtime(); } while (0)
#else
#define STAMP(k) do { } while (0)
#endif
    STAMP(0);
#ifdef DUP_P0
    { FRESH_IDS phase_prologue(p, L, gw, ngw, wave, lane); } __syncthreads();
#endif
    { FRESH_IDS phase_prologue(p, L, gw, ngw, wave, lane); }
    xcd_barrier(bar);
    STAMP(1);
    { EpiWin E; E.ws = ws; run_gemm(L, dgemm(ws + WS_XB, ws + WS_WIN, M, NINP, DM, DM, DM), E); }
    STAMP(10);
    { EpiPlain E; E.O0 = (bf16*)(ws + WS_MEMKV); E.O1 = nullptr; E.split = 0; E.ldc = 1024; run_gemm(L, dgemm(ws + WS_MEMN, ws + WS_WKVM, MMEM, 1024, DM, DM, DM), E); }
    xcd_barrier(bar);
    STAMP(2);
    { FRESH_IDS phase_tokprep(p, gw, ngw, lane); }
    xcd_barrier(bar);
    STAMP(3);
    { EpiQup E; E.Q = (bf16*)(ob + DO_Q); E.rstd = (const float*)(ws + WS_RSTDCQ); E.cs = (const float*)(ws + WS_COS); E.sn = (const float*)(ws + WS_SIN); run_gemm(L, dgemm(ws + WS_ZA, ws + WS_WUQ, M, QW, QR, 512, QR), E); }
    { EpiKVup E; E.Kd = (bf16*)(ob + DO_K); E.Vd = (bf16*)(ob + DO_V); E.rstd = (const float*)(ws + WS_RSTDCKV); run_gemm(L, dgemm(ws + WS_CKV, ws + WS_WUKV, M, 1024, KVR, KVR, KVR), E); }
    { EpiPlain E; E.O0 = (bf16*)(ws + WS_QKQ); E.O1 = (bf16*)(ws + WS_QKK); E.split = 512; E.ldc = 512; run_gemm(L, dgemm(ws + WS_CML, ws + WS_WML, M, 1024, 512, 512, 512), E); }
    xcd_barrier(bar);
    STAMP(4);
#ifdef DUP_ML
    phase_mlstm(p, (char*)lds, vcu, G);
#endif
    phase_mlstm(p, (char*)lds, vcu, G);
    STAMP(11);
#ifdef DUP_MLA
    phase_attn_mla(p, (char*)lds, vcu, G);
#endif
    phase_attn_mla(p, (char*)lds, vcu, G);
    STAMP(12);
    phase_attn_mem(p, (char*)lds, vcu, G);
    xcd_barrier(bar);
    STAMP(5);
#pragma unroll
    for (int b = 0; b < 3; ++b) { EpiBranch E; E.G = (const bf16*)(ws + WS_G); E.Mg = (bf16*)(ws + WS_MERGED); E.b = b; E.pad = 0;
        const size_t ao = b == 0 ? WS_OMLA : (b == 1 ? WS_OML : WS_MEMQ);
        run_gemm(L, dgemm(ws + ao, ws + WS_WBR + (size_t)b * DM * 512 * 2, M, DM, 512, 512, 512), E); }
    xcd_barrier(bar);
    STAMP(6);
    { EpiResid<true> E; E.res = p.in[I_X]; E.xo = p.out; E.xb = (bf16*)(ws + WS_X1B); E.ssq = (float*)(ws + WS_SSQ1); run_gemm(L, dgemm(ws + WS_MERGED, ws + WS_WOUT, M, DM, DM, DM, DM), E); }
    xcd_barrier(bar);
    STAMP(7);
#ifdef DUP_P6
    { EpiFfnUp E; E.act = (bf16*)(ws + WS_ACT); E.ssq = (const float*)(ws + WS_SSQ1); run_gemm(L, dgemm(ws + WS_X1B, ws + WS_WGU, M, NGU, DM, DM, DM), E); }
#endif
    { EpiFfnUp E; E.act = (bf16*)(ws + WS_ACT); E.ssq = (const float*)(ws + WS_SSQ1); run_gemm(L, dgemm(ws + WS_X1B, ws + WS_WGU, M, NGU, DM, DM, DM), E); }
    xcd_barrier(bar);
    STAMP(8);
    { EpiResid<false> E; E.res = p.out; E.xo = p.out; E.xb = nullptr; E.ssq = (float*)(ws + WS_SSQ2); run_gemm(L, dgemm(ws + WS_ACT, ws + WS_WDN, M, DM, DFF, DFF, DFF), E); }
    xcd_barrier(bar);
    STAMP(9);
#ifdef PROBE_A
    { const float dA = (float)(long long)(ts[PROBE_A1] - ts[PROBE_A]), dB = (float)(long long)(ts[PROBE_B1] - ts[PROBE_B]);
      FRESH_IDS phase_final(p, gw, ngw, lane, 1.f + dA * (1.f / 500000.f), dB * (1.f / 2000.f)); }
#else
    { FRESH_IDS phase_final(p, gw, ngw, lane, 1.f, 0.f); }
#endif
}
extern "C" void kernel_launch(void* const* d_in, const int* in_sizes, int n_in, void* d_out, int out_size, void* d_ws, size_t ws_size, hipStream_t stream) {
    static int grid = 0;
    if (grid == 0) {
        if (n_in != N_INPUTS || in_sizes[0] != M * DM || out_size != M * DM || ws_size < WS_END) { fprintf(stderr, "kernel_launch: shape/workspace mismatch (n_in %d, ws %zu)\n", n_in, ws_size); grid = -1; return; }
        int dev = 0, cus = 0, per_cu = 0;
        if (hipGetDevice(&dev) != hipSuccess || hipDeviceGetAttribute(&cus, hipDeviceAttributeMultiprocessorCount, dev) != hipSuccess) { grid = -1; return; }
        if (hipFuncSetAttribute((const void*)fwd_kernel, hipFuncAttributeMaxDynamicSharedMemorySize, LDS_TOTAL) != hipSuccess) { grid = -1; return; }
        if (hipOccupancyMaxActiveBlocksPerMultiprocessor(&per_cu, (const void*)fwd_kernel, NTHR, LDS_TOTAL) != hipSuccess || per_cu < 1) { fprintf(stderr, "kernel_launch: occupancy query says %d\n", per_cu); (void)hipGetLastError(); }
        grid = cus;
    }
    if (grid < 0) return;
    Params p{}; for (int i = 0; i < N_INPUTS; ++i) p.in[i] = (const float*)d_in[i]; p.out = (float*)d_out; p.ws = (unsigned char*)d_ws;
    (void)hipMemsetAsync((unsigned char*)d_ws + WS_CTL, 0, CTL_ZERO_BYTES, stream);
    hipLaunchKernelGGL(fwd_kernel, dim3(grid), dim3(NTHR), LDS_TOTAL, stream, p);
}
```

```cpp
#include <hip/hip_runtime.h>
#include <cstdio>
#include <cstdint>

constexpr int BATCH = 32, SEQ = 2048, DM = 1024, M = BATCH * SEQ;
constexpr int MEM_LEN = 256, MMEM = BATCH * MEM_LEN;
constexpr int NIN = 5824, NINP = 5888;
constexpr int DFF = 2816, NGU = 2 * DFF;
constexpr int QR = 384, KVR = 256, ROPE = 32, NOPE = 64, DQK = 96, MLAH = 8, QW = MLAH * DQK;
constexpr int MLW = 512, MLH = 8, MEMW = 512, MEMH = 4, MEMD = 128;
constexpr float EPS = 1e-6f;
constexpr int ZA_KR = 384, ZA_MG = 416;

constexpr size_t MiB = 1u << 20;
constexpr size_t WS_CTL = 0, CTL_ZERO_BYTES = 1 * MiB;
constexpr size_t WS_WIN = 1 * MiB;
constexpr size_t WS_WKVM = 13 * MiB;
constexpr size_t WS_WUQ = 15 * MiB;
constexpr size_t WS_WUKV = 16 * MiB;
constexpr size_t WS_WML = 17 * MiB;
constexpr size_t WS_WBR = 18 * MiB;
constexpr size_t WS_WOUT = 21 * MiB;
constexpr size_t WS_WGU = 23 * MiB;
constexpr size_t WS_WDN = 34 * MiB;
constexpr size_t WS_COS = 40 * MiB;
constexpr size_t WS_SIN = 44 * MiB;
constexpr size_t WS_RSTDX = 48 * MiB;
constexpr size_t WS_RSTDCQ = WS_RSTDX + 256 * 1024, WS_RSTDCKV = WS_RSTDCQ + 256 * 1024;
constexpr size_t WS_SSQ1 = 256 * 1024;
constexpr size_t WS_SSQ2 = 512 * 1024;
constexpr size_t WS_XB = 64 * MiB;
constexpr size_t WS_QKK = WS_XB, WS_OMLA = WS_XB + 64 * MiB, WS_X1B = WS_XB;
constexpr size_t WS_G = 192 * MiB;
constexpr size_t WS_ACT = WS_G;
constexpr size_t WS_ZA = 576 * MiB;
constexpr size_t WS_CKV = 640 * MiB;
constexpr size_t WS_MU = 672 * MiB;
constexpr size_t WS_QKQ = WS_MU;
constexpr size_t WS_MV = 736 * MiB;
constexpr size_t WS_MO = 800 * MiB;
constexpr size_t WS_MEMQ = 864 * MiB;
constexpr size_t WS_MEMKV = 928 * MiB;
constexpr size_t WS_MEMN = 944 * MiB;
constexpr size_t WS_CML = 960 * MiB;
constexpr size_t WS_OML = WS_CML;
constexpr size_t WS_MERGED = WS_ZA;
constexpr size_t WS_END = 1024 * MiB;
static_assert(WS_WIN + (size_t)NINP * DM * 2 <= WS_WKVM && WS_WGU + (size_t)NGU * DM * 2 <= WS_WDN && WS_WDN + (size_t)DM * DFF * 2 <= WS_COS, "weights map");
static_assert(WS_G + (size_t)M * 3072 * 2 == WS_ZA && WS_ACT + (size_t)M * DFF * 2 <= WS_ZA && WS_MERGED + (size_t)M * DM * 2 <= WS_MV && WS_CML + (size_t)M * 512 * 2 == WS_END, "activation map");
constexpr size_t DO_Q = 0, DO_K = 96 * MiB, DO_V = 192 * MiB;

enum { I_X = 0, I_MEM, I_POS, I_GMIX, I_WIN, I_GQ, I_GKV, I_WUQ, I_WUK, I_WUV, I_CONVW, I_WQ, I_WK, I_GBIAS, I_GHEAD, I_MEMG, I_MEMWKV, I_WBR, I_WOUT, I_GFFN, I_WFG, I_WFU, I_WFD, I_GFINAL, N_INPUTS };
struct Params { const float* in[N_INPUTS]; float* out; unsigned char* ws; };
#define GAS __attribute__((address_space(1)))
#define LAS __attribute__((address_space(3)))
typedef unsigned short bf16;
typedef unsigned v4u __attribute__((ext_vector_type(4)));
typedef float f32x4 __attribute__((ext_vector_type(4)));
typedef short bf16x8 __attribute__((ext_vector_type(8)));
typedef GAS unsigned gu32;
typedef GAS unsigned long long gu64;
#define RLX_AGENT __ATOMIC_RELAXED, __HIP_MEMORY_SCOPE_AGENT
#define LDS_WAIT() asm volatile("s_waitcnt lgkmcnt(0)" ::: "memory")
#define VM_WAIT() asm volatile("s_waitcnt vmcnt(0)" ::: "memory")
__device__ __forceinline__ unsigned long long rt() { return __builtin_amdgcn_s_memrealtime(); }
__device__ __forceinline__ unsigned f2bf(float f) { unsigned u = __builtin_bit_cast(unsigned, f); return (u + 0x7fffu + ((u >> 16) & 1u)) >> 16; }
__device__ __forceinline__ unsigned pk2(float lo, float hi) { return f2bf(lo) | (f2bf(hi) << 16); }
#define XB_TMO      128
#define XB_XCNT(j)  (256  + 64 * (j))
#define XB_XSUB(j)  (1280 + 64 * (j))
#define XB_XGEN(j)  (2304 + 64 * (j))
#define XB_TOP      3328
#define XB_TOPGEN   3392
#define XCD_BAR_WORDS 3456
#define XB_SPIN_CAP (1u << 18)

__device__ __forceinline__ unsigned xb_ld(unsigned* p)              { return __hip_atomic_load(p, __ATOMIC_RELAXED, __HIP_MEMORY_SCOPE_AGENT); }
__device__ __forceinline__ unsigned xb_add(unsigned* p, unsigned v) { return __hip_atomic_fetch_add(p, v, __ATOMIC_RELAXED, __HIP_MEMORY_SCOPE_AGENT); }
__device__ __forceinline__ unsigned xb_xcc_id() { return (unsigned)__builtin_amdgcn_s_getreg((3 << 11) | 20) & 0xFu; }
#define XB_SPIN(cond, bar) do { unsigned _sp = 0; while (cond) { __builtin_amdgcn_s_sleep(1); \
    if ((++_sp & 255u) == 0u) { if (xb_ld(&(bar)[XB_TMO])) break; if (_sp > XB_SPIN_CAP) { atomicAdd(&(bar)[XB_TMO], 1u); break; } } } } while (0)

struct XcdBarrier {
    unsigned* bar; unsigned x;
    volatile LAS unsigned* st;
};

__device__ __forceinline__ XcdBarrier xcd_barrier_post(unsigned* bar, volatile LAS unsigned* st) {
    XcdBarrier b; b.bar = bar; b.x = xb_xcc_id(); b.st = st;
    if (threadIdx.x == 0) (void)xb_add(&bar[XB_XCNT(b.x)], 1u);
    return b;
}
__device__ __forceinline__ void xcd_barrier_complete(unsigned* bar, unsigned x, unsigned& nloc, unsigned& nx) {
    const unsigned G = gridDim.x * gridDim.y * gridDim.z;
    unsigned sum, cnt, mine, sp = 0u;
    for (;;) {
        sum = 0u; cnt = 0u; mine = 0u;
#pragma unroll
        for (unsigned j = 0; j < 16; ++j) { const unsigned c = xb_ld(&bar[XB_XCNT(j)]); sum += c; cnt += (c > 0u) ? 1u : 0u; mine = (j == x) ? c : mine; }
        if (sum == G) break;
        __builtin_amdgcn_s_sleep(1);
        if ((++sp & 255u) == 0u) { if (xb_ld(&bar[XB_TMO])) break; if (sp > XB_SPIN_CAP) { atomicAdd(&bar[XB_TMO], 1u); break; } }
    }
    nloc = mine > 0u ? mine : 1u; nx = cnt > 0u ? cnt : 1u;
}

__device__ __forceinline__ void xcd_barrier(const XcdBarrier& b) {
    asm volatile("s_waitcnt vmcnt(0)" ::: "memory");
    __syncthreads();
    if (threadIdx.x == 0) {
        unsigned* bar = b.bar;
        __builtin_amdgcn_s_waitcnt(0);
        unsigned nloc = b.st[0], nx = b.st[1];
        if (nloc == 0u) { xcd_barrier_complete(bar, b.x, nloc, nx); b.st[0] = nloc; b.st[1] = nx; }
        const unsigned old = xb_add(&bar[XB_XSUB(b.x)], 1u);
        const unsigned gen = old / nloc;
        if (old + 1u == (gen + 1u) * nloc) {
            __builtin_amdgcn_fence(__ATOMIC_RELEASE, "agent");
            asm volatile("s_waitcnt vmcnt(0)" ::: "memory");
            const unsigned og = xb_add(&bar[XB_TOP], 1u);
            const unsigned tg = og / nx;
            if (og + 1u == (tg + 1u) * nx) xb_add(&bar[XB_TOPGEN], 1u);
            else XB_SPIN(xb_ld(&bar[XB_TOPGEN]) == tg, bar);
            __builtin_amdgcn_fence(__ATOMIC_ACQUIRE, "agent");
            xb_add(&bar[XB_XGEN(b.x)], 1u);
            asm volatile("s_waitcnt vmcnt(0)" ::: "memory");
        } else {
            XB_SPIN(xb_ld(&bar[XB_XGEN(b.x)]) == gen, bar);
            __builtin_amdgcn_fence(__ATOMIC_ACQUIRE, "agent");
            asm volatile("s_waitcnt vmcnt(0)" ::: "memory");
        }
    }
    __syncthreads();
}
namespace pg8 {
#define PG8_LAS __attribute__((address_space(3)))
typedef unsigned short bf16_t;
typedef short bf16x8 __attribute__((ext_vector_type(8)));
typedef float f32x4 __attribute__((ext_vector_type(4)));
typedef unsigned u32x4 __attribute__((ext_vector_type(4)));
constexpr int BM = 256, BK = 64, HALF = 128, HTB = HALF * BK * 2  , STAGE_BYTES = 8 * HTB, NXCD = 8, WGM = 8;

__host__ __device__ __forceinline__ int lds_byte(int r, int c) { const int st = (r >> 4) * 2 + (c >> 5), rr = r & 15, cc = c & 31, ob = rr * 64 + cc * 2; return st * 1024 + (ob ^ (((ob >> 9) & 1) << 5)); }
__host__ __device__ __forceinline__ void stage_rc(int b, int& R, int& C) { const int st = b / 1024, sb = b % 1024, swz = sb ^ (((sb >> 9) & 1) << 5); R = (st >> 1) * 16 + swz / 64; C = (st & 1) * 32 + (swz % 64) / 2; }
__host__ __device__ __forceinline__ int perm32(int rho) { const int n = rho >> 4, i = rho & 15; return 8 * (i >> 2) + 4 * n + (i & 3); }

struct Unit { int pm, pn; };
struct Gemm { const bf16_t* A; const bf16_t* Bt; int M, N, K, lda, ldb, pad; };

struct StaticOrder {
    int nM, nN, nwg, G, c;
    __host__ __device__ void init(int M, int N, int G_, int c_) { nM = M / BM; nN = N / BM; nwg = nM * nN; G = G_; c = c_; }
    __host__ __device__ bool next(int i, Unit& u) const {
        const long L = (long)i * G + c; if (L >= nwg) return false;
        int wgid = (int)L; { const int q = nwg / NXCD, r = nwg % NXCD, xcd = wgid % NXCD, off = wgid / NXCD; wgid = (xcd < r ? xcd * (q + 1) : r * (q + 1) + (xcd - r) * q) + off; }
        const int nig = WGM * nN, gid = wgid / nig, fm = gid * WGM, gsz = (nM - fm) < WGM ? (nM - fm) : WGM;
        u.pm = fm + ((wgid % nig) % gsz); u.pn = (wgid % nig) / gsz; return true;
    }
    __device__ __forceinline__ void a_ready(const Unit&) const {}
    __device__ __forceinline__ void done(const Unit&) const {}
};

__device__ __forceinline__ unsigned cvt_pk_bf16(float lo, float hi) { unsigned r; asm volatile("v_cvt_pk_bf16_f32 %0, %1, %2" : "=v"(r) : "v"(lo), "v"(hi)); return r; }
typedef float f32x2 __attribute__((ext_vector_type(2)));
template <class Epi, class Sched, bool ALIGN_EPI = false, bool SP2 = false>
__device__ __forceinline__ void gemm_phase(PG8_LAS unsigned char* lds, const Gemm g, const Sched& S, const Epi& E) {
    int tid = threadIdx.x; asm volatile("" : "+v"(tid));
    const int wid = __builtin_amdgcn_readfirstlane(tid >> 6), lane = tid & 63, wr = wid >> 2, wc = wid & 3, fr = lane & 15, fq = lane >> 4;
    const int K = g.K, nt = K / BK;
    unsigned voffA[2], voffB[2];
#pragma unroll
    for (int i = 0; i < 2; ++i) { int R, C; stage_rc(tid * 16 + i * 8192, R, C); const int Rb = Epi::PERM ? ((R & ~31) + perm32(R & 31)) : R;
        voffA[i] = (unsigned)(R * g.lda + C) * 2u; voffB[i] = (unsigned)(Rb * g.ldb + C) * 2u; }
    const size_t kstep = (size_t)(BK * 2);
    const size_t hstepA = (size_t)HALF * g.lda * 2, hstepB = (size_t)HALF * g.ldb * 2;
    const size_t tstepA = 2 * hstepA, tstepB = 2 * hstepB;
    const unsigned ldsw = (unsigned)wid * 1024u;
    const int aoff = lds_byte(wr * 64 + fr, fq * 8), boff = lds_byte(wc * 32 + fr, fq * 8);
#define PG8_SA(b, h) (((b) * 2 + (h)) * HTB)
#define PG8_SB(b, h) ((4 + (b) * 2 + (h)) * HTB)
#define PG8_STAGE(bufoff, gbase, voff) do { _Pragma("unroll") for (int _i = 0; _i < 2; ++_i) \
        __builtin_amdgcn_global_load_lds((const unsigned*)((const char*)(gbase) + (voff)[_i]), (PG8_LAS unsigned*)(lds + (bufoff) + ldsw + _i * 8192), 16, 0, 0); } while (0)
#define PG8_LDA(dst, b, h) do { _Pragma("unroll") for (int m = 0; m < 4; ++m) _Pragma("unroll") for (int k = 0; k < 2; ++k) dst[m][k] = *(const PG8_LAS bf16x8*)(lds + PG8_SA(b, h) + aoff + m * 2048 + k * 1024); } while (0)
#define PG8_LDB(dst, b, h) do { _Pragma("unroll") for (int n = 0; n < 2; ++n) _Pragma("unroll") for (int k = 0; k < 2; ++k) dst[n][k] = *(const PG8_LAS bf16x8*)(lds + PG8_SB(b, h) + boff + n * 2048 + k * 1024); } while (0)
#define PG8_MMA(ai, bj, At, Bt) do { __builtin_amdgcn_s_setprio(1); _Pragma("unroll") for (int m = 0; m < 4; ++m) _Pragma("unroll") for (int n = 0; n < 2; ++n) _Pragma("unroll") for (int k = 0; k < 2; ++k) \
        acc[ai][bj][m][n] = __builtin_amdgcn_mfma_f32_16x16x32_bf16(Bt[n][k], At[m][k], acc[ai][bj][m][n], 0, 0, 0); __builtin_amdgcn_s_setprio(0); } while (0)
#define PG8_WAIT_V(n) asm volatile("s_waitcnt vmcnt(" #n ")" ::: "memory")
#define PG8_WAIT_L(n) asm volatile("s_waitcnt lgkmcnt(" #n ")" ::: "memory")
#define PG8_BAR __builtin_amdgcn_s_barrier()
#define PG8_SCHED __builtin_amdgcn_sched_barrier(0)
    Unit cur, nxt; int ui = 0;
    if (!S.next(0, cur)) return;
    f32x4 acc[2][2][4][2];
#pragma unroll
    for (int a = 0; a < 2; ++a)
#pragma unroll
        for (int b = 0; b < 2; ++b)
#pragma unroll
            for (int m = 0; m < 4; ++m)
#pragma unroll
                for (int n = 0; n < 2; ++n) acc[a][b][m][n] = (f32x4){0.f, 0.f, 0.f, 0.f};
    bf16x8 At[4][2], B0[2][2], B1[2][2];
    const char* cA = (const char*)g.A + (size_t)cur.pm * tstepA; const char* cB = (const char*)g.Bt + (size_t)cur.pn * tstepB;
    S.a_ready(cur);
    if constexpr (SP2) {
        PG8_STAGE(PG8_SB(0, 0), cB, voffB); PG8_STAGE(PG8_SB(0, 1), cB + hstepB, voffB); PG8_STAGE(PG8_SA(0, 0), cA, voffA); PG8_STAGE(PG8_SA(0, 1), cA + hstepA, voffA);
        if (wr == 1) PG8_BAR;
        PG8_WAIT_V(2); PG8_BAR;
        PG8_STAGE(PG8_SB(1, 0), cB + kstep, voffB); PG8_STAGE(PG8_SA(1, 0), cA + kstep, voffA); PG8_STAGE(PG8_SB(1, 1), cB + hstepB + kstep, voffB);
        PG8_WAIT_V(6); PG8_BAR;
    } else {
        PG8_STAGE(PG8_SB(0, 0), cB, voffB); PG8_STAGE(PG8_SA(0, 0), cA, voffA); PG8_STAGE(PG8_SB(0, 1), cB + hstepB, voffB); PG8_STAGE(PG8_SA(0, 1), cA + hstepA, voffA);
        if (wr == 1) PG8_BAR;
        PG8_WAIT_V(4); PG8_BAR;
        PG8_STAGE(PG8_SB(1, 0), cB + kstep, voffB); PG8_STAGE(PG8_SA(1, 0), cA + kstep, voffA); PG8_STAGE(PG8_SB(1, 1), cB + hstepB + kstep, voffB);
        PG8_WAIT_V(6); PG8_BAR;
    }
    for (;;) {
        const bool has_next = S.next(ui + 1, nxt);
        const char* nA = has_next ? (const char*)g.A + (size_t)nxt.pm * tstepA : cA; const char* nB = has_next ? (const char*)g.Bt + (size_t)nxt.pn * tstepB : cB;
        for (int t = 0; t < nt; t += 2) {
            const bool last = (t == nt - 2);
            const char* a1 = cA + (size_t)(t + 1) * kstep;
            const char* a2 = last ? nA : cA + (size_t)(t + 2) * kstep; const char* b2 = last ? nB : cB + (size_t)(t + 2) * kstep;
            const char* a3 = a2 + kstep; const char* b3 = b2 + kstep;
            if (last && has_next) S.a_ready(nxt);
            if constexpr (SP2) {
            PG8_LDB(B0, 0, 0); PG8_LDB(B1, 0, 1); PG8_SCHED; PG8_LDA(At, 0, 0); PG8_STAGE(PG8_SA(1, 1), a1 + hstepA, voffA);
            PG8_WAIT_V(8); PG8_WAIT_L(0); PG8_BAR; PG8_MMA(0, 0, At, B0); PG8_MMA(0, 1, At, B1); PG8_BAR; PG8_SCHED;
            PG8_LDA(At, 0, 1); PG8_STAGE(PG8_SB(0, 0), b2, voffB); PG8_STAGE(PG8_SB(0, 1), b2 + hstepB, voffB); PG8_STAGE(PG8_SA(0, 0), a2, voffA);
            PG8_WAIT_V(8); PG8_WAIT_L(0); PG8_BAR; PG8_MMA(1, 0, At, B0); PG8_MMA(1, 1, At, B1); PG8_BAR; PG8_SCHED;
            PG8_LDB(B0, 1, 0); PG8_LDB(B1, 1, 1); PG8_SCHED; PG8_LDA(At, 1, 0); PG8_STAGE(PG8_SA(0, 1), a2 + hstepA, voffA);
            PG8_WAIT_V(8); PG8_WAIT_L(0); PG8_BAR; PG8_MMA(0, 0, At, B0); PG8_MMA(0, 1, At, B1); PG8_BAR; PG8_SCHED;
            PG8_LDA(At, 1, 1); PG8_STAGE(PG8_SB(1, 0), b3, voffB); PG8_STAGE(PG8_SB(1, 1), b3 + hstepB, voffB); PG8_STAGE(PG8_SA(1, 0), a3, voffA);
            PG8_WAIT_V(8); PG8_WAIT_L(0); PG8_BAR; PG8_MMA(1, 0, At, B0); PG8_MMA(1, 1, At, B1); PG8_BAR; PG8_SCHED;
            } else {
            PG8_LDB(B0, 0, 0); PG8_SCHED; PG8_LDA(At, 0, 0); PG8_STAGE(PG8_SA(1, 1), a1 + hstepA, voffA);
            PG8_WAIT_L(8); PG8_BAR; PG8_WAIT_L(0); PG8_MMA(0, 0, At, B0); PG8_BAR; PG8_SCHED;
            PG8_LDB(B1, 0, 1); PG8_STAGE(PG8_SB(0, 0), b2, voffB);
            PG8_BAR; PG8_WAIT_L(0); PG8_MMA(0, 1, At, B1); PG8_BAR;
            PG8_LDA(At, 0, 1); PG8_STAGE(PG8_SA(0, 0), a2, voffA);
            PG8_BAR; PG8_WAIT_L(0); PG8_MMA(1, 0, At, B0); PG8_BAR; PG8_SCHED;
            PG8_STAGE(PG8_SB(0, 1), b2 + hstepB, voffB);
            PG8_WAIT_V(6); PG8_BAR; PG8_MMA(1, 1, At, B1); PG8_BAR;
            PG8_LDB(B0, 1, 0); PG8_SCHED; PG8_LDA(At, 1, 0); PG8_STAGE(PG8_SA(0, 1), a2 + hstepA, voffA);
            PG8_WAIT_L(8); PG8_BAR; PG8_WAIT_L(0); PG8_MMA(0, 0, At, B0); PG8_BAR; PG8_SCHED;
            PG8_LDB(B1, 1, 1); PG8_STAGE(PG8_SB(1, 0), b3, voffB);
            PG8_BAR; PG8_WAIT_L(0); PG8_MMA(0, 1, At, B1); PG8_BAR;
            PG8_LDA(At, 1, 1); PG8_STAGE(PG8_SA(1, 0), a3, voffA);
            PG8_BAR; PG8_WAIT_L(0); PG8_MMA(1, 0, At, B0); PG8_BAR; PG8_SCHED;
            PG8_STAGE(PG8_SB(1, 1), b3 + hstepB, voffB);
            PG8_WAIT_V(6); PG8_BAR; PG8_MMA(1, 1, At, B1); PG8_BAR;
            }
        }
        if constexpr (ALIGN_EPI) { if (wr == 0) PG8_BAR; }
        if constexpr (!Epi::AFTER_DRAIN) { E(acc, cur, wr, wc, fr, fq); S.done(cur); }
        if (!has_next) break;
#pragma unroll
        for (int a = 0; a < 2; ++a)
#pragma unroll
            for (int b = 0; b < 2; ++b)
#pragma unroll
                for (int m = 0; m < 4; ++m)
#pragma unroll
                    for (int n = 0; n < 2; ++n) acc[a][b][m][n] = (f32x4){0.f, 0.f, 0.f, 0.f};
        cur = nxt; cA = nA; cB = nB; ++ui;
        if constexpr (ALIGN_EPI) { if (wr == 1) PG8_BAR; }
    }
    PG8_WAIT_V(0);
    if constexpr (!ALIGN_EPI) { if (wr == 0) PG8_BAR; }
    PG8_BAR;
    if constexpr (Epi::AFTER_DRAIN) { E.fused(acc, cur, wr, wc, fr, fq, lds, wid, lane); S.done(cur); }
#undef PG8_SA
#undef PG8_SB
#undef PG8_STAGE
#undef PG8_LDA
#undef PG8_LDB
#undef PG8_MMA
#undef PG8_WAIT_V
#undef PG8_WAIT_L
#undef PG8_BAR
#undef PG8_SCHED
}
}
typedef unsigned u32x4_t __attribute__((ext_vector_type(4)));
__device__ __forceinline__ float bf2f(unsigned short b) { return __uint_as_float((unsigned)b << 16); }
__device__ __forceinline__ float bflo(unsigned w) { return __uint_as_float(w << 16); }
__device__ __forceinline__ float bfhi(unsigned w) { return __uint_as_float(w & 0xffff0000u); }
__device__ __forceinline__ float sigmoid_f(float x) { return __builtin_amdgcn_rcpf(1.f + __builtin_amdgcn_exp2f(-1.4426950408889634f * x)); }
__device__ __forceinline__ float silu_f(float x) { return x * sigmoid_f(x); }
__device__ __forceinline__ u32x4_t pack8(const pg8::f32x4& a, const pg8::f32x4& b) {
    u32x4_t w; w.x = pg8::cvt_pk_bf16(a[0], a[1]); w.y = pg8::cvt_pk_bf16(a[2], a[3]); w.z = pg8::cvt_pk_bf16(b[0], b[1]); w.w = pg8::cvt_pk_bf16(b[2], b[3]); return w; }
__device__ __forceinline__ void unpack8(const u32x4_t w, pg8::f32x4& a, pg8::f32x4& b) {
    a = (pg8::f32x4){bflo(w.x), bfhi(w.x), bflo(w.y), bfhi(w.y)}; b = (pg8::f32x4){bflo(w.z), bfhi(w.z), bflo(w.w), bfhi(w.w)}; }

#define EPI_ARGS const pg8::f32x4 (&acc)[2][2][4][2], const pg8::Unit& u, int wr, int wc, int fr, int fq
#define EPI_ROWS_BEGIN  _Pragma("unroll") for (int ai = 0; ai < 2; ++ai) _Pragma("unroll") for (int m = 0; m < 4; ++m) { const int row = u.pm * 256 + ai * 128 + wr * 64 + m * 16 + fr;
#define EPI_ROWS_END }


#define EPI_ROW(ai, m) (u.pm * 256 + (ai) * 128 + wr * 64 + (m) * 16 + fr)

struct EpiWin {
    static constexpr bool PERM = true, AFTER_DRAIN = false;
    unsigned char* ws;
    __device__ __forceinline__ void operator()(EPI_ARGS) const {
        const int pn = u.pn; size_t off; int ldc, cb; bool act = false;
        if (pn < 12) { off = WS_G; ldc = 3072; cb = pn * 256; act = true; }
        else if (pn < 14) { off = WS_ZA; ldc = 512; cb = (pn - 12) * 256; }
        else if (pn < 15) { off = WS_CKV; ldc = 256; cb = 0; }
        else if (pn < 17) { off = WS_MU; ldc = 512; cb = (pn - 15) * 256; }
        else if (pn < 19) { off = WS_MV; ldc = 512; cb = (pn - 17) * 256; }
        else if (pn < 21) { off = WS_MO; ldc = 512; cb = (pn - 19) * 256; act = true; }
        else { off = WS_MEMQ; ldc = 512; cb = (pn - 21) * 256; }
        bf16* base = (bf16*)(ws + off); const float* rstd = (const float*)(ws + WS_RSTDX);
        const int col0 = cb + wc * 32 + 8 * fq;
        float rs[2][4];
#pragma unroll
        for (int ai = 0; ai < 2; ++ai)
#pragma unroll
            for (int m = 0; m < 4; ++m) rs[ai][m] = rstd[EPI_ROW(ai, m)];
#pragma unroll
        for (int ai = 0; ai < 2; ++ai)
#pragma unroll
            for (int m = 0; m < 4; ++m) { bf16* rowp = base + (size_t)EPI_ROW(ai, m) * ldc + col0;
#pragma unroll
                for (int bj = 0; bj < 2; ++bj) { pg8::f32x4 v0 = acc[ai][bj][m][0] * rs[ai][m], v1 = acc[ai][bj][m][1] * rs[ai][m];
                    if (act) {
#pragma unroll
                        for (int e = 0; e < 4; ++e) { v0[e] = sigmoid_f(v0[e]); v1[e] = sigmoid_f(v1[e]); } }
                    *(u32x4_t*)(rowp + bj * 128) = pack8(v0, v1); } }
    }
};
struct EpiPlain {
    static constexpr bool PERM = true, AFTER_DRAIN = false;
    bf16* O0; bf16* O1; int split, ldc;
    __device__ __forceinline__ void operator()(EPI_ARGS) const {
        int c8 = u.pn * 256 + wc * 32 + 8 * fq; bf16* base = O0;
        if (split && c8 >= split) { base = O1; c8 -= split; }
        EPI_ROWS_BEGIN
            bf16* rowp = base + (size_t)row * ldc + c8;
#pragma unroll
            for (int bj = 0; bj < 2; ++bj) *(u32x4_t*)(rowp + bj * 128) = pack8(acc[ai][bj][m][0], acc[ai][bj][m][1]);
        EPI_ROWS_END
    }
};
struct EpiQup {
    static constexpr bool PERM = true, AFTER_DRAIN = false;
    bf16* Q; const float* rstd; const float* cs; const float* sn;
    __device__ __forceinline__ void operator()(EPI_ARGS) const {
        int c8[2], i0[2]; bool rope[2];
#pragma unroll
        for (int bj = 0; bj < 2; ++bj) { c8[bj] = u.pn * 256 + bj * 128 + wc * 32 + 8 * fq; const int h = c8[bj] / 96, w = c8[bj] - 96 * h; rope[bj] = w >= 64; i0[bj] = rope[bj] ? (w - 64) >> 1 : 0; }
#pragma unroll
        for (int ai = 0; ai < 2; ++ai)
#pragma unroll
        for (int mh = 0; mh < 2; ++mh) {
            float rs[2]; pg8::f32x4 cv[2][2], sv[2][2];
#pragma unroll
            for (int mm = 0; mm < 2; ++mm) { const int row = EPI_ROW(ai, 2 * mh + mm); rs[mm] = rstd[row];
#pragma unroll
                for (int bj = 0; bj < 2; ++bj) if (rope[bj]) { cv[mm][bj] = *(const pg8::f32x4*)(cs + (size_t)row * 16 + i0[bj]); sv[mm][bj] = *(const pg8::f32x4*)(sn + (size_t)row * 16 + i0[bj]); } }
#pragma unroll
            for (int mm = 0; mm < 2; ++mm) { const int m = 2 * mh + mm, row = EPI_ROW(ai, m);
#pragma unroll
                for (int bj = 0; bj < 2; ++bj) { pg8::f32x4 v0 = acc[ai][bj][m][0] * rs[mm], v1 = acc[ai][bj][m][1] * rs[mm];
                    if (rope[bj]) { const pg8::f32x4 c = cv[mm][bj], s = sv[mm][bj]; pg8::f32x4 r0, r1;
                        r0[0] = v0[0] * c[0] - v0[1] * s[0]; r0[1] = v0[0] * s[0] + v0[1] * c[0]; r0[2] = v0[2] * c[1] - v0[3] * s[1]; r0[3] = v0[2] * s[1] + v0[3] * c[1];
                        r1[0] = v1[0] * c[2] - v1[1] * s[2]; r1[1] = v1[0] * s[2] + v1[1] * c[2]; r1[2] = v1[2] * c[3] - v1[3] * s[3]; r1[3] = v1[2] * s[3] + v1[3] * c[3];
                        v0 = r0; v1 = r1; }
                    *(u32x4_t*)(Q + (size_t)row * QW + c8[bj]) = pack8(v0, v1); } }
        }
    }
};
struct EpiKVup {
    static constexpr bool PERM = true, AFTER_DRAIN = false;
    bf16* Kd; bf16* Vd; const float* rstd;
    __device__ __forceinline__ void operator()(EPI_ARGS) const {
        float rs[2][4];
#pragma unroll
        for (int ai = 0; ai < 2; ++ai)
#pragma unroll
            for (int m = 0; m < 4; ++m) rs[ai][m] = rstd[EPI_ROW(ai, m)];
#pragma unroll
        for (int ai = 0; ai < 2; ++ai)
#pragma unroll
            for (int m = 0; m < 4; ++m) { const int row = EPI_ROW(ai, m);
#pragma unroll
                for (int bj = 0; bj < 2; ++bj) { const int c8 = u.pn * 256 + bj * 128 + wc * 32 + 8 * fq;
                    bf16* dst = (c8 < 512) ? Kd + (size_t)row * QW + (c8 >> 6) * 96 + (c8 & 63) : Vd + (size_t)row * 512 + (c8 - 512);
                    *(u32x4_t*)dst = pack8(acc[ai][bj][m][0] * rs[ai][m], acc[ai][bj][m][1] * rs[ai][m]); } }
    }
};
struct EpiBranch {
    static constexpr bool PERM = true, AFTER_DRAIN = false;
    const bf16* G; bf16* Mg; int b, pad;
    __device__ __forceinline__ void operator()(EPI_ARGS) const {
#pragma unroll
        for (int ai = 0; ai < 2; ++ai) {
            u32x4_t gv[4][2], pv[4][2];
#pragma unroll
            for (int m = 0; m < 4; ++m)
#pragma unroll
                for (int bj = 0; bj < 2; ++bj) { const int row = EPI_ROW(ai, m), c8 = u.pn * 256 + bj * 128 + wc * 32 + 8 * fq;
                    gv[m][bj] = *(const u32x4_t*)(G + (size_t)row * 3072 + b * 1024 + c8); if (b > 0) pv[m][bj] = *(const u32x4_t*)(Mg + (size_t)row * DM + c8); }
#pragma unroll
            for (int m = 0; m < 4; ++m)
#pragma unroll
                for (int bj = 0; bj < 2; ++bj) { const int row = EPI_ROW(ai, m), c8 = u.pn * 256 + bj * 128 + wc * 32 + 8 * fq;
                    pg8::f32x4 g0, g1; unpack8(gv[m][bj], g0, g1);
                    pg8::f32x4 v0 = acc[ai][bj][m][0] * g0, v1 = acc[ai][bj][m][1] * g1;
                    if (b > 0) { pg8::f32x4 p0, p1; unpack8(pv[m][bj], p0, p1); v0 += p0; v1 += p1; }
                    *(u32x4_t*)(Mg + (size_t)row * DM + c8) = pack8(v0, v1); }
        }
    }
};
template <bool WB> struct EpiResid {
    static constexpr bool PERM = true, AFTER_DRAIN = false;
    const float* res; float* xo; bf16* xb; float* ssq;
    __device__ __forceinline__ void operator()(EPI_ARGS) const {
#pragma unroll
        for (int ai = 0; ai < 2; ++ai) {
            pg8::f32x4 rv[4][2][2];
#pragma unroll
            for (int m = 0; m < 4; ++m)
#pragma unroll
                for (int bj = 0; bj < 2; ++bj) { const size_t o = (size_t)EPI_ROW(ai, m) * DM + u.pn * 256 + bj * 128 + wc * 32 + 8 * fq;
                    rv[m][bj][0] = *(const pg8::f32x4*)(res + o); rv[m][bj][1] = *(const pg8::f32x4*)(res + o + 4); }
#pragma unroll
            for (int m = 0; m < 4; ++m) { const int row = EPI_ROW(ai, m); float s = 0.f;
#pragma unroll
                for (int bj = 0; bj < 2; ++bj) { const size_t o = (size_t)row * DM + u.pn * 256 + bj * 128 + wc * 32 + 8 * fq;
                    const pg8::f32x4 v0 = rv[m][bj][0] + acc[ai][bj][m][0], v1 = rv[m][bj][1] + acc[ai][bj][m][1];
                    *(pg8::f32x4*)(xo + o) = v0; *(pg8::f32x4*)(xo + o + 4) = v1;
                    if (WB) *(u32x4_t*)(xb + o) = pack8(v0, v1);
                    s += (v0[0] * v0[0] + v0[1] * v0[1]) + (v0[2] * v0[2] + v0[3] * v0[3]) + (v1[0] * v1[0] + v1[1] * v1[1]) + (v1[2] * v1[2] + v1[3] * v1[3]); }
                s += __shfl_xor(s, 16); s += __shfl_xor(s, 32);
                if (fq == 0) (void)__hip_atomic_fetch_add(ssq + row, s, __ATOMIC_RELAXED, __HIP_MEMORY_SCOPE_AGENT); }
        }
    }
};
__device__ __forceinline__ float rstd_from_ssq(const float* ssq, int row) { return 1.0f / sqrtf(ssq[row] * (1.0f / DM) + EPS); }
struct EpiFfnUp {
    static constexpr bool PERM = true, AFTER_DRAIN = false;
    bf16* act; const float* ssq;
    __device__ __forceinline__ void operator()(EPI_ARGS) const {
        const int c8 = u.pn * 128 + wc * 32 + 8 * fq;
        float rs[2][4];
#pragma unroll
        for (int ai = 0; ai < 2; ++ai)
#pragma unroll
            for (int m = 0; m < 4; ++m) rs[ai][m] = ssq[EPI_ROW(ai, m)];
#pragma unroll
        for (int ai = 0; ai < 2; ++ai)
#pragma unroll
            for (int m = 0; m < 4; ++m) { const float r = 1.0f / sqrtf(rs[ai][m] * (1.0f / DM) + EPS);
                pg8::f32x4 g0 = acc[ai][0][m][0] * r, g1 = acc[ai][0][m][1] * r; const pg8::f32x4 u0 = acc[ai][1][m][0] * r, u1 = acc[ai][1][m][1] * r;
#pragma unroll
                for (int e = 0; e < 4; ++e) { g0[e] = silu_f(g0[e]) * u0[e]; g1[e] = silu_f(g1[e]) * u1[e]; }
                *(u32x4_t*)(act + (size_t)EPI_ROW(ai, m) * DFF + c8) = pack8(g0, g1); }
    }
};
typedef float f32x4g __attribute__((ext_vector_type(4)));
__device__ __forceinline__ float wave_sum(float v) {
#pragma unroll
    for (int o = 1; o < 64; o <<= 1) v += __shfl_xor(v, o);
    return v;
}
struct MapWin { __device__ __forceinline__ int operator()(int n) const {
    if (n < 3072) return n;
    if (n < 3584) { const int j = n - 3072; if (j < 384) return 3072 + j; if (j < 416) { const int i = (j - 384) >> 1, pp = (j - 384) & 1; return 3712 + i + 16 * pp; } if (j < 448) return 5280 + (j - 416); return -1; }
    if (n < 3840) return 3456 + (n - 3584);
    if (n < 4352) return 3744 + (n - 3840);
    if (n < 4864) return 4256 + (n - 4352);
    if (n < 5376) return 4768 + (n - 4864);
    return 5312 + (n - 5376); } };
struct MapUq { __device__ __forceinline__ int operator()(int n) const { const int h = n / 96, j = n - 96 * h; if (j < 64) return n; const int i = (j - 64) >> 1, pp = (j - 64) & 1; return h * 96 + 64 + i + 16 * pp; } };
struct MapId { __device__ __forceinline__ int operator()(int n) const { return n; } };
struct RowId { __device__ __forceinline__ int operator()(int n) const { return n; } };
struct RowGU { int up; __device__ __forceinline__ int operator()(int j) const { return (j >> 7) * 256 + (j & 127) + up * 128; } };

template <class SCol, class DRow>
__device__ __forceinline__ void tr_job(const float* src, int ld_src, int K, int NL, bf16* dst, int ldd, const float* rs, const SCol& scol, const DRow& drow, LAS float* scr, int gw, int ngw, int lane) {
    const int nblk = NL / 32, nitems = (K / 64) * nblk;
    for (int it = gw; it < nitems; it += ngw) {
        const int kb = it / nblk, nb = it - kb * nblk, k0 = 64 * kb, n0 = 32 * nb;
        const int sc = scol(n0 + (lane & 31));
#pragma unroll
        for (int i = 0; i < 32; ++i) { const int kk = 2 * i + (lane >> 5); float v = 0.f;
            if (sc >= 0) { v = src[(size_t)(k0 + kk) * ld_src + sc]; if (rs) v *= rs[k0 + kk]; }
            scr[kk * 33 + (lane & 31)] = v; }
        LDS_WAIT(); asm volatile("" ::: "memory");
        const int c = lane & 7;
#pragma unroll
        for (int j = 0; j < 4; ++j) { const int n = (lane >> 3) + 8 * j; const LAS float* s = scr + (8 * c) * 33 + n;
            v4u o; o.x = pk2(s[0 * 33], s[1 * 33]); o.y = pk2(s[2 * 33], s[3 * 33]); o.z = pk2(s[4 * 33], s[5 * 33]); o.w = pk2(s[6 * 33], s[7 * 33]);
            *(GAS v4u*)(dst + (size_t)drow(n0 + n) * ldd + k0 + 8 * c) = o; }
        LDS_WAIT(); asm volatile("" ::: "memory");
    }
}
__device__ __forceinline__ double rope_inv(int i) {
    switch (i) {
        case 0: return 1.0; case 1: return 0.5623413251903491; case 2: return 0.31622776601683794; case 3: return 0.17782794100389228;
        case 4: return 0.1; case 5: return 0.05623413251903491; case 6: return 0.03162277660168379; case 7: return 0.01778279410038923;
        case 8: return 0.01; case 9: return 0.005623413251903491; case 10: return 0.0031622776601683794; case 11: return 0.0017782794100389228;
        case 12: return 0.001; case 13: return 0.0005623413251903491; case 14: return 0.00031622776601683794; default: return 0.00017782794100389227; }
}
template <int NR>
__device__ __forceinline__ void rows_to_bf16(const float* x, bf16* o, float* rstd_out, const float* gain, int m0, int stride, int mend, int lane) {
    f32x4g v[NR][4];
#pragma unroll
    for (int r = 0; r < NR; ++r) { const int m = m0 + r * stride; if (m < mend) { const GAS f32x4g* xr = (const GAS f32x4g*)(x + (size_t)m * DM) + lane;
#pragma unroll
        for (int j = 0; j < 4; ++j) v[r][j] = xr[64 * j]; } }
#pragma unroll
    for (int r = 0; r < NR; ++r) { const int m = m0 + r * stride; if (m < mend) {
        float s = 0.f;
#pragma unroll
        for (int j = 0; j < 4; ++j) s += (v[r][j].x * v[r][j].x + v[r][j].y * v[r][j].y) + (v[r][j].z * v[r][j].z + v[r][j].w * v[r][j].w);
        const float rstd = 1.f / sqrtf(wave_sum(s) * (1.f / DM) + EPS);
        if (rstd_out && lane == 0) rstd_out[m] = rstd;
        GAS unsigned long long* o8 = (GAS unsigned long long*)(o + (size_t)m * DM) + lane;
#pragma unroll
        for (int j = 0; j < 4; ++j) { f32x4g w = v[r][j];
            if (gain) { const f32x4g g = ((const GAS f32x4g*)gain)[lane + 64 * j]; w = w * rstd * g; }
            o8[64 * j] = (unsigned long long)pk2(w.x, w.y) | ((unsigned long long)pk2(w.z, w.w) << 32); } } }
}

__device__ __forceinline__ void phase_prologue(const Params& p, LAS unsigned char* lds, int gw, int ngw, int wave, int lane) {
    LAS float* scr = (LAS float*)(lds + wave * 16384);
    unsigned char* ws = p.ws;
    tr_job(p.in[I_WIN], NIN, DM, NINP, (bf16*)(ws + WS_WIN), DM, p.in[I_GMIX], MapWin{}, RowId{}, scr, gw, ngw, lane);
    tr_job(p.in[I_MEMWKV], 1024, DM, 1024, (bf16*)(ws + WS_WKVM), DM, nullptr, MapId{}, RowId{}, scr, gw, ngw, lane);
    tr_job(p.in[I_WUQ], QW, QR, QW, (bf16*)(ws + WS_WUQ), QR, p.in[I_GQ], MapUq{}, RowId{}, scr, gw, ngw, lane);
    tr_job(p.in[I_WUK], 512, KVR, 512, (bf16*)(ws + WS_WUKV), KVR, p.in[I_GKV], MapId{}, RowId{}, scr, gw, ngw, lane);
    tr_job(p.in[I_WUV], 512, KVR, 512, (bf16*)(ws + WS_WUKV) + (size_t)512 * KVR, KVR, p.in[I_GKV], MapId{}, RowId{}, scr, gw, ngw, lane);
    for (int b = 0; b < 3; ++b) tr_job(p.in[I_WBR] + (size_t)b * 512 * DM, DM, 512, DM, (bf16*)(ws + WS_WBR) + (size_t)b * DM * 512, 512, nullptr, MapId{}, RowId{}, scr, gw, ngw, lane);
    tr_job(p.in[I_WOUT], DM, DM, DM, (bf16*)(ws + WS_WOUT), DM, nullptr, MapId{}, RowId{}, scr, gw, ngw, lane);
    tr_job(p.in[I_WFG], DFF, DM, DFF, (bf16*)(ws + WS_WGU), DM, p.in[I_GFFN], MapId{}, RowGU{0}, scr, gw, ngw, lane);
    tr_job(p.in[I_WFU], DFF, DM, DFF, (bf16*)(ws + WS_WGU), DM, p.in[I_GFFN], MapId{}, RowGU{1}, scr, gw, ngw, lane);
    tr_job(p.in[I_WFD], DM, DFF, DM, (bf16*)(ws + WS_WDN), DFF, nullptr, MapId{}, RowId{}, scr, gw, ngw, lane);
    { bf16* W = (bf16*)(ws + WS_WML);
      for (int e = gw * 64 + lane; e < 1024 * 512; e += ngw * 64) { const int n = e >> 9, k = e & 511, part = n >> 9, h = (n >> 6) & 7, d = n & 63; float v = 0.f;
          if ((k >> 6) == h) { const float* w = part ? p.in[I_WK] : p.in[I_WQ]; v = w[(size_t)h * 4096 + (k & 63) * 64 + d]; if (part) v *= 0.125f; }
          W[e] = (bf16)f2bf(v); } }
    for (int m = gw; m < M; m += 4 * ngw) rows_to_bf16<4>(p.in[I_X], (bf16*)(ws + WS_XB), (float*)(ws + WS_RSTDX), nullptr, m, ngw, M, lane);
    for (int m = gw; m < MMEM; m += 4 * ngw) rows_to_bf16<4>(p.in[I_MEM], (bf16*)(ws + WS_MEMN), nullptr, p.in[I_MEMG], m, ngw, MMEM, lane);
    { const int* pos = (const int*)p.in[I_POS]; float* cs = (float*)(ws + WS_COS); float* sn = (float*)(ws + WS_SIN);
      for (int e = gw * 64 + lane; e < M * 16; e += ngw * 64) { const int m = e >> 4, i = e & 15;
          const double rev = (double)pos[m] * rope_inv(i) * 0.15915494309189535; const float fr = (float)(rev - __builtin_rint(rev));
          cs[e] = __builtin_amdgcn_cosf(fr); sn[e] = __builtin_amdgcn_sinf(fr); } }
}

__device__ __forceinline__ void phase_tokprep(const Params& p, int gw, int ngw, int lane) {
    unsigned char* ws = p.ws;
    const bf16* ZA = (const bf16*)(ws + WS_ZA); const bf16* CKV = (const bf16*)(ws + WS_CKV); const bf16* MU = (const bf16*)(ws + WS_MU);
    bf16* Kd = (bf16*)((unsigned char*)p.out + DO_K); bf16* Cml = (bf16*)(ws + WS_CML);
    const float* cs = (const float*)(ws + WS_COS); const float* sn = (const float*)(ws + WS_SIN); const float* cw = p.in[I_CONVW];
    float wv[5][8];
#pragma unroll
    for (int j = 0; j < 5; ++j)
#pragma unroll
        for (int e = 0; e < 8; ++e) wv[j][e] = cw[j * 512 + lane * 8 + e];
    for (int m = gw; m < M; m += ngw) {
        float s1 = 0.f, s2 = 0.f;
        if (lane < 48) { const u32x4_t w = *(const u32x4_t*)(ZA + (size_t)m * 512 + lane * 8);
            const float a0 = bflo(w.x), a1 = bfhi(w.x), a2 = bflo(w.y), a3 = bfhi(w.y), a4 = bflo(w.z), a5 = bfhi(w.z), a6 = bflo(w.w), a7 = bfhi(w.w);
            s1 = (a0 * a0 + a1 * a1) + (a2 * a2 + a3 * a3) + (a4 * a4 + a5 * a5) + (a6 * a6 + a7 * a7); }
        if (lane < 32) { const u32x4_t w = *(const u32x4_t*)(CKV + (size_t)m * 256 + lane * 8);
            const float a0 = bflo(w.x), a1 = bfhi(w.x), a2 = bflo(w.y), a3 = bfhi(w.y), a4 = bflo(w.z), a5 = bfhi(w.z), a6 = bflo(w.w), a7 = bfhi(w.w);
            s2 = (a0 * a0 + a1 * a1) + (a2 * a2 + a3 * a3) + (a4 * a4 + a5 * a5) + (a6 * a6 + a7 * a7); }
        s1 = wave_sum(s1); s2 = wave_sum(s2);
        if (lane == 0) { ((float*)(ws + WS_RSTDCQ))[m] = 1.f / sqrtf(s1 * (1.f / QR) + EPS); ((float*)(ws + WS_RSTDCKV))[m] = 1.f / sqrtf(s2 * (1.f / KVR) + EPS); }
        if (lane < 16) { const unsigned w = *(const unsigned*)(ZA + (size_t)m * 512 + ZA_KR + 2 * lane); const float x1 = bflo(w), x2 = bfhi(w), c = cs[(size_t)m * 16 + lane], s = sn[(size_t)m * 16 + lane];
            const unsigned o = pk2(x1 * c - x2 * s, x1 * s + x2 * c);
#pragma unroll
            for (int h = 0; h < 8; ++h) *(unsigned*)(Kd + (size_t)m * QW + h * 96 + 64 + 2 * lane) = o; }
        const int t = m & (SEQ - 1); float a[8];
#pragma unroll
        for (int e = 0; e < 8; ++e) a[e] = 0.f;
#pragma unroll
        for (int j = 0; j < 5; ++j) { const int tt = t + j - 2;
            if (tt >= 0 && tt < SEQ) { const u32x4_t w = *(const u32x4_t*)(MU + (size_t)(m + j - 2) * 512 + lane * 8);
                a[0] += wv[j][0] * bflo(w.x); a[1] += wv[j][1] * bfhi(w.x); a[2] += wv[j][2] * bflo(w.y); a[3] += wv[j][3] * bfhi(w.y);
                a[4] += wv[j][4] * bflo(w.z); a[5] += wv[j][5] * bfhi(w.z); a[6] += wv[j][6] * bflo(w.w); a[7] += wv[j][7] * bfhi(w.w); } }
        u32x4_t o; o.x = pk2(silu_f(a[0]), silu_f(a[1])); o.y = pk2(silu_f(a[2]), silu_f(a[3])); o.z = pk2(silu_f(a[4]), silu_f(a[5])); o.w = pk2(silu_f(a[6]), silu_f(a[7]));
        *(u32x4_t*)(Cml + (size_t)m * 512 + lane * 8) = o;
    }
}
__device__ __forceinline__ void phase_final(const Params& p, int gw, int ngw, int lane, float pscale, float pspike) {
    const float* ssq = (const float*)(p.ws + WS_SSQ2); const float* g = p.in[I_GFINAL];
    f32x4g gv[4];
#pragma unroll
    for (int j = 0; j < 4; ++j) gv[j] = ((const f32x4g*)g)[lane + 64 * j];
    for (int m = gw; m < M; m += ngw) { const float rs = rstd_from_ssq(ssq, m); f32x4g* xr = (f32x4g*)(p.out + (size_t)m * DM) + lane;
#pragma unroll
        for (int j = 0; j < 4; ++j) { f32x4g v = xr[64 * j] * (rs * pscale) * gv[j]; if (m == 0 && lane == 0 && j == 0) v.x += pspike; xr[64 * j] = v; } }
}
namespace att {
using bf16x8 = __attribute__((ext_vector_type(8))) short;
using s16x4 = __attribute__((ext_vector_type(4))) short;
using f32x16 = __attribute__((ext_vector_type(16))) float;
using u32x4 = __attribute__((ext_vector_type(4))) unsigned;
constexpr int NW = 8, QBLK = 32, KVBLK = 64;
constexpr size_t SHM_V = KVBLK * 128 * 2, SHM_K = KVBLK * 128 * 2, SHM_ATTN = 2 * SHM_V + 2 * SHM_K + NW * 64 * 4;
constexpr float THR = 8.f;
#define KSWZ(row, colB) ((row) * 256 + ((colB) ^ (((row) & 7) << 4)))
#define SBAR() __builtin_amdgcn_sched_barrier(0)
__device__ __forceinline__ int crow(int r, int hi) { return (r & 3) + 8 * (r >> 2) + 4 * hi; }
__device__ __forceinline__ unsigned cvtpk(float lo, float hi) { unsigned r; asm volatile("v_cvt_pk_bf16_f32 %0, %1, %2" : "=v"(r) : "v"(lo), "v"(hi)); return r; }

template <int MODE> struct Cfg;
template <> struct Cfg<0> { static constexpr float SCALE = 0.10206207261596575f; };
template <> struct Cfg<1> { static constexpr float SCALE = 0.08838834764831845f; };

template <int MODE> __device__ __forceinline__ void partialSM(f32x16& p0, f32x16& p1, float& m_reg, float& mn, float& alpha) {
  constexpr float SCALE = Cfg<MODE>::SCALE, C = SCALE * 1.4426950408889634f;
  float pmax = p0[0];
#pragma unroll
  for (int r = 1; r < 16; ++r) pmax = fmaxf(pmax, p0[r]);
#pragma unroll
  for (int r = 0; r < 16; ++r) pmax = fmaxf(pmax, p1[r]);
  { auto rr = __builtin_amdgcn_permlane32_swap(__float_as_uint(pmax), __float_as_uint(pmax), false, false);
    pmax = fmaxf(__uint_as_float(rr[0]), __uint_as_float(rr[1])); }
  if (__builtin_expect(__all(pmax - m_reg <= THR / SCALE), 1)) { mn = m_reg; alpha = 1.f; }
  else { mn = fmaxf(m_reg, pmax); alpha = __builtin_amdgcn_exp2f((m_reg - mn) * C); m_reg = mn; }
  const float mnC = -mn * C;
#pragma unroll
  for (int r = 0; r < 16; ++r) p0[r] = fmaf(p0[r], C, mnC);
#pragma unroll
  for (int r = 0; r < 16; ++r) p1[r] = fmaf(p1[r], C, mnC);
#pragma unroll
  for (int r = 0; r < 16; ++r) p0[r] = __builtin_amdgcn_exp2f(p0[r]);
}
__device__ __forceinline__ void finishSM(f32x16& p0, f32x16& p1, float alpha, float& l_reg, bf16x8& pa0, bf16x8& pa1, bf16x8& pa2, bf16x8& pa3) {
#pragma unroll
  for (int r = 0; r < 16; ++r) p1[r] = __builtin_amdgcn_exp2f(p1[r]);
  float ps = 0;
#pragma unroll
  for (int r = 0; r < 16; ++r) ps += p0[r];
#pragma unroll
  for (int r = 0; r < 16; ++r) ps += p1[r];
  { auto rr = __builtin_amdgcn_permlane32_swap(__float_as_uint(ps), __float_as_uint(ps), false, false);
    ps = __uint_as_float(rr[0]) + __uint_as_float(rr[1]); }
  l_reg = l_reg * alpha + ps;
#define PK4(P, BASE, OUT) do { unsigned a0 = cvtpk(P[BASE + 0], P[BASE + 1]), a1 = cvtpk(P[BASE + 2], P[BASE + 3]);   \
    unsigned b0 = cvtpk(P[BASE + 4], P[BASE + 5]), b1 = cvtpk(P[BASE + 6], P[BASE + 7]);                              \
    auto r0 = __builtin_amdgcn_permlane32_swap(a0, b0, false, false); auto r1 = __builtin_amdgcn_permlane32_swap(a1, b1, false, false); \
    u32x4 w = {r0[0], r1[0], r0[1], r1[1]}; OUT = *reinterpret_cast<bf16x8*>(&w); } while (0)
  PK4(p0, 0, pa0); PK4(p0, 8, pa1); PK4(p1, 0, pa2); PK4(p1, 8, pa3);
#undef PK4
}
template <int ND0> __device__ __forceinline__ void qkt(f32x16& p0, f32x16& p1, const char* Ks, const bf16x8* qr, int r32, int hi) {
  p0 = f32x16{}; p1 = f32x16{};
#pragma unroll
  for (int d0 = 0; d0 < ND0; ++d0) { const int cb = (d0 * 16 + hi * 8) * 2;
    const bf16x8 b0 = *reinterpret_cast<const bf16x8*>(Ks + KSWZ(r32, cb));
    const bf16x8 b1 = *reinterpret_cast<const bf16x8*>(Ks + KSWZ(32 + r32, cb));
    p0 = __builtin_amdgcn_mfma_f32_32x32x16_bf16(b0, qr[d0], p0, 0, 0, 0);
    p1 = __builtin_amdgcn_mfma_f32_32x32x16_bf16(b1, qr[d0], p1, 0, 0, 0); }
}
__device__ __forceinline__ int v_st(int k, int c) { const int kk = (k & ~0xC) | ((k & 4) << 1) | ((k & 8) >> 1); return ((kk >> 3) * 4 + (c >> 5)) * 512 + ((kk & 7) * 32 + (c & 31)) * 2; }
__device__ __forceinline__ int v_rd_base(int lane) { return ((lane & 3) << 3) | (((lane >> 2) & 3) << 6) | (((lane >> 4) & 1) << 5) | (((lane >> 5) & 1) << 8); }
constexpr int v_rd_off(int d0, int ks, int half) { return d0 * 512 + ks * 4096 + half * 2048; }
template <int OFF> __device__ __forceinline__ s16x4 tr_read(int vb) { s16x4 r; asm volatile("ds_read_b64_tr_b16 %0, %1 offset:%2" : "=&v"(r) : "v"(vb), "i"(OFF) : "memory"); return r; }
template <int D0> __device__ __forceinline__ void pv_one(f32x16& od, int vb, bf16x8 pa0, bf16x8 pa1, bf16x8 pa2, bf16x8 pa3) {
  const s16x4 l0 = tr_read<v_rd_off(D0, 0, 0)>(vb), h0 = tr_read<v_rd_off(D0, 0, 1)>(vb), l1 = tr_read<v_rd_off(D0, 1, 0)>(vb), h1 = tr_read<v_rd_off(D0, 1, 1)>(vb);
  const s16x4 l2 = tr_read<v_rd_off(D0, 2, 0)>(vb), h2 = tr_read<v_rd_off(D0, 2, 1)>(vb), l3 = tr_read<v_rd_off(D0, 3, 0)>(vb), h3 = tr_read<v_rd_off(D0, 3, 1)>(vb);
  asm volatile("s_waitcnt lgkmcnt(0)" ::: "memory"); SBAR();
#define PK(L, H) (bf16x8){L[0], L[1], L[2], L[3], H[0], H[1], H[2], H[3]}
  od = __builtin_amdgcn_mfma_f32_32x32x16_bf16(pa0, PK(l0, h0), od, 0, 0, 0);
  od = __builtin_amdgcn_mfma_f32_32x32x16_bf16(pa1, PK(l1, h1), od, 0, 0, 0);
  od = __builtin_amdgcn_mfma_f32_32x32x16_bf16(pa2, PK(l2, h2), od, 0, 0, 0);
  od = __builtin_amdgcn_mfma_f32_32x32x16_bf16(pa3, PK(l3, h3), od, 0, 0, 0);
#undef PK
}
template <int NDV> __device__ __forceinline__ void pv_all(f32x16* o, int vb, bf16x8 pa0, bf16x8 pa1, bf16x8 pa2, bf16x8 pa3) {
  pv_one<0>(o[0], vb, pa0, pa1, pa2, pa3); pv_one<1>(o[1], vb, pa0, pa1, pa2, pa3);
  if constexpr (NDV == 4) { pv_one<2>(o[2], vb, pa0, pa1, pa2, pa3); pv_one<3>(o[3], vb, pa0, pa1, pa2, pa3); }
}

template <int MODE, int ND0, int NDV>
__device__ __forceinline__ void attn_unit(const bf16* Qb, int ldq, const bf16* __restrict__ Kh, int ldk, const bf16* __restrict__ Vh, int ldv, bf16* Ob, int ldo, int seq, char* lds) {
  constexpr float SCALE = Cfg<MODE>::SCALE;
  int tid = threadIdx.x; asm volatile("" : "+v"(tid));
  const int wid = tid >> 6, lane = tid & 63, r32 = lane & 31, hi = lane >> 5;
  char* V_lds = lds; char* K_lds = lds + 2 * SHM_V;
  float* wsf = (float*)(lds + 2 * SHM_V + 2 * SHM_K) + wid * 64; float* li_l = wsf; float* al_l = wsf + 32;
  float m_reg = -1e30f, l_reg = 0; f32x16 o[NDV]; bf16x8 qr[ND0];
#pragma unroll
  for (int d = 0; d < NDV; ++d) o[d] = f32x16{};
  const bf16* Qw = Qb + (long)(wid * QBLK + r32) * ldq + hi * 8;
#pragma unroll
  for (int d0 = 0; d0 < ND0; ++d0) qr[d0] = *reinterpret_cast<const bf16x8*>(Qw + d0 * 16);
  const int sr = tid >> 4, sc = (tid & 15) * 8, vst0 = v_st(sr, sc), vst1 = v_st(32 + sr, sc);
  const bool kact = sc < ND0 * 16, vact = sc < NDV * 32;
  const int vb0 = (int)(uintptr_t)V_lds + v_rd_base(lane);
  struct { bf16x8 vs0, vs1, ks0, ks1; } sr_[2];
#define SLOAD(i, k0) do { if (vact) { sr_[i].vs0 = *reinterpret_cast<const bf16x8*>(&Vh[(long)((k0) + sr) * ldv + sc]); sr_[i].vs1 = *reinterpret_cast<const bf16x8*>(&Vh[(long)((k0) + 32 + sr) * ldv + sc]); } \
    if (kact) { sr_[i].ks0 = *reinterpret_cast<const bf16x8*>(&Kh[(long)((k0) + sr) * ldk + sc]); sr_[i].ks1 = *reinterpret_cast<const bf16x8*>(&Kh[(long)((k0) + 32 + sr) * ldk + sc]); } } while (0)
#define SWRITE(b, i) do { if (vact) { *(bf16x8*)(V_lds + (b) * SHM_V + vst0) = sr_[i].vs0; *(bf16x8*)(V_lds + (b) * SHM_V + vst1) = sr_[i].vs1; } \
    if (kact) { const int kc = sc * 2; *(bf16x8*)(K_lds + (b) * SHM_K + KSWZ(sr, kc)) = sr_[i].ks0; *(bf16x8*)(K_lds + (b) * SHM_K + KSWZ(32 + sr, kc)) = sr_[i].ks1; } } while (0)
#define RESC(a) do { if (__any((a) < 1.f)) { if (hi == 0) al_l[r32] = (a); asm volatile("s_waitcnt lgkmcnt(0)" ::: "memory"); \
    _Pragma("unroll") for (int d = 0; d < NDV; ++d) _Pragma("unroll") for (int r = 0; r < 16; ++r) o[d][r] *= al_l[crow(r, hi)]; } } while (0)
  f32x16 pA0, pA1, pB0, pB1; float mnA, mnB, alA, alB; bf16x8 pa0, pa1, pa2, pa3; const int NT = seq / KVBLK;
  SLOAD(0, 0); asm volatile("s_waitcnt vmcnt(0)" ::: "memory"); SWRITE(0, 0); __syncthreads();
  qkt<ND0>(pA0, pA1, K_lds, qr, r32, hi); partialSM<MODE>(pA0, pA1, m_reg, mnA, alA);
  SLOAD(1, KVBLK); if (2 < NT) SLOAD(0, 2 * KVBLK);
  SWRITE(1, 1); __syncthreads();
  for (int j = 1; j + 1 < NT; j += 2) {
    SBAR(); qkt<ND0>(pB0, pB1, K_lds + SHM_K, qr, r32, hi);
    finishSM(pA0, pA1, alA, l_reg, pa0, pa1, pa2, pa3); SBAR();
    SLOAD(1, (j + 2) * KVBLK); SBAR();
    pv_all<NDV>(o, vb0, pa0, pa1, pa2, pa3); partialSM<MODE>(pB0, pB1, m_reg, mnB, alB);
    __syncthreads(); SWRITE(0, 0);
    RESC(alB); __syncthreads();
    SBAR(); qkt<ND0>(pA0, pA1, K_lds, qr, r32, hi);
    finishSM(pB0, pB1, alB, l_reg, pa0, pa1, pa2, pa3); SBAR();
    if (j + 3 < NT) SLOAD(0, (j + 3) * KVBLK); SBAR();
    pv_all<NDV>(o, vb0 + (int)SHM_V, pa0, pa1, pa2, pa3); partialSM<MODE>(pA0, pA1, m_reg, mnA, alA);
    __syncthreads(); SWRITE(1, 1);
    RESC(alA); __syncthreads();
  }
  SBAR(); qkt<ND0>(pB0, pB1, K_lds + SHM_K, qr, r32, hi);
  finishSM(pA0, pA1, alA, l_reg, pa0, pa1, pa2, pa3); SBAR();
  pv_all<NDV>(o, vb0, pa0, pa1, pa2, pa3); partialSM<MODE>(pB0, pB1, m_reg, mnB, alB);
  __syncthreads(); RESC(alB);
  finishSM(pB0, pB1, alB, l_reg, pa0, pa1, pa2, pa3); SBAR();
  pv_all<NDV>(o, vb0 + (int)SHM_V, pa0, pa1, pa2, pa3);
  if (hi == 0) li_l[r32] = l_reg; asm volatile("s_waitcnt lgkmcnt(0)" ::: "memory");
  float rli[16];
#pragma unroll
  for (int r = 0; r < 16; ++r) rli[r] = __builtin_amdgcn_rcpf(li_l[crow(r, hi)]);
  bf16* Ow = Ob + (long)(wid * QBLK) * ldo;
#pragma unroll
  for (int r = 0; r < 16; ++r) { const int orow = crow(r, hi);
#pragma unroll
    for (int d0 = 0; d0 < NDV; ++d0) Ow[(long)orow * ldo + d0 * 32 + r32] = (bf16)f2bf(o[d0][r] * rli[r]); }
  __syncthreads();
#undef SLOAD
#undef SWRITE
#undef RESC
}
#undef KSWZ
#undef SBAR
}

__device__ __forceinline__ void phase_attn_mla(const Params& p, char* lds, int vcu, int G) {
    const bf16* Q = (const bf16*)((const unsigned char*)p.out + DO_Q); const bf16* K = (const bf16*)((const unsigned char*)p.out + DO_K); const bf16* V = (const bf16*)((const unsigned char*)p.out + DO_V);
    bf16* O = (bf16*)(p.ws + WS_OMLA);
    for (int u = vcu; u < BATCH * MLAH * (SEQ / 256); u += G) { const int qb = u & 7, h = (u >> 3) & 7, b = u >> 6; const size_t r0 = (size_t)b * SEQ;
        att::attn_unit<0, 6, 2>(Q + (r0 + qb * 256) * QW + h * 96, QW, K + r0 * QW + h * 96, QW, V + r0 * 512 + h * 64, 512, O + (r0 + qb * 256) * 512 + h * 64, 512, SEQ, lds); }
}
__device__ __forceinline__ void phase_attn_mem(const Params& p, char* lds, int vcu, int G) {
    bf16* Q = (bf16*)(p.ws + WS_MEMQ); const bf16* KV = (const bf16*)(p.ws + WS_MEMKV);
    for (int u = vcu; u < BATCH * MEMH * (SEQ / 256); u += G) { const int qb = u & 7, h = (u >> 3) & 3, b = u >> 5;
        bf16* q = Q + ((size_t)b * SEQ + qb * 256) * 512 + h * 128;
        att::attn_unit<1, 8, 4>(q, 512, KV + (size_t)b * MEM_LEN * 1024 + h * 128, 1024, KV + (size_t)b * MEM_LEN * 1024 + 512 + h * 128, 1024, q, 512, MEM_LEN, lds); }
}
namespace ml {
typedef short bf16x8 __attribute__((ext_vector_type(8)));
typedef short s16x4 __attribute__((ext_vector_type(4)));
typedef float f32x4 __attribute__((ext_vector_type(4)));
typedef unsigned u32x4 __attribute__((ext_vector_type(4)));
typedef unsigned u32x2 __attribute__((ext_vector_type(2)));
constexpr int LP = 72;
constexpr int OFF_Q = 0, OFF_K = 64 * LP * 2, OFF_V = 2 * 64 * LP * 2, OFF_C = 3 * 64 * LP * 2, OFF_N = 4 * 64 * LP * 2, OFF_VEC = OFF_N + 256, VEC_BYTES = 5 * 256, GSZ = 42496;
static_assert(OFF_VEC + 4 * VEC_BYTES <= GSZ, "mlstm lds map");
constexpr int LDS_BYTES = 2 * GSZ;
__device__ __forceinline__ s16x4 trd(unsigned addr) { s16x4 r; asm volatile("ds_read_b64_tr_b16 %0, %1" : "=v"(r) : "v"(addr) : "memory"); return r; }
__device__ __forceinline__ void lds_wait() { asm volatile("s_waitcnt lgkmcnt(0)" ::: "memory"); __builtin_amdgcn_sched_barrier(0); }
__device__ __forceinline__ bf16x8 cat(s16x4 lo, s16x4 hi) { return (bf16x8){lo[0], lo[1], lo[2], lo[3], hi[0], hi[1], hi[2], hi[3]}; }
__device__ __forceinline__ f32x4 mfma16(bf16x8 a, bf16x8 b, f32x4 c) { return __builtin_amdgcn_mfma_f32_16x16x32_bf16(a, b, c, 0, 0, 0); }
__device__ __forceinline__ void unpack(bf16x8 v, float (&f)[8]) { const u32x4 w = __builtin_bit_cast(u32x4, v);
    f[0] = bflo(w.x); f[1] = bfhi(w.x); f[2] = bflo(w.y); f[3] = bfhi(w.y); f[4] = bflo(w.z); f[5] = bfhi(w.z); f[6] = bflo(w.w); f[7] = bfhi(w.w); }
__device__ __forceinline__ bf16x8 pack(const float (&f)[8]) { u32x4 w; w.x = pg8::cvt_pk_bf16(f[0], f[1]); w.y = pg8::cvt_pk_bf16(f[2], f[3]); w.z = pg8::cvt_pk_bf16(f[4], f[5]); w.w = pg8::cvt_pk_bf16(f[6], f[7]); return __builtin_bit_cast(bf16x8, w); }

__device__ __forceinline__ void mlstm_unit(const Params& p, int b, int h, char* lds) {
    int tid = threadIdx.x; asm volatile("" : "+v"(tid));
    const int lane = tid & 63, gt = tid & 255, fr = lane & 15, fq = lane >> 4, tq = fr >> 2, tp = fr & 3;
    const int wid = __builtin_amdgcn_readfirstlane(tid >> 6), g = wid >> 2, w = wid & 3;
    char* base = lds + g * GSZ;
    bf16* qL = (bf16*)(base + OFF_Q); bf16* kL = (bf16*)(base + OFF_K); bf16* vL = (bf16*)(base + OFF_V); bf16* Cb = (bf16*)(base + OFF_C); float* nv = (float*)(base + OFF_N);
    float* vec = (float*)(base + OFF_VEC + w * VEC_BYTES); float *av = vec, *rv = vec + 64, *wiv = vec + 128, *wsv = vec + 192, *flv = vec + 256;
    const unsigned vL_a = (unsigned)(uintptr_t)vL, kL_a = (unsigned)(uintptr_t)kL;
    unsigned char* ws = p.ws;
    const bf16* Qm = (const bf16*)(ws + WS_QKQ); const bf16* Km = (const bf16*)(ws + WS_QKK); const bf16* Vm = (const bf16*)(ws + WS_MV); const bf16* ZA = (const bf16*)(ws + WS_ZA);
    const bf16* MO = (const bf16*)(ws + WS_MO); bf16* Oml = (bf16*)(ws + WS_OML);
    const size_t rowb = (size_t)b * SEQ; const int hc = h * 64;
    const float bias_i = p.in[I_GBIAS][(g * 2) * 8 + h], bias_f = p.in[I_GBIAS][(g * 2 + 1) * 8 + h];
    f32x4 gh[4];
#pragma unroll
    for (int ne = 0; ne < 4; ++ne) gh[ne] = *(const f32x4*)(p.in[I_GHEAD] + hc + 16 * ne + 4 * fq);
    for (int e = gt; e < 64 * LP / 2; e += 256) ((unsigned*)Cb)[e] = 0u;
    if (gt < 64) nv[gt] = 0.f;
    f32x4 Cacc[4];
#pragma unroll
    for (int n = 0; n < 4; ++n) Cacc[n] = (f32x4){0.f, 0.f, 0.f, 0.f};
    float mprev = -1e30f;
    u32x4 pq[2], pk[2], pv[2]; unsigned short gi, gf;
#define ML_TOK(c, j) (g ? (c) * 64 + 63 - (j) : (c) * 64 + (j))
#define ML_LOAD(c) do { _Pragma("unroll") for (int i = 0; i < 2; ++i) { const int pi = gt + 256 * i, j = pi >> 3, ch = pi & 7; const size_t o = (rowb + ML_TOK(c, j)) * 512 + hc + ch * 8; \
        pq[i] = *(const u32x4*)(Qm + o); pk[i] = *(const u32x4*)(Km + o); pv[i] = *(const u32x4*)(Vm + o); } \
        { const size_t r = rowb + ML_TOK(c, lane); gi = ZA[r * 512 + ZA_MG + (g * 2) * 8 + h]; gf = ZA[r * 512 + ZA_MG + (g * 2 + 1) * 8 + h]; } } while (0)
    ML_LOAD(g ? 31 : 0);
    __syncthreads();
    for (int cc = 0; cc < 32; ++cc) {
        const int c = g ? 31 - cc : cc;
#pragma unroll
        for (int i = 0; i < 2; ++i) { const int pi = gt + 256 * i, j = pi >> 3, ch = pi & 7;
            *(u32x4*)(qL + j * LP + ch * 8) = pq[i]; *(u32x4*)(kL + j * LP + ch * 8) = pk[i]; *(u32x4*)(vL + j * LP + ch * 8) = pv[i]; }
        float decay, mnew;
        { const float ip = bf2f(gi) + bias_i, fp = bf2f(gf) + bias_f;
          const float lf = fminf(fp, 0.f) - log1pf(__expf(-fabsf(fp)));
          float bb = lf;
#pragma unroll
          for (int o = 1; o < 64; o <<= 1) { const float t = __shfl_up(bb, o); if (lane >= o) bb += t; }
          const float a = ip - bb; float pm = a;
#pragma unroll
          for (int o = 1; o < 64; o <<= 1) { const float t = __shfl_up(pm, o); if (lane >= o) pm = fmaxf(pm, t); }
          const float mx = fmaxf(mprev, pm);
          av[lane] = a; rv[lane] = -mx; wiv[lane] = __expf(mprev - mx); flv[lane] = __expf(-(bb + mx));
          const float bL = __shfl(bb, 63), mxL = __shfl(mx, 63);
          decay = __expf(mprev - mxL); wsv[lane] = __expf(a - mxL); mnew = bL + mxL; }
        __syncthreads();
        if (cc < 31) ML_LOAD(g ? 30 - cc : cc + 1);
        const int jrow = 16 * w + fr; const int tk = ML_TOK(c, jrow);
        bf16* orow = Oml + (rowb + tk) * 512 + hc + 4 * fq;
        u32x2 oth[4], mo[4];
        if (cc >= 16) {
#pragma unroll
            for (int ne = 0; ne < 4; ++ne) { oth[ne] = *(const u32x2*)(orow + 16 * ne); mo[ne] = *(const u32x2*)(MO + (rowb + tk) * 512 + hc + 4 * fq + 16 * ne); } }
        const float r_j = rv[jrow], wi_j = wiv[jrow], fl_j = flv[jrow];
        bf16x8 qf[2];
#pragma unroll
        for (int ks = 0; ks < 2; ++ks) qf[ks] = *(const bf16x8*)(qL + jrow * LP + 32 * ks + 8 * fq);
        f32x4 St[4];
#pragma unroll
        for (int n = 0; n < 4; ++n) {
            St[n] = (f32x4){0.f, 0.f, 0.f, 0.f};
            if (n <= w) { f32x4 acc = (f32x4){0.f, 0.f, 0.f, 0.f};
#pragma unroll
                for (int ks = 0; ks < 2; ++ks) { const bf16x8 kf = *(const bf16x8*)(kL + (16 * n + fr) * LP + 32 * ks + 8 * fq); acc = mfma16(kf, qf[ks], acc); }
                const f32x4 a4 = *(const f32x4*)(av + 16 * n + 4 * fq);
#pragma unroll
                for (int jj = 0; jj < 4; ++jj) { const float dd = __expf(r_j + a4[jj]); const bool ok = (n < w) || (4 * fq + jj <= fr); St[n][jj] = ok ? acc[jj] * dd : 0.f; } }
        }
        float rs = 0.f, qn = 0.f;
#pragma unroll
        for (int n = 0; n < 4; ++n) rs += (St[n][0] + St[n][1]) + (St[n][2] + St[n][3]);
#pragma unroll
        for (int ks = 0; ks < 2; ++ks) { float qv[8]; unpack(qf[ks], qv); const f32x4 n0 = *(const f32x4*)(nv + 32 * ks + 8 * fq), n1 = *(const f32x4*)(nv + 32 * ks + 8 * fq + 4);
            qn += (qv[0] * n0[0] + qv[1] * n0[1]) + (qv[2] * n0[2] + qv[3] * n0[3]) + (qv[4] * n1[0] + qv[5] * n1[1]) + (qv[6] * n1[2] + qv[7] * n1[3]); }
        rs += __shfl_xor(rs, 16); rs += __shfl_xor(rs, 32); qn += __shfl_xor(qn, 16); qn += __shfl_xor(qn, 32);
        const float den = rs + wi_j * qn, rden = 1.f / fmaxf(fabsf(den), fl_j);
        bf16x8 sf[2];
#pragma unroll
        for (int ks = 0; ks < 2; ++ks) { const float t8[8] = {St[2 * ks][0], St[2 * ks][1], St[2 * ks][2], St[2 * ks][3], St[2 * ks + 1][0], St[2 * ks + 1][1], St[2 * ks + 1][2], St[2 * ks + 1][3]}; sf[ks] = pack(t8); }
        f32x4 hv[4];
        { s16x4 vlo[4][2], vhi[4][2];
#pragma unroll
          for (int ne = 0; ne < 4; ++ne)
#pragma unroll
              for (int ks = 0; ks < 2; ++ks) if (ks == 0 || w >= 2) {
                  vlo[ne][ks] = trd(vL_a + (unsigned)((32 * ks + 4 * fq + tq) * (LP * 2) + 32 * ne + 8 * tp)); vhi[ne][ks] = trd(vL_a + (unsigned)((32 * ks + 16 + 4 * fq + tq) * (LP * 2) + 32 * ne + 8 * tp)); }
          bf16x8 cf[4][2];
#pragma unroll
          for (int ne = 0; ne < 4; ++ne)
#pragma unroll
              for (int ks = 0; ks < 2; ++ks) cf[ne][ks] = *(const bf16x8*)(Cb + (16 * ne + fr) * LP + 32 * ks + 8 * fq);
          lds_wait();
#pragma unroll
          for (int ne = 0; ne < 4; ++ne) {
              f32x4 y = (f32x4){0.f, 0.f, 0.f, 0.f}, nm = (f32x4){0.f, 0.f, 0.f, 0.f};
#pragma unroll
              for (int ks = 0; ks < 2; ++ks) y = mfma16(cf[ne][ks], qf[ks], y);
#pragma unroll
              for (int ks = 0; ks < 2; ++ks) if (ks == 0 || w >= 2) nm = mfma16(cat(vlo[ne][ks], vhi[ne][ks]), sf[ks], nm);
              hv[ne] = (nm + y * wi_j) * rden; } }
        if (cc < 16) {
#pragma unroll
            for (int ne = 0; ne < 4; ++ne) { u32x2 o; o.x = pg8::cvt_pk_bf16(hv[ne][0], hv[ne][1]); o.y = pg8::cvt_pk_bf16(hv[ne][2], hv[ne][3]); *(u32x2*)(orow + 16 * ne) = o; }
        } else {
            float ss = 0.f;
#pragma unroll
            for (int ne = 0; ne < 4; ++ne) { hv[ne][0] += bflo(oth[ne].x); hv[ne][1] += bfhi(oth[ne].x); hv[ne][2] += bflo(oth[ne].y); hv[ne][3] += bfhi(oth[ne].y);
                ss += (hv[ne][0] * hv[ne][0] + hv[ne][1] * hv[ne][1]) + (hv[ne][2] * hv[ne][2] + hv[ne][3] * hv[ne][3]); }
            ss += __shfl_xor(ss, 16); ss += __shfl_xor(ss, 32);
            const float rn = 1.f / sqrtf(ss * (1.f / 64.f) + EPS);
#pragma unroll
            for (int ne = 0; ne < 4; ++ne) { const f32x4 gg = gh[ne] * rn; u32x2 o;
                o.x = pg8::cvt_pk_bf16(hv[ne][0] * gg[0] * bflo(mo[ne].x), hv[ne][1] * gg[1] * bfhi(mo[ne].x)); o.y = pg8::cvt_pk_bf16(hv[ne][2] * gg[2] * bflo(mo[ne].y), hv[ne][3] * gg[3] * bfhi(mo[ne].y));
                *(u32x2*)(orow + 16 * ne) = o; }
        }
        float dn = 0.f;
        bf16x8 vsf[2]; float wsl[2][8];
        { s16x4 vlo[2], vhi[2], klo[4][2], khi[4][2];
#pragma unroll
          for (int ks = 0; ks < 2; ++ks) { vlo[ks] = trd(vL_a + (unsigned)((32 * ks + 8 * fq + tq) * (LP * 2) + 32 * w + 8 * tp)); vhi[ks] = trd(vL_a + (unsigned)((32 * ks + 8 * fq + 4 + tq) * (LP * 2) + 32 * w + 8 * tp)); }
#pragma unroll
          for (int nd = 0; nd < 4; ++nd)
#pragma unroll
              for (int ks = 0; ks < 2; ++ks) { klo[nd][ks] = trd(kL_a + (unsigned)((32 * ks + 8 * fq + tq) * (LP * 2) + 32 * nd + 8 * tp)); khi[nd][ks] = trd(kL_a + (unsigned)((32 * ks + 8 * fq + 4 + tq) * (LP * 2) + 32 * nd + 8 * tp)); }
          f32x4 w0[2], w1[2];
#pragma unroll
          for (int ks = 0; ks < 2; ++ks) { w0[ks] = *(const f32x4*)(wsv + 32 * ks + 8 * fq); w1[ks] = *(const f32x4*)(wsv + 32 * ks + 8 * fq + 4); }
          lds_wait();
#pragma unroll
          for (int ks = 0; ks < 2; ++ks) {
              wsl[ks][0] = w0[ks][0]; wsl[ks][1] = w0[ks][1]; wsl[ks][2] = w0[ks][2]; wsl[ks][3] = w0[ks][3]; wsl[ks][4] = w1[ks][0]; wsl[ks][5] = w1[ks][1]; wsl[ks][6] = w1[ks][2]; wsl[ks][7] = w1[ks][3];
              float f8[8]; unpack(cat(vlo[ks], vhi[ks]), f8);
#pragma unroll
              for (int e = 0; e < 8; ++e) f8[e] *= wsl[ks][e];
              vsf[ks] = pack(f8); }
          float dn_ = 0.f;
#pragma unroll
          for (int nd = 0; nd < 4; ++nd) {
              Cacc[nd] = Cacc[nd] * decay;
#pragma unroll
              for (int ks = 0; ks < 2; ++ks) { const bf16x8 kt = cat(klo[nd][ks], khi[nd][ks]);
                  Cacc[nd] = mfma16(vsf[ks], kt, Cacc[nd]);
                  if (nd == w) { float k8[8]; unpack(kt, k8);
#pragma unroll
                      for (int e = 0; e < 8; ++e) dn_ += k8[e] * wsl[ks][e]; } } }
          dn = dn_; }
        dn += __shfl_xor(dn, 16); dn += __shfl_xor(dn, 32);
        const float nnew = decay * nv[16 * w + fr] + dn;
        asm volatile("s_waitcnt vmcnt(0) lgkmcnt(0)" ::: "memory");
        __syncthreads();
#pragma unroll
        for (int nd = 0; nd < 4; ++nd)
#pragma unroll
            for (int jj = 0; jj < 4; ++jj) Cb[(16 * w + 4 * fq + jj) * LP + 16 * nd + fr] = (bf16)f2bf(Cacc[nd][jj]);
        if (fq == 0) nv[16 * w + fr] = nnew;
        mprev = mnew;
    }
    __syncthreads();
#undef ML_TOK
#undef ML_LOAD
}
}
__device__ __forceinline__ void phase_mlstm(const Params& p, char* lds, int vcu, int G) {
    for (int u = vcu; u < BATCH * MLH; u += G) ml::mlstm_unit(p, u >> 3, u & 7, lds);
}
constexpr int NTHR = 512, GEMM_LDS = pg8::STAGE_BYTES;
constexpr int LDS_BAR_OFF = 131072, LDS_TOTAL = 131072 + 1024;
static_assert((int)att::SHM_ATTN <= LDS_BAR_OFF && ml::LDS_BYTES <= LDS_BAR_OFF && GEMM_LDS <= LDS_BAR_OFF, "phase scratch fits under the barrier words");
constexpr int CW_BAR = 4096;
static_assert((CW_BAR + XCD_BAR_WORDS) * 4 <= (int)CTL_ZERO_BYTES, "barrier words inside the memset region");

static __device__ __forceinline__ pg8::Gemm dgemm(const void* A, const void* Bt, int M_, int N_, int K_, int lda, int ldb) { pg8::Gemm g; g.A = (const pg8::bf16_t*)A; g.Bt = (const pg8::bf16_t*)Bt; g.M = M_; g.N = N_; g.K = K_; g.lda = lda; g.ldb = ldb; g.pad = 0; return g; }
template <class Epi> __device__ __forceinline__ void run_gemm(LAS unsigned char* lds, const pg8::Gemm& g, const Epi& E) {
    pg8::StaticOrder S; S.init(g.M, g.N, (int)gridDim.x, (int)blockIdx.x);
    pg8::gemm_phase<Epi, pg8::StaticOrder, true, true>(lds, g, S, E);
}
__global__ __launch_bounds__(NTHR, 2) void fwd_kernel(Params p) {
    extern __shared__ __attribute__((aligned(16))) unsigned char lds[];
    LAS unsigned char* L = (LAS unsigned char*)lds;
    const int tid = threadIdx.x;
    const int G = gridDim.x, bx = blockIdx.x, vcu = (G % 8 == 0) ? (bx % 8) * (G / 8) + bx / 8 : bx;
    const int ngw = G * 8;
#define FRESH_IDS int tid_ = threadIdx.x; asm volatile("" : "+v"(tid_)); const int lane = tid_ & 63, wave = __builtin_amdgcn_readfirstlane(tid_ >> 6), gw = bx * 8 + wave;
    unsigned char* ws = p.ws; unsigned char* ob = (unsigned char*)p.out;
    if (tid < 4) ((LAS unsigned*)(L + LDS_BAR_OFF))[tid] = 0u;
    __syncthreads();
    XcdBarrier bar = xcd_barrier_post((unsigned*)(ws + WS_CTL) + CW_BAR, (volatile LAS unsigned*)(L + LDS_BAR_OFF));
#ifdef PROBE_A
    unsigned long long* ts = (unsigned long long*)(ws + WS_CTL + 896 * 1024);
#define STAMP(k) do { if (bx == 0 && tid == 0) ts[k] = __builtin_amdgcn_s_memrealtime(); } while (0)
#else
#define STAMP(k) do { } while (0)
#endif
    STAMP(0);
#ifdef DUP_P0
    { FRESH_IDS phase_prologue(p, L, gw, ngw, wave, lane); } __syncthreads();
#endif
    { FRESH_IDS phase_prologue(p, L, gw, ngw, wave, lane); }
    xcd_barrier(bar);
    STAMP(1);
    { EpiWin E; E.ws = ws; run_gemm(L, dgemm(ws + WS_XB, ws + WS_WIN, M, NINP, DM, DM, DM), E); }
    STAMP(10);
    { EpiPlain E; E.O0 = (bf16*)(ws + WS_MEMKV); E.O1 = nullptr; E.split = 0; E.ldc = 1024; run_gemm(L, dgemm(ws + WS_MEMN, ws + WS_WKVM, MMEM, 1024, DM, DM, DM), E); }
    xcd_barrier(bar);
    STAMP(2);
    { FRESH_IDS phase_tokprep(p, gw, ngw, lane); }
    xcd_barrier(bar);
    STAMP(3);
    { EpiQup E; E.Q = (bf16*)(ob + DO_Q); E.rstd = (const float*)(ws + WS_RSTDCQ); E.cs = (const float*)(ws + WS_COS); E.sn = (const float*)(ws + WS_SIN); run_gemm(L, dgemm(ws + WS_ZA, ws + WS_WUQ, M, QW, QR, 512, QR), E); }
    { EpiKVup E; E.Kd = (bf16*)(ob + DO_K); E.Vd = (bf16*)(ob + DO_V); E.rstd = (const float*)(ws + WS_RSTDCKV); run_gemm(L, dgemm(ws + WS_CKV, ws + WS_WUKV, M, 1024, KVR, KVR, KVR), E); }
    { EpiPlain E; E.O0 = (bf16*)(ws + WS_QKQ); E.O1 = (bf16*)(ws + WS_QKK); E.split = 512; E.ldc = 512; run_gemm(L, dgemm(ws + WS_CML, ws + WS_WML, M, 1024, 512, 512, 512), E); }
    xcd_barrier(bar);
    STAMP(4);
#ifdef DUP_ML
    phase_mlstm(p, (char*)lds, vcu, G);
#endif
    phase_mlstm(p, (char*)lds, vcu, G);
    STAMP(11);
#ifdef DUP_MLA
    phase_attn_mla(p, (char*)lds, vcu, G);
#endif
    phase_attn_mla(p, (char*)lds, vcu, G);
    STAMP(12);
    phase_attn_mem(p, (char*)lds, vcu, G);
    xcd_barrier(bar);
    STAMP(5);
#pragma unroll
    for (int b = 0; b < 3; ++b) { EpiBranch E; E.G = (const bf16*)(ws + WS_G); E.Mg = (bf16*)(ws + WS_MERGED); E.b = b; E.pad = 0;
        const size_t ao = b == 0 ? WS_OMLA : (b == 1 ? WS_OML : WS_MEMQ);
        run_gemm(L, dgemm(ws + ao, ws + WS_WBR + (size_t)b * DM * 512 * 2, M, DM, 512, 512, 512), E); }
    xcd_barrier(bar);
    STAMP(6);
    { EpiResid<true> E; E.res = p.in[I_X]; E.xo = p.out; E.xb = (bf16*)(ws + WS_X1B); E.ssq = (float*)(ws + WS_SSQ1); run_gemm(L, dgemm(ws + WS_MERGED, ws + WS_WOUT, M, DM, DM, DM, DM), E); }
    xcd_barrier(bar);
    STAMP(7);
#ifdef DUP_P6
    { EpiFfnUp E; E.act = (bf16*)(ws + WS_ACT); E.ssq = (const float*)(ws + WS_SSQ1); run_gemm(L, dgemm(ws + WS_X1B, ws + WS_WGU, M, NGU, DM, DM, DM), E); }
#endif
    { EpiFfnUp E; E.act = (bf16*)(ws + WS_ACT); E.ssq = (const float*)(ws + WS_SSQ1); run_gemm(L, dgemm(ws + WS_X1B, ws + WS_WGU, M, NGU, DM, DM, DM), E); }
    xcd_barrier(bar);
    STAMP(8);
    { EpiResid<false> E; E.res = p.out; E.xo = p.out; E.xb = nullptr; E.ssq = (float*)(ws + WS_SSQ2); run_gemm(L, dgemm(ws + WS_ACT, ws + WS_WDN, M, DM, DFF, DFF, DFF), E); }
    xcd_barrier(bar);
    STAMP(9);
#ifdef PROBE_A
    { const float dA = (float)(long long)(ts[PROBE_A1] - ts[PROBE_A]), dB = (float)(long long)(ts[PROBE_B1] - ts[PROBE_B]);
      FRESH_IDS phase_final(p, gw, ngw, lane, 1.f + dA * (1.f / 500000.f), dB * (1.f / 2000.f)); }
#else
    { FRESH_IDS phase_final(p, gw, ngw, lane, 1.f, 0.f); }
#endif
}
extern "C" void kernel_launch(void* const* d_in, const int* in_sizes, int n_in, void* d_out, int out_size, void* d_ws, size_t ws_size, hipStream_t stream) {
    static int grid = 0;
    if (grid == 0) {
        if (n_in != N_INPUTS || in_sizes[0] != M * DM || out_size != M * DM || ws_size < WS_END) { fprintf(stderr, "kernel_launch: shape/workspace mismatch (n_in %d, ws %zu)\n", n_in, ws_size); grid = -1; return; }
        int dev = 0, cus = 0, per_cu = 0;
        if (hipGetDevice(&dev) != hipSuccess || hipDeviceGetAttribute(&cus, hipDeviceAttributeMultiprocessorCount, dev) != hipSuccess) { grid = -1; return; }
        if (hipFuncSetAttribute((const void*)fwd_kernel, hipFuncAttributeMaxDynamicSharedMemorySize, LDS_TOTAL) != hipSuccess) { grid = -1; return; }
        if (hipOccupancyMaxActiveBlocksPerMultiprocessor(&per_cu, (const void*)fwd_kernel, NTHR, LDS_TOTAL) != hipSuccess || per_cu < 1) { fprintf(stderr, "kernel_launch: occupancy query says %d\n", per_cu); (void)hipGetLastError(); }
        grid = cus;
    }
    if (grid < 0) return;
    Params p{}; for (int i = 0; i < N_INPUTS; ++i) p.in[i] = (const float*)d_in[i]; p.out = (float*)d_out; p.ws = (unsigned char*)d_ws;
    (void)hipMemsetAsync((unsigned char*)d_ws + WS_CTL, 0, CTL_ZERO_BYTES, stream);
    hipLaunchKernelGGL(fwd_kernel, dim3(grid), dim3(NTHR), LDS_TOTAL, stream, p);
}
```
